# Optimizing an MI355X kernel written in HIP

```python
import jax, jax.numpy as jnp
from jax import lax
import numpy as np

D_MODEL = 2048
BATCH = 2
SEQ = 4096
DEPTH = 4

HEAD_DIM = 64
EPS = 1e-6
Q_BLOCK = 128
FOX_HEADS = 8
FOX_WIDTH = FOX_HEADS * HEAD_DIM
CONV_WIDTH = 512
CONV_TAPS = 3
SGU_GROUPS = 4
SGU_GROUP_DIM = 128
SGU_WIDTH = SGU_GROUPS * SGU_GROUP_DIM
SGU_CHUNK = 128
DIL_PATTERNS = ((128, 1), (512, 4), (2048, 16))
DIL_HEADS_PER_GROUP = 4
DIL_HEADS = DIL_HEADS_PER_GROUP * len(DIL_PATTERNS)
DIL_WIDTH = DIL_HEADS * HEAD_DIM
DIL_OUT = DIL_HEADS_PER_GROUP * HEAD_DIM
ROPE_THETA = 500000.0
ROPE_DIM = HEAD_DIM // 4
N_BRANCH = 4
IN_SIZES = (3 * FOX_WIDTH, FOX_HEADS, 3 * CONV_WIDTH, 2 * SGU_WIDTH, 3 * DIL_WIDTH, N_BRANCH * D_MODEL)
D_IN = 3 * FOX_WIDTH + FOX_HEADS + 3 * CONV_WIDTH + 2 * SGU_WIDTH + 3 * DIL_WIDTH + N_BRANCH * D_MODEL
D_FF = 5632
FFN_TAPS = 3
PLE_DIM = 256

kernel_name = "hybrid_parallel_gated_fox_conv_sgu_dilated"


def rms_norm(x, g):
    xf = x.astype(jnp.float32)
    var = jnp.mean(xf * xf, axis=-1, keepdims=True)
    return (xf * lax.rsqrt(var + EPS)).astype(x.dtype) * g


def causal_dwconv(z, w):
    K = w.shape[0]
    S = z.shape[1]
    zp = jnp.pad(z, ((0, 0), (K - 1, 0), (0, 0)))
    return sum(w[k] * zp[:, k:k + S] for k in range(K))


def partial_rope(x, positions):
    half = ROPE_DIM // 2
    inv = ROPE_THETA ** (-jnp.arange(half, dtype=jnp.float32) * (2.0 / ROPE_DIM))
    ang = positions.astype(jnp.float32)[..., None] * inv
    cos = jnp.cos(ang)[:, :, None, :]
    sin = jnp.sin(ang)[:, :, None, :]
    x1 = x[..., :half].astype(jnp.float32)
    x2 = x[..., half:ROPE_DIM].astype(jnp.float32)
    rot = jnp.concatenate([(x1 * cos - x2 * sin).astype(x.dtype),
                           (x1 * sin + x2 * cos).astype(x.dtype),
                           x[..., ROPE_DIM:]], axis=-1)
    return rot


def forgetting_attention(q, k, v, log_f):
    B, S, H, Dh = q.shape
    nb = S // Q_BLOCK
    F = jnp.cumsum(log_f, axis=1).transpose(0, 2, 1)
    qb = q.reshape(B, nb, Q_BLOCK, H, Dh).transpose(1, 0, 2, 3, 4)
    Fb = F.reshape(B, H, nb, Q_BLOCK).transpose(2, 0, 1, 3)
    kpos = jnp.arange(S)
    scale = Dh ** -0.5

    def one_block(args):
        blk, q_blk, f_blk = args
        s = jnp.einsum('bqhd,bkhd->bhqk', q_blk, k, preferred_element_type=jnp.float32) * scale
        s = s + (f_blk[..., :, None] - F[..., None, :])
        qpos = blk * Q_BLOCK + jnp.arange(Q_BLOCK)
        s = jnp.where(kpos[None, :] <= qpos[:, None], s, -jnp.inf)
        p = jax.nn.softmax(s, axis=-1).astype(v.dtype)
        return jnp.einsum('bhqk,bkhd->bqhd', p, v)

    out = lax.map(one_block, (jnp.arange(nb), qb, Fb))
    return out.transpose(1, 0, 2, 3, 4).reshape(B, S, H * Dh)


def dilated_window_attention(q, k, v, window, dilation):
    B, S, H, Dh = q.shape
    L = S // dilation
    span = window // dilation
    nb = -(-L // span)
    Lp = nb * span

    def strided_blocks(t):
        t = t.reshape(B, L, dilation, H, Dh).transpose(0, 2, 1, 3, 4)
        t = jnp.pad(t, ((0, 0), (0, 0), (0, Lp - L), (0, 0), (0, 0)))
        return t.reshape(B, dilation, nb, span, H, Dh)

    def with_prev(t):
        prev = jnp.pad(t[:, :, :-1], ((0, 0), (0, 0), (1, 0), (0, 0), (0, 0), (0, 0)))
        return jnp.concatenate([prev, t], axis=3)

    qs = strided_blocks(q)
    kc = with_prev(strided_blocks(k))
    vc = with_prev(strided_blocks(v))
    s = jnp.einsum('brnqhd,brnkhd->brnhqk', qs, kc, preferred_element_type=jnp.float32) * (Dh ** -0.5)
    blk = jnp.arange(nb)[:, None, None]
    qi = jnp.arange(span)[None, :, None]
    ki = jnp.arange(2 * span)[None, None, :]
    dist = span + qi - ki
    valid = (dist >= 0) & (dist <= span) & ((blk > 0) | (ki >= span))
    s = jnp.where(valid[:, None], s, -jnp.inf)
    lse = jax.nn.logsumexp(s, axis=-1, keepdims=True)
    p = jnp.exp(s - lse).astype(v.dtype)
    o = jnp.einsum('brnhqk,brnkhd->brnqhd', p, vc)
    o = o.reshape(B, dilation, Lp, H, Dh)[:, :, :L].transpose(0, 2, 1, 3, 4).reshape(B, S, H, Dh)
    lse = lse[..., 0].transpose(0, 1, 2, 4, 3).reshape(B, dilation, Lp, H)[:, :, :L]
    lse = lse.transpose(0, 2, 1, 3).reshape(B, S, H)
    return o, lse


def chunked_spatial_gating(z, norm_g, w_s, b_s):
    u, v = jnp.split(z, 2, axis=-1)
    v = rms_norm(v, norm_g)
    B, S, _ = v.shape
    nc = S // SGU_CHUNK
    vc = v.reshape(B, nc, SGU_CHUNK, SGU_GROUPS, SGU_GROUP_DIM)
    mask = jnp.tril(jnp.ones((SGU_CHUNK, SGU_CHUNK), dtype=bool))
    ws = jnp.where(mask[None], w_s, jnp.zeros_like(w_s))
    mixed = jnp.einsum('gts,bcsgd->bctgd', ws, vc) + b_s.T[None, None, :, :, None]
    return u * mixed.reshape(B, S, SGU_WIDTH)


def setup_inputs(seed: int = 0) -> dict:
    key = jax.random.key(seed)
    ks = jax.random.split(key, 24)

    def nrm(k, shape, scale):
        return jax.random.normal(k, shape, jnp.float32) * scale

    def gain(k, shape):
        return 1.0 + 0.1 * jax.random.normal(k, shape, jnp.float32)

    offset = jax.random.randint(ks[2], (BATCH, 1), 0, 1024, dtype=jnp.int32)
    positions = offset + jnp.arange(SEQ, dtype=jnp.int32)[None, :]
    return {
        "x": nrm(ks[0], (BATCH, SEQ, D_MODEL), 1.0),
        "p": nrm(ks[1], (DEPTH, BATCH, SEQ, PLE_DIM), 1.0),
        "positions": positions,
        "norm_mix_g": gain(ks[3], (DEPTH, D_MODEL)),
        "w_in": nrm(ks[4], (DEPTH, D_MODEL, D_IN), D_MODEL ** -0.5),
        "fox_forget_b": 2.0 + 3.0 * jax.random.uniform(ks[5], (DEPTH, FOX_HEADS), jnp.float32),
        "shortconv_w": nrm(ks[6], (DEPTH, CONV_TAPS, CONV_WIDTH), CONV_TAPS ** -0.5),
        "sgu_norm_g": gain(ks[7], (DEPTH, SGU_WIDTH)),
        "sgu_w": nrm(ks[8], (DEPTH, SGU_GROUPS, SGU_CHUNK, SGU_CHUNK), SGU_CHUNK ** -0.5),
        "sgu_b": gain(ks[9], (DEPTH, SGU_GROUPS, SGU_CHUNK)),
        "w_br_fox": nrm(ks[10], (DEPTH, FOX_WIDTH, D_MODEL), FOX_WIDTH ** -0.5),
        "w_br_conv": nrm(ks[11], (DEPTH, CONV_WIDTH, D_MODEL), CONV_WIDTH ** -0.5),
        "w_br_sgu": nrm(ks[12], (DEPTH, SGU_WIDTH, D_MODEL), SGU_WIDTH ** -0.5),
        "w_br_dil": nrm(ks[13], (DEPTH, DIL_OUT, D_MODEL), DIL_OUT ** -0.5),
        "w_out": nrm(ks[14], (DEPTH, D_MODEL, D_MODEL), D_MODEL ** -0.5),
        "norm_ffn_g": gain(ks[15], (DEPTH, D_MODEL)),
        "w_up": nrm(ks[16], (DEPTH, D_MODEL, 2 * D_FF), D_MODEL ** -0.5),
        "ffn_conv_w": nrm(ks[17], (DEPTH, FFN_TAPS, 2 * D_FF), FFN_TAPS ** -0.5),
        "w_down": nrm(ks[18], (DEPTH, D_FF, D_MODEL), D_FF ** -0.5),
        "norm_ple_g": gain(ks[19], (DEPTH, D_MODEL)),
        "w_ple_gate": nrm(ks[20], (DEPTH, D_MODEL, D_MODEL), D_MODEL ** -0.5),
        "w_ple_proj": nrm(ks[21], (DEPTH, PLE_DIM, D_MODEL), PLE_DIM ** -0.5),
        "final_norm_g": gain(ks[22], (D_MODEL,)),
    }


def reference(x, p, positions, norm_mix_g, w_in, fox_forget_b, shortconv_w, sgu_norm_g, sgu_w, sgu_b,
              w_br_fox, w_br_conv, w_br_sgu, w_br_dil, w_out, norm_ffn_g, w_up, ffn_conv_w, w_down,
              norm_ple_g, w_ple_gate, w_ple_proj, final_norm_g):
    B, S, _ = x.shape
    split_points = [int(c) for c in np.cumsum(IN_SIZES)[:-1]]
    for i in range(DEPTH):
        h = rms_norm(x, norm_mix_g[i])
        proj = h @ w_in[i]
        a_qkv, a_f, b_in, c_in, d_qkv, gate_logits = jnp.split(proj, split_points, axis=-1)

        a_qkv = a_qkv.reshape(B, S, 3, FOX_HEADS, HEAD_DIM)
        log_f = jax.nn.log_sigmoid(a_f.astype(jnp.float32) + fox_forget_b[i].astype(jnp.float32))
        o_a = forgetting_attention(a_qkv[:, :, 0], a_qkv[:, :, 1], a_qkv[:, :, 2], log_f)

        xb, gate_b, gate_c = jnp.split(b_in, 3, axis=-1)
        o_b = gate_b * causal_dwconv(gate_c * xb, shortconv_w[i])

        o_c = chunked_spatial_gating(jax.nn.gelu(c_in), sgu_norm_g[i], sgu_w[i], sgu_b[i])

        d_qkv = d_qkv.reshape(B, S, 3, DIL_HEADS, HEAD_DIM)
        qd = partial_rope(d_qkv[:, :, 0], positions)
        kd = partial_rope(d_qkv[:, :, 1], positions)
        vd = d_qkv[:, :, 2]
        outs, lses = [], []
        for g, (window, dil) in enumerate(DIL_PATTERNS):
            hs = slice(g * DIL_HEADS_PER_GROUP, (g + 1) * DIL_HEADS_PER_GROUP)
            o_g, l_g = dilated_window_attention(qd[:, :, hs], kd[:, :, hs], vd[:, :, hs], window, dil)
            outs.append(o_g)
            lses.append(l_g)
        wts = jax.nn.softmax(jnp.stack(lses, axis=0), axis=0)
        o_d = jnp.sum(wts[..., None] * jnp.stack(outs, axis=0), axis=0).astype(x.dtype).reshape(B, S, DIL_OUT)

        gates = jax.nn.sigmoid(gate_logits).reshape(B, S, N_BRANCH, D_MODEL)
        merged = (gates[:, :, 0] * (o_a @ w_br_fox[i]) + gates[:, :, 1] * (o_b @ w_br_conv[i])
                  + gates[:, :, 2] * (o_c @ w_br_sgu[i]) + gates[:, :, 3] * (o_d @ w_br_dil[i]))
        x = x + merged @ w_out[i]

        h = rms_norm(x, norm_ffn_g[i])
        up = causal_dwconv(h @ w_up[i], ffn_conv_w[i])
        up_gate, up_val = jnp.split(up, 2, axis=-1)
        x = x + (jax.nn.silu(up_gate) * up_val) @ w_down[i]

        ple_gate = jax.nn.sigmoid(rms_norm(x, norm_ple_g[i]) @ w_ple_gate[i])
        x = x + ple_gate * (p[i] @ w_ple_proj[i])
    return rms_norm(x, final_norm_g)
```

```cpp
#include <hip/hip_runtime.h>
#include <cstdio>
#include <cstdint>

#ifndef MK_SPLIT
#define MK_SPLIT 1
#endif

#define LAS __attribute__((address_space(3)))
#define GAS __attribute__((address_space(1)))
typedef unsigned short bf16_t;
typedef short bf16x8 __attribute__((ext_vector_type(8)));
typedef short s16x4 __attribute__((ext_vector_type(4)));
typedef float f32x2 __attribute__((ext_vector_type(2)));
typedef float f32x4 __attribute__((ext_vector_type(4)));
typedef float f32x16 __attribute__((ext_vector_type(16)));
typedef unsigned u32x2 __attribute__((ext_vector_type(2)));
typedef unsigned u32x4 __attribute__((ext_vector_type(4)));

constexpr int NB = 2, SEQ = 4096, DM = 2048, DEPTH = 4, M = NB * SEQ;
constexpr int DIN_SRC = 14600, DIN = 14592;
constexpr int DFF = 5632, PLE = 256;
constexpr float EPS = 1e-6f;
constexpr float LOG2E = 1.4426950408889634f;
constexpr float C2 = 0.125f * LOG2E;
constexpr int PC_AQ = 0, PC_AK = 512, PC_AV = 1024, PC_XB = 1536, PC_GB = 2048, PC_GC = 2560, PC_SU = 3072, PC_SV = 3584,
              PC_DQ = 4096, PC_DK = 4864, PC_DV = 5632, PC_G = 6400;
constexpr int OC_W = 1792;
constexpr int OC_A = 0, OC_B = 512, OC_C = 1024, OC_D = 1536;

constexpr size_t MiB = 1u << 20;
constexpr size_t WS_CTL = 0, CTL_BYTES = 2 * MiB;
constexpr size_t WS_WL = 2 * MiB;
constexpr size_t WL_IN = 0, WL_BR = 57 * MiB, WL_OUT = 64 * MiB, WL_UP = 72 * MiB, WL_DN = 116 * MiB, WL_PG = 138 * MiB, WL_PE = 146 * MiB, WL_STRIDE = 147 * MiB;
constexpr size_t WS_SMALL = WS_WL + 4 * WL_STRIDE;
constexpr size_t SM_WFG = 0, SM_SGUW = 256 * 1024, SM_ROPE = 768 * 1024, SM_LOGF = 1280 * 1024, SM_FL = 1536 * 1024, SM_LSE = 1792 * 1024;
constexpr size_t WS_PB = WS_SMALL + 4 * MiB;
constexpr size_t WS_PP = WS_PB + 16 * MiB;
constexpr size_t WS_XN = WS_PP + 128 * MiB;
constexpr size_t WS_PROJ = WS_XN + 32 * MiB;
constexpr size_t WS_HID = WS_PROJ + 228 * MiB;
constexpr size_t WS_OCAT = WS_HID + 88 * MiB;
constexpr size_t WS_MG = WS_OCAT + 28 * MiB;
constexpr size_t WS_ODIL = WS_MG + 32 * MiB;
constexpr size_t WS_END = WS_ODIL + 24 * MiB;
constexpr int CW_BAR = 4096;
constexpr int CW_Q = 1024;

constexpr int LDS_BYTES = 147456;
constexpr int RING_BYTES = 131072;
constexpr int MISC_OFF = RING_BYTES + 320;

#define LDS_WAIT() asm volatile("s_waitcnt lgkmcnt(0)" ::: "memory")
#define VM_WAIT() asm volatile("s_waitcnt vmcnt(0)" ::: "memory")
#define BAR_L() asm volatile("s_waitcnt lgkmcnt(0)\n\ts_barrier" ::: "memory")
typedef __bf16 bf16x2_t __attribute__((ext_vector_type(2)));
__device__ __forceinline__ unsigned cvt_pk_bf16(float lo, float hi) { f32x2 v = {lo, hi}; bf16x2_t b = __builtin_convertvector(v, bf16x2_t); return __builtin_bit_cast(unsigned, b); }
__device__ __forceinline__ float bf_lo(unsigned u) { return __uint_as_float(u << 16); }
__device__ __forceinline__ float bf_hi(unsigned u) { return __uint_as_float(u & 0xffff0000u); }
__device__ __forceinline__ float bf1(bf16_t u) { return __uint_as_float(((unsigned)u) << 16); }
__device__ __forceinline__ float wave_sum(float v) {
#pragma unroll
    for (int o = 1; o < 64; o <<= 1) v += __shfl_xor(v, o);
    return v;
}
__device__ __forceinline__ float fast_exp2(float x) { return __builtin_amdgcn_exp2f(x); }
__device__ __forceinline__ float fast_rcp(float x) { return __builtin_amdgcn_rcpf(x); }
__device__ __forceinline__ float sigmoid_f(float x) { return fast_rcp(1.0f + fast_exp2(-LOG2E * x)); }
__device__ __forceinline__ float gelu_tanh_f(float x) {
    const float z = 0.7978845608028654f * (x + 0.044715f * x * x * x);
    return x * fast_rcp(1.0f + fast_exp2(-2.0f * LOG2E * z));
}

namespace pg8 {
#define PG8_LAS __attribute__((address_space(3)))
constexpr int BM = 256, BK = 64, HALF = 128, HTB = HALF * BK * 2, STAGE_BYTES = 8 * HTB, NXCD = 8, WGM = 8;
__host__ __device__ __forceinline__ int lds_byte(int r, int c) { const int st = (r >> 4) * 2 + (c >> 5), rr = r & 15, cc = c & 31, ob = rr * 64 + cc * 2; return st * 1024 + (ob ^ (((ob >> 9) & 1) << 5)); }
__host__ __device__ __forceinline__ void stage_rc(int b, int& R, int& C) { const int st = b / 1024, sb = b % 1024, swz = sb ^ (((sb >> 9) & 1) << 5); R = (st >> 1) * 16 + swz / 64; C = (st & 1) * 32 + (swz % 64) / 2; }
__host__ __device__ __forceinline__ int perm32(int rho) { const int n = rho >> 4, i = rho & 15; return 8 * (i >> 2) + 4 * n + (i & 3); }
struct Unit { int pm, pn; };
struct Gemm { const bf16_t* A; const bf16_t* Bt; int M, N, K; };
struct StaticOrder {
    int nM, nN, nwg, G, c;
    __host__ __device__ void init(int M_, int N_, int G_, int c_) { nM = M_ / BM; nN = N_ / BM; nwg = nM * nN; G = G_; c = c_; }
    __host__ __device__ bool next(int i, Unit& u) const {
        const long L = (long)i * G + c; if (L >= nwg) return false;
        int wgid = (int)L; { const int q = nwg / NXCD, r = nwg % NXCD, xcd = wgid % NXCD, off = wgid / NXCD; wgid = (xcd < r ? xcd * (q + 1) : r * (q + 1) + (xcd - r) * q) + off; }
        const int nig = WGM * nN, gid = wgid / nig, fm = gid * WGM, gsz = (nM - fm) < WGM ? (nM - fm) : WGM;
        u.pm = fm + ((wgid % nig) % gsz); u.pn = (wgid % nig) / gsz; return true;
    }
    __device__ __forceinline__ void a_ready(const Unit&) const {}
    __device__ __forceinline__ void done(const Unit&) const {}
};
typedef f32x4 Acc[2][2][4][2];

template <int MODE> __device__ __forceinline__ void store_tile_bf16(const Acc& acc, bf16_t* O, int ldc, int row0, int col0) {
#pragma unroll
    for (int ai = 0; ai < 2; ++ai)
#pragma unroll
        for (int m = 0; m < 4; ++m) { bf16_t* rowp = O + (size_t)(row0 + ai * HALF + m * 16) * ldc + col0;
#pragma unroll
            for (int bj = 0; bj < 2; ++bj) { f32x4 v0 = acc[ai][bj][m][0], v1 = acc[ai][bj][m][1];
                if (MODE == 1) { v0 = v0 * C2; v1 = v1 * C2; }
                if (MODE == 2) {
#pragma unroll
                    for (int e = 0; e < 4; ++e) { v0[e] = gelu_tanh_f(v0[e]); v1[e] = gelu_tanh_f(v1[e]); } }
                if (MODE == 3) {
#pragma unroll
                    for (int e = 0; e < 4; ++e) { v0[e] = sigmoid_f(v0[e]); v1[e] = sigmoid_f(v1[e]); } }
                u32x4 w; w.x = cvt_pk_bf16(v0[0], v0[1]); w.y = cvt_pk_bf16(v0[2], v0[3]); w.z = cvt_pk_bf16(v1[0], v1[1]); w.w = cvt_pk_bf16(v1[2], v1[3]);
                *(u32x4*)(rowp + bj * HALF) = w; } }
}
struct NoHook { static constexpr bool ON = false; __device__ __forceinline__ void operator()(Acc&, const Unit&, int, int, int, int, int) const {} };
struct EpiPlain {
    static constexpr bool PERM = true, AFTER_DRAIN = false;
    bf16_t* O; int ldc;
    __device__ __forceinline__ void operator()(Acc& acc, const Unit& u, int wr, int wc, int fr, int fq) const {
        store_tile_bf16<0>(acc, O, ldc, u.pm * BM + wr * 64 + fr, u.pn * BM + wc * 32 + 8 * fq); }
};
struct EpiProj {
    static constexpr bool PERM = true, AFTER_DRAIN = false;
    bf16_t* O; int ldc;
    __device__ __forceinline__ void operator()(Acc& acc, const Unit& u, int wr, int wc, int fr, int fq) const {
        const int pn = u.pn, row0 = u.pm * BM + wr * 64 + fr, col0 = pn * BM + wc * 32 + 8 * fq;
        if (pn < 2 || (pn >= 16 && pn < 19)) store_tile_bf16<1>(acc, O, ldc, row0, col0);
        else if (pn >= 12 && pn < 16) store_tile_bf16<2>(acc, O, ldc, row0, col0);
        else if (pn >= 25) store_tile_bf16<3>(acc, O, ldc, row0, col0);
        else store_tile_bf16<0>(acc, O, ldc, row0, col0);
    }
};
struct EpiResid {
    static constexpr bool PERM = false, AFTER_DRAIN = false;
    const float* base; float* out; int ldc;
    __device__ __forceinline__ void operator()(Acc& acc, const Unit& u, int wr, int wc, int fr, int fq) const {
        const int row0 = u.pm * BM + wr * 64 + fr, col0 = u.pn * BM + wc * 32 + 4 * fq;
#pragma unroll
        for (int ai = 0; ai < 2; ++ai)
#pragma unroll
            for (int mp = 0; mp < 2; ++mp) { f32x4 b[2][2][2];
#pragma unroll
                for (int mm = 0; mm < 2; ++mm) { const size_t off = (size_t)(row0 + ai * HALF + (2 * mp + mm) * 16) * ldc + col0;
#pragma unroll
                    for (int bj = 0; bj < 2; ++bj)
#pragma unroll
                        for (int n = 0; n < 2; ++n) b[mm][bj][n] = *(const f32x4*)(base + off + bj * HALF + n * 16); }
#pragma unroll
                for (int mm = 0; mm < 2; ++mm) { const size_t off = (size_t)(row0 + ai * HALF + (2 * mp + mm) * 16) * ldc + col0;
#pragma unroll
                    for (int bj = 0; bj < 2; ++bj)
#pragma unroll
                        for (int n = 0; n < 2; ++n) *(f32x4*)(out + off + bj * HALF + n * 16) = b[mm][bj][n] + acc[ai][bj][2 * mp + mm][n]; }
                asm volatile("" ::: "memory"); }
    }
};
struct EpiPle {
    static constexpr bool PERM = false, AFTER_DRAIN = false;
    float* X; const bf16_t* PP; int ldc;
    __device__ __forceinline__ void operator()(Acc& acc, const Unit& u, int wr, int wc, int fr, int fq) const {
        const int row0 = u.pm * BM + wr * 64 + fr, col0 = u.pn * BM + wc * 32 + 4 * fq;
#pragma unroll
        for (int ai = 0; ai < 2; ++ai)
#pragma unroll
            for (int mp = 0; mp < 2; ++mp) { f32x4 b[2][2][2]; u32x2 pp[2][2][2];
#pragma unroll
                for (int mm = 0; mm < 2; ++mm) { const size_t off = (size_t)(row0 + ai * HALF + (2 * mp + mm) * 16) * ldc + col0;
#pragma unroll
                    for (int bj = 0; bj < 2; ++bj)
#pragma unroll
                        for (int n = 0; n < 2; ++n) { b[mm][bj][n] = *(const f32x4*)(X + off + bj * HALF + n * 16); pp[mm][bj][n] = *(const u32x2*)(PP + off + bj * HALF + n * 16); } }
#pragma unroll
                for (int mm = 0; mm < 2; ++mm) { const size_t off = (size_t)(row0 + ai * HALF + (2 * mp + mm) * 16) * ldc + col0;
#pragma unroll
                    for (int bj = 0; bj < 2; ++bj)
#pragma unroll
                        for (int n = 0; n < 2; ++n) { const f32x4 a = acc[ai][bj][2 * mp + mm][n], bb = b[mm][bj][n]; const u32x2 p2 = pp[mm][bj][n]; f32x4 r;
                            r[0] = bb[0] + sigmoid_f(a[0]) * bf_lo(p2.x); r[1] = bb[1] + sigmoid_f(a[1]) * bf_hi(p2.x); r[2] = bb[2] + sigmoid_f(a[2]) * bf_lo(p2.y); r[3] = bb[3] + sigmoid_f(a[3]) * bf_hi(p2.y);
                            *(f32x4*)(X + off + bj * HALF + n * 16) = r; } }
                asm volatile("" ::: "memory"); }
    }
};
struct MergeHook {
    static constexpr bool ON = true;
    const bf16_t* G;
    __device__ __forceinline__ void operator()(Acc& acc, const Unit& u, int t, int wr, int wc, int fr, int fq) const {
        const int j = (t >> 3) - 1;
        unsigned off0 = (unsigned)((u.pm * BM + wr * 64 + fr) * DIN + u.pn * BM + wc * 32 + 8 * fq);
        asm volatile("" : "+v"(off0));
        const bf16_t* gj = G + j * 2048;
#pragma unroll
        for (int ai = 0; ai < 2; ++ai) {
#pragma unroll
            for (int m = 0; m < 4; ++m) { const bf16_t* gp = gj + (off0 + (unsigned)((ai * HALF + m * 16) * DIN));
#pragma unroll
                for (int bj = 0; bj < 2; ++bj) { const u32x4 a = *(const u32x4*)(gp + bj * HALF), b = *(const u32x4*)(gp + 2048 + bj * HALF);
                    f32x4 r0, r1;
                    r0[0] = bf_lo(a.x) * fast_rcp(bf_lo(b.x)); r0[1] = bf_hi(a.x) * fast_rcp(bf_hi(b.x)); r0[2] = bf_lo(a.y) * fast_rcp(bf_lo(b.y)); r0[3] = bf_hi(a.y) * fast_rcp(bf_hi(b.y));
                    r1[0] = bf_lo(a.z) * fast_rcp(bf_lo(b.z)); r1[1] = bf_hi(a.z) * fast_rcp(bf_hi(b.z)); r1[2] = bf_lo(a.w) * fast_rcp(bf_lo(b.w)); r1[3] = bf_hi(a.w) * fast_rcp(bf_hi(b.w));
                    acc[ai][bj][m][0] = acc[ai][bj][m][0] * r0; acc[ai][bj][m][1] = acc[ai][bj][m][1] * r1; }
                if (m & 1) asm volatile("" ::: "memory"); } }
    }
};
struct EpiMerge {
    static constexpr bool PERM = true, AFTER_DRAIN = false;
    bf16_t* O; int ldc; const bf16_t* G3;
    __device__ __forceinline__ void operator()(Acc& acc, const Unit& u, int wr, int wc, int fr, int fq) const {
        const int row0 = u.pm * BM + wr * 64 + fr, col0 = u.pn * BM + wc * 32 + 8 * fq;
#pragma unroll
        for (int ai = 0; ai < 2; ++ai) { u32x4 g[4][2];
#pragma unroll
            for (int m = 0; m < 4; ++m)
#pragma unroll
                for (int bj = 0; bj < 2; ++bj) g[m][bj] = *(const u32x4*)(G3 + (size_t)(row0 + ai * HALF + m * 16) * DIN + col0 + bj * HALF);
#pragma unroll
            for (int m = 0; m < 4; ++m)
#pragma unroll
                for (int bj = 0; bj < 2; ++bj) { const u32x4 gg = g[m][bj]; const f32x4 v0 = acc[ai][bj][m][0], v1 = acc[ai][bj][m][1];
                    u32x4 w; w.x = cvt_pk_bf16(v0[0] * bf_lo(gg.x), v0[1] * bf_hi(gg.x)); w.y = cvt_pk_bf16(v0[2] * bf_lo(gg.y), v0[3] * bf_hi(gg.y));
                    w.z = cvt_pk_bf16(v1[0] * bf_lo(gg.z), v1[1] * bf_hi(gg.z)); w.w = cvt_pk_bf16(v1[2] * bf_lo(gg.w), v1[3] * bf_hi(gg.w));
                    *(u32x4*)(O + (size_t)(row0 + ai * HALF + m * 16) * ldc + col0 + bj * HALF) = w; }
            asm volatile("" ::: "memory"); }
    }
};

template <class Epi, class Hook>
__device__ __forceinline__ void gemm_phase(PG8_LAS unsigned char* lds, const Gemm g, const StaticOrder& S, const Epi& E, const Hook& H) {
    int tid = threadIdx.x; asm volatile("" : "+v"(tid));
    const int wid = __builtin_amdgcn_readfirstlane(tid >> 6), lane = tid & 63, wr = wid >> 2, wc = wid & 3, fr = lane & 15, fq = lane >> 4;
    const int K = g.K, nt = K / BK;
    unsigned voffA[2], voffB[2];
#pragma unroll
    for (int i = 0; i < 2; ++i) { int R, C; stage_rc(tid * 16 + i * 8192, R, C); const int Rb = Epi::PERM ? ((R & ~31) + perm32(R & 31)) : R;
        voffA[i] = (unsigned)(R * K + C) * 2u; voffB[i] = (unsigned)(Rb * K + C) * 2u; }
    const size_t kstep = (size_t)(BK * 2);
    const size_t hstep = (size_t)HALF * K * 2;
    const size_t tstep = 2 * hstep;
    const unsigned ldsw = (unsigned)wid * 1024u;
    const int aoff = lds_byte(wr * 64 + fr, fq * 8), boff = lds_byte(wc * 32 + fr, fq * 8);
#define PG8_SA(b, h) (((b) * 2 + (h)) * HTB)
#define PG8_SB(b, h) ((4 + (b) * 2 + (h)) * HTB)
#define PG8_STAGE(bufoff, gbase, voff) do { _Pragma("unroll") for (int _i = 0; _i < 2; ++_i) \
        __builtin_amdgcn_global_load_lds((const unsigned*)((const char*)(gbase) + (voff)[_i]), (PG8_LAS unsigned*)(lds + (bufoff) + ldsw + _i * 8192), 16, 0, 0); } while (0)
#define PG8_LDA(dst, b, h) do { _Pragma("unroll") for (int m = 0; m < 4; ++m) _Pragma("unroll") for (int k = 0; k < 2; ++k) dst[m][k] = *(const PG8_LAS bf16x8*)(lds + PG8_SA(b, h) + aoff + m * 2048 + k * 1024); } while (0)
#define PG8_LDB(dst, b, h) do { _Pragma("unroll") for (int n = 0; n < 2; ++n) _Pragma("unroll") for (int k = 0; k < 2; ++k) dst[n][k] = *(const PG8_LAS bf16x8*)(lds + PG8_SB(b, h) + boff + n * 2048 + k * 1024); } while (0)
#define PG8_MMA(ai, bj, At, Bt) do { __builtin_amdgcn_s_setprio(1); _Pragma("unroll") for (int m = 0; m < 4; ++m) _Pragma("unroll") for (int n = 0; n < 2; ++n) _Pragma("unroll") for (int k = 0; k < 2; ++k) \
        acc[ai][bj][m][n] = __builtin_amdgcn_mfma_f32_16x16x32_bf16(Bt[n][k], At[m][k], acc[ai][bj][m][n], 0, 0, 0); __builtin_amdgcn_s_setprio(0); } while (0)
#define PG8_WAIT_V(n) asm volatile("s_waitcnt vmcnt(" #n ")" ::: "memory")
#define PG8_WAIT_L(n) asm volatile("s_waitcnt lgkmcnt(" #n ")" ::: "memory")
#define PG8_BAR __builtin_amdgcn_s_barrier()
#define PG8_SCHED __builtin_amdgcn_sched_barrier(0)
    Unit cur, nxt; int ui = 0;
    if (!S.next(0, cur)) return;
    Acc acc;
#pragma unroll
    for (int a = 0; a < 2; ++a)
#pragma unroll
        for (int b = 0; b < 2; ++b)
#pragma unroll
            for (int m = 0; m < 4; ++m)
#pragma unroll
                for (int n = 0; n < 2; ++n) acc[a][b][m][n] = (f32x4){0.f, 0.f, 0.f, 0.f};
    bf16x8 At[4][2], B0[2][2], B1[2][2];
    const char* cA = (const char*)g.A + (size_t)cur.pm * tstep; const char* cB = (const char*)g.Bt + (size_t)cur.pn * tstep;
    S.a_ready(cur);
    PG8_STAGE(PG8_SB(0, 0), cB, voffB); PG8_STAGE(PG8_SB(0, 1), cB + hstep, voffB); PG8_STAGE(PG8_SA(0, 0), cA, voffA); PG8_STAGE(PG8_SA(0, 1), cA + hstep, voffA);
    if (wr == 1) PG8_BAR;
    PG8_WAIT_V(2); PG8_BAR;
    PG8_STAGE(PG8_SB(1, 0), cB + kstep, voffB); PG8_STAGE(PG8_SA(1, 0), cA + kstep, voffA); PG8_STAGE(PG8_SB(1, 1), cB + hstep + kstep, voffB);
    PG8_WAIT_V(6); PG8_BAR;
    for (;;) {
        const bool has_next = S.next(ui + 1, nxt);
        const char* nA = has_next ? (const char*)g.A + (size_t)nxt.pm * tstep : cA; const char* nB = has_next ? (const char*)g.Bt + (size_t)nxt.pn * tstep : cB;
        for (int t = 0; t < nt; t += 2) {
            if constexpr (Hook::ON) { if (t != 0 && (t & 7) == 0) H(acc, cur, t, wr, wc, fr, fq); }
            const bool last = (t == nt - 2);
            const char* a1 = cA + (size_t)(t + 1) * kstep;
            const char* a2 = last ? nA : cA + (size_t)(t + 2) * kstep; const char* b2 = last ? nB : cB + (size_t)(t + 2) * kstep;
            const char* a3 = a2 + kstep; const char* b3 = b2 + kstep;
            if (last && has_next) S.a_ready(nxt);
            PG8_LDB(B0, 0, 0); PG8_LDB(B1, 0, 1); PG8_SCHED; PG8_LDA(At, 0, 0); PG8_STAGE(PG8_SA(1, 1), a1 + hstep, voffA);
            PG8_WAIT_V(8); PG8_WAIT_L(0); PG8_BAR; PG8_MMA(0, 0, At, B0); PG8_MMA(0, 1, At, B1); PG8_BAR; PG8_SCHED;
            PG8_LDA(At, 0, 1); PG8_STAGE(PG8_SB(0, 0), b2, voffB); PG8_STAGE(PG8_SB(0, 1), b2 + hstep, voffB); PG8_STAGE(PG8_SA(0, 0), a2, voffA);
            PG8_WAIT_V(8); PG8_WAIT_L(0); PG8_BAR; PG8_MMA(1, 0, At, B0); PG8_MMA(1, 1, At, B1); PG8_BAR; PG8_SCHED;
            PG8_LDB(B0, 1, 0); PG8_LDB(B1, 1, 1); PG8_SCHED; PG8_LDA(At, 1, 0); PG8_STAGE(PG8_SA(0, 1), a2 + hstep, voffA);
            PG8_WAIT_V(8); PG8_WAIT_L(0); PG8_BAR; PG8_MMA(0, 0, At, B0); PG8_MMA(0, 1, At, B1); PG8_BAR; PG8_SCHED;
            PG8_LDA(At, 1, 1); PG8_STAGE(PG8_SB(1, 0), b3, voffB); PG8_STAGE(PG8_SB(1, 1), b3 + hstep, voffB); PG8_STAGE(PG8_SA(1, 0), a3, voffA);
            PG8_WAIT_V(8); PG8_WAIT_L(0); PG8_BAR; PG8_MMA(1, 0, At, B0); PG8_MMA(1, 1, At, B1); PG8_BAR; PG8_SCHED;
        }
        if (wr == 0) PG8_BAR;
        E(acc, cur, wr, wc, fr, fq); S.done(cur);
        if (!has_next) break;
#pragma unroll
        for (int a = 0; a < 2; ++a)
#pragma unroll
            for (int b = 0; b < 2; ++b)
#pragma unroll
                for (int m = 0; m < 4; ++m)
#pragma unroll
                    for (int n = 0; n < 2; ++n) acc[a][b][m][n] = (f32x4){0.f, 0.f, 0.f, 0.f};
        cur = nxt; cA = nA; cB = nB; ++ui;
        if (wr == 1) PG8_BAR;
    }
    PG8_WAIT_V(0);
    PG8_BAR;
#undef PG8_SA
#undef PG8_SB
#undef PG8_STAGE
#undef PG8_LDA
#undef PG8_LDB
#undef PG8_MMA
#undef PG8_WAIT_V
#undef PG8_WAIT_L
#undef PG8_BAR
#undef PG8_SCHED
}
}

#define XB_TMO      128
#define XB_XCNT(j)  (256  + 64 * (j))
#define XB_XSUB(j)  (1280 + 64 * (j))
#define XB_XGEN(j)  (2304 + 64 * (j))
#define XB_TOP      3328
#define XB_TOPGEN   3392
#define XCD_BAR_WORDS 3456
#define XB_SPIN_CAP (1u << 18)
__device__ __forceinline__ unsigned xb_ld(unsigned* p)              { return __hip_atomic_load(p, __ATOMIC_RELAXED, __HIP_MEMORY_SCOPE_AGENT); }
__device__ __forceinline__ unsigned xb_add(unsigned* p, unsigned v) { return __hip_atomic_fetch_add(p, v, __ATOMIC_RELAXED, __HIP_MEMORY_SCOPE_AGENT); }
__device__ __forceinline__ unsigned xb_xcc_id() { return (unsigned)__builtin_amdgcn_s_getreg((3 << 11) | 20) & 0xFu; }
#define XB_SPIN(cond, bar) do { unsigned _sp = 0; while (cond) { __builtin_amdgcn_s_sleep(1); \
    if ((++_sp & 255u) == 0u) { if (xb_ld(&(bar)[XB_TMO])) break; if (_sp > XB_SPIN_CAP) { atomicAdd(&(bar)[XB_TMO], 1u); break; } } } } while (0)
struct XcdBarrier { unsigned* bar; unsigned x; volatile LAS unsigned* st; };
__device__ __forceinline__ XcdBarrier xcd_barrier_post(unsigned* bar, volatile LAS unsigned* st) {
    XcdBarrier b; b.bar = bar; b.x = xb_xcc_id(); b.st = st;
    if (threadIdx.x == 0) (void)xb_add(&bar[XB_XCNT(b.x)], 1u);
    return b;
}
__device__ __forceinline__ void xcd_barrier_complete(unsigned* bar, unsigned x, unsigned& nloc, unsigned& nx) {
    const unsigned G = gridDim.x * gridDim.y * gridDim.z;
    unsigned sum, cnt, mine, sp = 0u;
    for (;;) {
        sum = 0u; cnt = 0u; mine = 0u;
#pragma unroll
        for (unsigned j = 0; j < 16; ++j) { const unsigned c = xb_ld(&bar[XB_XCNT(j)]); sum += c; cnt += (c > 0u) ? 1u : 0u; mine = (j == x) ? c : mine; }
        if (sum == G) break;
        __builtin_amdgcn_s_sleep(1);
        if ((++sp & 255u) == 0u) { if (xb_ld(&bar[XB_TMO])) break; if (sp > XB_SPIN_CAP) { atomicAdd(&bar[XB_TMO], 1u); break; } }
    }
    nloc = mine > 0u ? mine : 1u; nx = cnt > 0u ? cnt : 1u;
}
__device__ __forceinline__ void xcd_barrier(const XcdBarrier& b) {
    asm volatile("s_waitcnt vmcnt(0)" ::: "memory");
    __syncthreads();
    if (threadIdx.x == 0) {
        unsigned* bar = b.bar;
        __builtin_amdgcn_s_waitcnt(0);
        unsigned nloc = b.st[0], nx = b.st[1];
        if (nloc == 0u) { xcd_barrier_complete(bar, b.x, nloc, nx); b.st[0] = nloc; b.st[1] = nx; }
        const unsigned old = xb_add(&bar[XB_XSUB(b.x)], 1u);
        const unsigned gen = old / nloc;
        if (old + 1u == (gen + 1u) * nloc) {
            __builtin_amdgcn_fence(__ATOMIC_RELEASE, "agent");
            asm volatile("s_waitcnt vmcnt(0)" ::: "memory");
            const unsigned og = xb_add(&bar[XB_TOP], 1u);
            const unsigned tg = og / nx;
            if (og + 1u == (tg + 1u) * nx) xb_add(&bar[XB_TOPGEN], 1u);
            else XB_SPIN(xb_ld(&bar[XB_TOPGEN]) == tg, bar);
            __builtin_amdgcn_fence(__ATOMIC_ACQUIRE, "agent");
            xb_add(&bar[XB_XGEN(b.x)], 1u);
            asm volatile("s_waitcnt vmcnt(0)" ::: "memory");
        } else {
            XB_SPIN(xb_ld(&bar[XB_XGEN(b.x)]) == gen, bar);
            __builtin_amdgcn_fence(__ATOMIC_ACQUIRE, "agent");
            asm volatile("s_waitcnt vmcnt(0)" ::: "memory");
        }
    }
    __syncthreads();
}

__device__ __forceinline__ void transpose_item(const float* W, int ldw, int scol0, const float* gk, bf16_t* WT, int ldt, int drow0, int dk0, LAS float* scr, int kb, int nb, int lane) {
    const int k0 = 64 * kb, n0 = 32 * nb;
#pragma unroll 8
    for (int i = 0; i < 32; ++i) { const int kk = 2 * i + (lane >> 5); float v = W[(size_t)(k0 + kk) * ldw + scol0 + n0 + (lane & 31)]; if (gk) v *= gk[k0 + kk]; scr[kk * 33 + (lane & 31)] = v; }
    LDS_WAIT(); asm volatile("" ::: "memory");
    const int c = lane & 7;
#pragma unroll
    for (int j = 0; j < 4; ++j) { const int n = (lane >> 3) + 8 * j; const LAS float* s = scr + (8 * c) * 33 + n;
        u32x4 o; o.x = cvt_pk_bf16(s[0 * 33], s[1 * 33]); o.y = cvt_pk_bf16(s[2 * 33], s[3 * 33]); o.z = cvt_pk_bf16(s[4 * 33], s[5 * 33]); o.w = cvt_pk_bf16(s[6 * 33], s[7 * 33]);
        *(u32x4*)(WT + (size_t)(drow0 + n0 + n) * ldt + dk0 + k0 + 8 * c) = o; }
    LDS_WAIT(); asm volatile("" ::: "memory");
}

struct Args { const float* in[23]; float* out; unsigned char* ws; int ph_lo, ph_hi, li, pad; };

template <bool FORGET, bool FINAL>
__device__ __forceinline__ void norm_phase(const float* X, bf16_t* XN, const float* wfg, const float* fb, float* logf, const float* gfin, float* outf,
                                           LAS unsigned char* lds, int gw, int NGW, int lane, int tid) {
    if (FORGET) {
        LAS f32x4* w4 = (LAS f32x4*)lds;
        for (int i = tid; i < 8 * 2048 / 4; i += 512) w4[i] = ((const f32x4*)wfg)[i];
        __syncthreads();
    }
    for (int m0 = gw * 4; m0 < M; m0 += NGW * 4) {
        f32x4 v[4][8]; float rr[4];
#pragma unroll
        for (int r = 0; r < 4; ++r) { const GAS f32x4* xr = (const GAS f32x4*)(X + (size_t)(m0 + r) * DM) + lane;
#pragma unroll
            for (int j = 0; j < 8; ++j) v[r][j] = xr[64 * j]; }
#pragma unroll
        for (int r = 0; r < 4; ++r) { float s = 0.f;
#pragma unroll
            for (int j = 0; j < 8; ++j) s += (v[r][j].x * v[r][j].x + v[r][j].y * v[r][j].y) + (v[r][j].z * v[r][j].z + v[r][j].w * v[r][j].w);
            rr[r] = 1.0f / sqrtf(wave_sum(s) * (1.0f / DM) + EPS); }
        if (FINAL) {
#pragma unroll
            for (int r = 0; r < 4; ++r) { GAS f32x4* o = (GAS f32x4*)(outf + (size_t)(m0 + r) * DM) + lane;
#pragma unroll
                for (int j = 0; j < 8; ++j) { const f32x4 g = ((const GAS f32x4*)gfin)[64 * j + lane]; o[64 * j] = v[r][j] * rr[r] * g; } }
        } else {
#pragma unroll
            for (int r = 0; r < 4; ++r) { GAS u32x2* o = (GAS u32x2*)(XN + (size_t)(m0 + r) * DM) + lane;
#pragma unroll
                for (int j = 0; j < 8; ++j) { const f32x4 t = v[r][j] * rr[r]; u32x2 w; w.x = cvt_pk_bf16(t.x, t.y); w.y = cvt_pk_bf16(t.z, t.w); o[64 * j] = w; } }
        }
        if (FORGET) {
#pragma unroll 1
            for (int h = 0; h < 8; ++h) {
                float a0 = 0.f, a1 = 0.f, a2 = 0.f, a3 = 0.f;
#pragma unroll
                for (int j = 0; j < 8; ++j) { const f32x4 w = *((LAS f32x4*)lds + h * 512 + 64 * j + lane);
                    a0 += (v[0][j].x * w.x + v[0][j].y * w.y) + (v[0][j].z * w.z + v[0][j].w * w.w);
                    a1 += (v[1][j].x * w.x + v[1][j].y * w.y) + (v[1][j].z * w.z + v[1][j].w * w.w);
                    a2 += (v[2][j].x * w.x + v[2][j].y * w.y) + (v[2][j].z * w.z + v[2][j].w * w.w);
                    a3 += (v[3][j].x * w.x + v[3][j].y * w.y) + (v[3][j].z * w.z + v[3][j].w * w.w); }
                a0 = wave_sum(a0); a1 = wave_sum(a1); a2 = wave_sum(a2); a3 = wave_sum(a3);
                const float bh = fb[h];
                const float z = (lane == 0 ? a0 * rr[0] : lane == 1 ? a1 * rr[1] : lane == 2 ? a2 * rr[2] : a3 * rr[3]) + bh;
                const float ls = z >= 0.f ? -log1pf(expf(-z)) : z - log1pf(expf(z));
                if (lane < 4) logf[(size_t)(m0 + lane) * 8 + h] = ls;
            }
        }
    }
}

namespace att {
constexpr int LDS_K = 0, LDS_V = 8192, LDS_WS = 16384, LDS_SV = 32768, LDS_QW = 20480;
constexpr float NEG = -1e30f;
__device__ __forceinline__ int crow(int r, int hi) { return (r & 3) + 8 * (r >> 2) + 4 * hi; }
__device__ __forceinline__ s16x4 vtr(const LAS unsigned char* p) { return __builtin_bit_cast(s16x4, __builtin_amdgcn_ds_read_tr16_b64_v4i16((LAS s16x4*)p)); }
struct AttnArgs {
    const bf16_t *Q, *K, *V; long rs;
    int q0, kbase, jlo, jhi;
    const float* Fl;
    const float* rope; long rrs;
    bf16_t* Ob; float* Of; long ors;
    float* lse; long lrs;
};
__device__ __forceinline__ u32x4 rope8(u32x4 x1, u32x4 x2, const f32x4 c0, const f32x4 c1, const f32x4 s0, const f32x4 s1, bool first) {
    float a[8], b[8], c[8], s[8], o[8];
    a[0] = bf_lo(x1.x); a[1] = bf_hi(x1.x); a[2] = bf_lo(x1.y); a[3] = bf_hi(x1.y); a[4] = bf_lo(x1.z); a[5] = bf_hi(x1.z); a[6] = bf_lo(x1.w); a[7] = bf_hi(x1.w);
    b[0] = bf_lo(x2.x); b[1] = bf_hi(x2.x); b[2] = bf_lo(x2.y); b[3] = bf_hi(x2.y); b[4] = bf_lo(x2.z); b[5] = bf_hi(x2.z); b[6] = bf_lo(x2.w); b[7] = bf_hi(x2.w);
#pragma unroll
    for (int e = 0; e < 4; ++e) { c[e] = c0[e]; c[4 + e] = c1[e]; s[e] = s0[e]; s[4 + e] = s1[e]; }
#pragma unroll
    for (int e = 0; e < 8; ++e) o[e] = first ? (a[e] * c[e] - b[e] * s[e]) : (a[e] * s[e] + b[e] * c[e]);
    u32x4 w; w.x = cvt_pk_bf16(o[0], o[1]); w.y = cvt_pk_bf16(o[2], o[3]); w.z = cvt_pk_bf16(o[4], o[5]); w.w = cvt_pk_bf16(o[6], o[7]); return w;
}
template <int MODE>
__device__ __forceinline__ void attn_unit(LAS unsigned char* lds, const AttnArgs& A) {
    int tid = threadIdx.x; asm volatile("" : "+v"(tid));
    const int lane = tid & 63, wv = __builtin_amdgcn_readfirstlane(tid >> 6), r32 = lane & 31, hi = lane >> 5;
    LAS float* wsf = (LAS float*)(lds + LDS_WS) + wv * 64;
    const int qi = A.q0 + 32 * wv + r32;
    bf16x8 qr[4];
    { const bf16_t* qrow = A.Q + (long)qi * A.rs;
#pragma unroll
      for (int d0 = 0; d0 < 4; ++d0) qr[d0] = *(const bf16x8*)(qrow + d0 * 16 + hi * 8); }
    if (MODE == 1) {
        const float* rp = A.rope + (long)qi * A.rrs;
        const f32x4 c0 = *(const f32x4*)(rp), c1 = *(const f32x4*)(rp + 4), s0 = *(const f32x4*)(rp + 8), s1 = *(const f32x4*)(rp + 12);
        const u32x4 me = __builtin_bit_cast(u32x4, qr[0]); u32x4 x1, x2;
#pragma unroll
        for (int e = 0; e < 4; ++e) { auto rr = __builtin_amdgcn_permlane32_swap(me[e], me[e], false, false); x1[e] = rr[0]; x2[e] = rr[1]; }
        qr[0] = __builtin_bit_cast(bf16x8, rope8(x1, x2, c0, c1, s0, s1, hi == 0));
    }
    const float flq = (MODE == 0) ? A.Fl[qi] : 0.f;
    float m = NEG, l = 0.f; f32x16 o0, o1;
#pragma unroll
    for (int r = 0; r < 16; ++r) { o0[r] = 0.f; o1[r] = 0.f; }
    const int qw0 = A.q0 + 32 * wv;
    int wlo = A.jlo; const int whi = (qw0 + 31 - A.kbase) >> 6;
    if (MODE == 1) { const int f = (qw0 - 128 - A.kbase) >> 6; wlo = f > wlo ? f : wlo; }
    const int krow = 8 * wv + (lane & 7), kch = lane >> 3, vrow = 8 * wv + (lane >> 3), vch = lane & 7;
    LAS u32x4* kdst = (LAS u32x4*)(lds + LDS_K + kch * 1024 + krow * 16);
    LAS u32x4* vdst = (LAS u32x4*)(lds + LDS_V + (vch >> 2) * 4096 + vrow * 64 + (vch & 3) * 16);
    u32x4 kreg, vreg; f32x4 rc0, rc1, rs0, rs1;
    rc0 = rc1 = rs0 = rs1 = (f32x4){0.f, 0.f, 0.f, 0.f};
#define ATT_LOAD(j) do { const long ks_ = (long)A.kbase + 64 * (j); \
        kreg = *(const u32x4*)(A.K + (ks_ + krow) * A.rs + kch * 8); vreg = *(const u32x4*)(A.V + (ks_ + vrow) * A.rs + vch * 8); \
        if (MODE == 1) { if (kch < 2) { const float* rp_ = A.rope + (ks_ + krow) * A.rrs; rc0 = *(const f32x4*)(rp_); rc1 = *(const f32x4*)(rp_ + 4); rs0 = *(const f32x4*)(rp_ + 8); rs1 = *(const f32x4*)(rp_ + 12); } } } while (0)
    ATT_LOAD(A.jlo);
    for (int j = A.jlo; j < A.jhi; ++j) {
        asm volatile("s_barrier" ::: "memory");
        if (MODE == 1) {
            u32x4 oth;
#pragma unroll
            for (int e = 0; e < 4; ++e) oth[e] = (unsigned)__shfl_xor((int)kreg[e], 8);
            if (kch < 2) kreg = (kch == 0) ? rope8(kreg, oth, rc0, rc1, rs0, rs1, true) : rope8(oth, kreg, rc0, rc1, rs0, rs1, false);
        }
        *kdst = kreg; *vdst = vreg;
        if (j + 1 < A.jhi) ATT_LOAD(j + 1);
        BAR_L();
        if (j >= wlo && j <= whi) {
            const int ks = A.kbase + 64 * j;
            f32x16 p0, p1;
            if (MODE == 0) { const float* fk = A.Fl + ks + 4 * hi;
#pragma unroll
                for (int g4 = 0; g4 < 4; ++g4) { const f32x4 a = *(const f32x4*)(fk + 8 * g4), b = *(const f32x4*)(fk + 32 + 8 * g4);
#pragma unroll
                    for (int e = 0; e < 4; ++e) { p0[4 * g4 + e] = flq - a[e]; p1[4 * g4 + e] = flq - b[e]; } }
            } else {
#pragma unroll
                for (int r = 0; r < 16; ++r) { p0[r] = 0.f; p1[r] = 0.f; } }
            { const LAS unsigned char* kb = lds + LDS_K + hi * 1024 + r32 * 16;
#pragma unroll
              for (int d0 = 0; d0 < 4; ++d0) { const bf16x8 b0 = *(const LAS bf16x8*)(kb + d0 * 2048), b1 = *(const LAS bf16x8*)(kb + d0 * 2048 + 512);
                  p0 = __builtin_amdgcn_mfma_f32_32x32x16_bf16(b0, qr[d0], p0, 0, 0, 0); p1 = __builtin_amdgcn_mfma_f32_32x32x16_bf16(b1, qr[d0], p1, 0, 0, 0); } }
            if (MODE == 0) {
                if (ks + 63 > qw0) {
#pragma unroll
                    for (int r = 0; r < 16; ++r) { const int kv = ks + crow(r, hi); if (kv > qi) p0[r] = NEG; if (kv + 32 > qi) p1[r] = NEG; } }
            } else {
#pragma unroll
                for (int r = 0; r < 16; ++r) { const int d = qi - (ks + crow(r, hi)); if (d < 0 || d > 128) p0[r] = NEG; if (d - 32 < 0 || d - 32 > 128) p1[r] = NEG; }
            }
            float rm = fmaxf(p0[0], p1[0]);
#pragma unroll
            for (int r = 1; r < 16; ++r) rm = fmaxf(rm, fmaxf(p0[r], p1[r]));
            { auto rr = __builtin_amdgcn_permlane32_swap(__float_as_uint(rm), __float_as_uint(rm), false, false); rm = fmaxf(__uint_as_float(rr[0]), __uint_as_float(rr[1])); }
            const float mn = fmaxf(m, rm), f = fast_exp2(m - mn); m = mn;
            float ps = 0.f;
#pragma unroll
            for (int r = 0; r < 16; ++r) { p0[r] = fast_exp2(p0[r] - mn); p1[r] = fast_exp2(p1[r] - mn); ps += p0[r] + p1[r]; }
            l = l * f + ps;
            if (hi == 0) wsf[r32] = f;
            f32x4 fr[4];
#pragma unroll
            for (int g4 = 0; g4 < 4; ++g4) fr[g4] = *(const LAS f32x4*)(wsf + 8 * g4 + 4 * hi);
#pragma unroll
            for (int r = 0; r < 16; ++r) { o0[r] *= fr[r >> 2][r & 3]; o1[r] *= fr[r >> 2][r & 3]; }
            u32x4 pw[4];
#pragma unroll
            for (int e = 0; e < 4; ++e) { pw[0][e] = cvt_pk_bf16(p0[2 * e], p0[2 * e + 1]); pw[1][e] = cvt_pk_bf16(p0[8 + 2 * e], p0[9 + 2 * e]);
                                          pw[2][e] = cvt_pk_bf16(p1[2 * e], p1[2 * e + 1]); pw[3][e] = cvt_pk_bf16(p1[8 + 2 * e], p1[9 + 2 * e]); }
            const LAS unsigned char* vp = lds + LDS_V + ((lane >> 4) & 1) * 32 + (lane & 3) * 8 + (4 * hi + ((lane & 15) >> 2)) * 64;
#pragma unroll
            for (int k4 = 0; k4 < 4; ++k4) {
                const s16x4 a0 = vtr(vp + k4 * 1024), a1 = vtr(vp + k4 * 1024 + 512), b0 = vtr(vp + 4096 + k4 * 1024), b1 = vtr(vp + 4096 + k4 * 1024 + 512);
                const bf16x8 v0 = (bf16x8){a0[0], a0[1], a0[2], a0[3], a1[0], a1[1], a1[2], a1[3]}, v1 = (bf16x8){b0[0], b0[1], b0[2], b0[3], b1[0], b1[1], b1[2], b1[3]};
                o0 = __builtin_amdgcn_mfma_f32_32x32x16_bf16(__builtin_bit_cast(bf16x8, pw[k4]), v0, o0, 0, 0, 0);
                o1 = __builtin_amdgcn_mfma_f32_32x32x16_bf16(__builtin_bit_cast(bf16x8, pw[k4]), v1, o1, 0, 0, 0);
            }
        }
    }
#undef ATT_LOAD
    { auto rr = __builtin_amdgcn_permlane32_swap(__float_as_uint(l), __float_as_uint(l), false, false); l = __uint_as_float(rr[0]) + __uint_as_float(rr[1]); }
    if (hi == 0) wsf[r32] = 1.0f / l;
    f32x4 fr[4];
#pragma unroll
    for (int g4 = 0; g4 < 4; ++g4) fr[g4] = *(const LAS f32x4*)(wsf + 8 * g4 + 4 * hi);
#pragma unroll
    for (int r = 0; r < 16; ++r) { const long row = (long)(qw0 + crow(r, hi)) * A.ors; const float s = fr[r >> 2][r & 3];
        if (MODE == 0) { A.Ob[row + r32] = (bf16_t)(cvt_pk_bf16(o0[r] * s, 0.f) & 0xffffu); A.Ob[row + 32 + r32] = (bf16_t)(cvt_pk_bf16(o1[r] * s, 0.f) & 0xffffu); }
        else { A.Of[row + r32] = o0[r] * s; A.Of[row + 32 + r32] = o1[r] * s; } }
    if (MODE == 1) { if (hi == 0) A.lse[(long)qi * A.lrs] = m + log2f(l); }
}
}

constexpr int NPH_PRO = 2, NPH_LAYER = 12, NPHASE = NPH_PRO + DEPTH * NPH_LAYER;
constexpr int TR_ITEMS = 37632;
constexpr int MIX_FOX = 256, MIX_DIL = 384, MIX_SGU = 256, MIX_CONV = 256, MIX_UNITS = MIX_FOX + MIX_DIL + MIX_SGU + MIX_CONV;
__constant__ double c_rope_inv[8] = {1.0, 0.19392274474868576, 0.03760603093086393, 0.007292664737217109, 0.001414213562373095, 0.0002742481756762073, 5.318295896944988e-05, 1.031338537721246e-05};

__device__ __forceinline__ void sincos_d(double x, float& sn, float& cs) {
    const double q = rint(x * 0.63661977236758134308);
    const double r = (x - q * 1.57079632679489655800e+00) - q * 6.12323399573676603587e-17;
    const int qi = ((int)q) & 3;
    const double r2 = r * r;
    double s = r * (1.0 + r2 * (-1.0 / 6 + r2 * (1.0 / 120 + r2 * (-1.0 / 5040 + r2 * (1.0 / 362880 + r2 * (-1.0 / 39916800 + r2 * (1.0 / 6227020800.0)))))));
    double c = 1.0 + r2 * (-0.5 + r2 * (1.0 / 24 + r2 * (-1.0 / 720 + r2 * (1.0 / 40320 + r2 * (-1.0 / 3628800 + r2 * (1.0 / 479001600.0 + r2 * (-1.0 / 87178291200.0)))))));
    double so = (qi == 0) ? s : (qi == 1) ? c : (qi == 2) ? -s : -c;
    double co = (qi == 0) ? c : (qi == 1) ? -s : (qi == 2) ? -c : s;
    sn = (float)so; cs = (float)co;
}

__global__ void __launch_bounds__(512, 2) mk_fwd(Args args) {
    extern __shared__ __attribute__((aligned(16))) unsigned char lds_raw[];
    LAS unsigned char* lds = (LAS unsigned char*)lds_raw;
    volatile LAS unsigned* MISC = (volatile LAS unsigned*)(lds + MISC_OFF);
    const int tid0 = threadIdx.x;
    const int G = gridDim.x, bx = blockIdx.x, NGW = G * 8;
#define ws (args.ws)
    unsigned* ctl = (unsigned*)(ws + WS_CTL);
    for (int u = tid0; u < (LDS_BYTES - RING_BYTES) / 4; u += 512) ((LAS unsigned*)(lds + RING_BYTES))[u] = 0u;
    __syncthreads();
    XcdBarrier bar = xcd_barrier_post(ctl + CW_BAR + args.li * XCD_BAR_WORDS, MISC + 8);
    const int lo = args.ph_lo, hi = args.ph_hi;
#define IN(k) (lo <= (k) && (k) < hi)
#define SEAM(k) do { if (IN(k) && IN((k) + 1)) xcd_barrier(bar); } while (0)
#define x_in (args.in[0])
#define p_in (args.in[1])
#define pos_in ((const int*)args.in[2])
#define norm_mix_g (args.in[3])
#define w_in (args.in[4])
#define fox_b (args.in[5])
#define scw (args.in[6])
#define sgu_g (args.in[7])
#define sgu_w (args.in[8])
#define sgu_b (args.in[9])
#define w_br_fox (args.in[10])
#define w_br_conv (args.in[11])
#define w_br_sgu (args.in[12])
#define w_br_dil (args.in[13])
#define w_out (args.in[14])
#define norm_ffn_g (args.in[15])
#define w_up (args.in[16])
#define ffn_cw (args.in[17])
#define w_down (args.in[18])
#define norm_ple_g (args.in[19])
#define w_pg (args.in[20])
#define w_pe (args.in[21])
#define final_g (args.in[22])
#define X (args.out)
#define WFG ((float*)(ws + WS_SMALL + SM_WFG))
#define SGUW ((bf16_t*)(ws + WS_SMALL + SM_SGUW))
#define ROPE ((float*)(ws + WS_SMALL + SM_ROPE))
#define LOGF ((float*)(ws + WS_SMALL + SM_LOGF))
#define FL ((float*)(ws + WS_SMALL + SM_FL))
#define LSE ((float*)(ws + WS_SMALL + SM_LSE))
#define PB ((bf16_t*)(ws + WS_PB))
#define PP ((bf16_t*)(ws + WS_PP))
#define XN ((bf16_t*)(ws + WS_XN))
#define PROJ ((bf16_t*)(ws + WS_PROJ))
#define UP ((bf16_t*)(ws + WS_PROJ))
#define HID ((bf16_t*)(ws + WS_HID))
#define OCAT ((bf16_t*)(ws + WS_OCAT))
#define MG ((bf16_t*)(ws + WS_MG))
#define ODIL ((float*)(ws + WS_ODIL))

    if (IN(0)) {
        const int tid = tid0, lane = tid & 63, wave = __builtin_amdgcn_readfirstlane(tid >> 6), gw = bx * 8 + wave;
        LAS float* scr = (LAS float*)(lds + wave * 16384);
        for (int it = gw; it < DEPTH * TR_ITEMS; it += NGW) {
            const int L = it / TR_ITEMS; int r = it % TR_ITEMS;
            unsigned char* wl = ws + WS_WL + (size_t)L * WL_STRIDE;
            const float* win = w_in + (size_t)L * DM * DIN_SRC;
            if (r < 1536) { transpose_item(win, DIN_SRC, 0, norm_mix_g + L * DM, (bf16_t*)(wl + WL_IN), DM, 0, 0, scr, r / 48, r % 48, lane); continue; } r -= 1536;
            if (r < 13056) { transpose_item(win, DIN_SRC, 1544, norm_mix_g + L * DM, (bf16_t*)(wl + WL_IN), DM, 1536, 0, scr, r / 408, r % 408, lane); continue; } r -= 13056;
            if (r < 512) { transpose_item(w_br_fox + (size_t)L * 512 * DM, DM, 0, nullptr, (bf16_t*)(wl + WL_BR), OC_W, 0, OC_A, scr, r / 64, r % 64, lane); continue; } r -= 512;
            if (r < 512) { transpose_item(w_br_conv + (size_t)L * 512 * DM, DM, 0, nullptr, (bf16_t*)(wl + WL_BR), OC_W, 0, OC_B, scr, r / 64, r % 64, lane); continue; } r -= 512;
            if (r < 512) { transpose_item(w_br_sgu + (size_t)L * 512 * DM, DM, 0, nullptr, (bf16_t*)(wl + WL_BR), OC_W, 0, OC_C, scr, r / 64, r % 64, lane); continue; } r -= 512;
            if (r < 256) { transpose_item(w_br_dil + (size_t)L * 256 * DM, DM, 0, nullptr, (bf16_t*)(wl + WL_BR), OC_W, 0, OC_D, scr, r / 64, r % 64, lane); continue; } r -= 256;
            if (r < 2048) { transpose_item(w_out + (size_t)L * DM * DM, DM, 0, nullptr, (bf16_t*)(wl + WL_OUT), DM, 0, 0, scr, r / 64, r % 64, lane); continue; } r -= 2048;
            if (r < 11264) { transpose_item(w_up + (size_t)L * DM * 2 * DFF, 2 * DFF, 0, norm_ffn_g + L * DM, (bf16_t*)(wl + WL_UP), DM, 0, 0, scr, r / 352, r % 352, lane); continue; } r -= 11264;
            if (r < 5632) { transpose_item(w_down + (size_t)L * DFF * DM, DM, 0, nullptr, (bf16_t*)(wl + WL_DN), DFF, 0, 0, scr, r / 64, r % 64, lane); continue; } r -= 5632;
            if (r < 2048) { transpose_item(w_pg + (size_t)L * DM * DM, DM, 0, norm_ple_g + L * DM, (bf16_t*)(wl + WL_PG), DM, 0, 0, scr, r / 64, r % 64, lane); continue; } r -= 2048;
            transpose_item(w_pe + (size_t)L * PLE * DM, DM, 0, nullptr, (bf16_t*)(wl + WL_PE), PLE, 0, 0, scr, r / 64, r % 64, lane);
        }
        const int gt = bx * 512 + tid, NGT = G * 512;
        for (int i = gt; i < DEPTH * 8 * DM; i += NGT) { const int L = i / (8 * DM), h = (i / DM) % 8, k = i % DM;
            WFG[i] = norm_mix_g[L * DM + k] * w_in[(size_t)L * DM * DIN_SRC + (size_t)k * DIN_SRC + 1536 + h]; }
        for (int i = gt; i < DEPTH * 4 * 128 * 128; i += NGT) { const int t = (i >> 7) & 127, s = i & 127; SGUW[i] = (s <= t) ? (bf16_t)(cvt_pk_bf16(sgu_w[i], 0.f) & 0xffffu) : (bf16_t)0; }
        for (int i = gt; i < M * 8; i += NGT) { const int row = i >> 3, jj = i & 7; float sn, cs; sincos_d((double)pos_in[row] * c_rope_inv[jj], sn, cs); ROPE[row * 16 + jj] = cs; ROPE[row * 16 + 8 + jj] = sn; }
        for (int i = gt; i < DEPTH * M * PLE / 8; i += NGT) { const f32x4 a = ((const f32x4*)p_in)[2 * i], b = ((const f32x4*)p_in)[2 * i + 1];
            u32x4 w; w.x = cvt_pk_bf16(a.x, a.y); w.y = cvt_pk_bf16(a.z, a.w); w.z = cvt_pk_bf16(b.x, b.y); w.w = cvt_pk_bf16(b.z, b.w); ((u32x4*)PB)[i] = w; }
    }
    SEAM(0);
    if (IN(1)) {
        const int tid = tid0, lane = tid & 63, wave = __builtin_amdgcn_readfirstlane(tid >> 6), gw = bx * 8 + wave;
        for (int L = 0; L < DEPTH; ++L) {
            pg8::Gemm g{PB + (size_t)L * M * PLE, (const bf16_t*)(ws + WS_WL + (size_t)L * WL_STRIDE + WL_PE), M, DM, PLE}; pg8::StaticOrder S; S.init(M, DM, G, bx);
            pg8::EpiPlain E{PP + (size_t)L * M * DM, DM};
            pg8::gemm_phase(lds, g, S, E, pg8::NoHook{});
        }
        __syncthreads();
        norm_phase<true, false>(x_in, XN, WFG, fox_b, LOGF, nullptr, nullptr, lds, gw, NGW, lane, tid);
    }
    SEAM(1);

    for (int L = 0; L < DEPTH; ++L) {
        int tid = tid0; asm volatile("" : "+v"(tid));
        const int lane = tid & 63, wave = __builtin_amdgcn_readfirstlane(tid >> 6), gw = bx * 8 + wave;
        const int pb = NPH_PRO + L * NPH_LAYER;
        unsigned char* wl = ws + WS_WL + (size_t)L * WL_STRIDE;
        const float* xres = (L == 0) ? x_in : X;
        if (IN(pb + 0)) {
            if (bx >= 32 && bx < 48 && G >= 48) {
                const int seq = bx - 32, b = seq >> 3, h = seq & 7; float v[8], run = 0.f;
#pragma unroll
                for (int e = 0; e < 8; ++e) { run += LOGF[(size_t)(b * SEQ + tid * 8 + e) * 8 + h]; v[e] = run; }
                float inc = run;
#pragma unroll
                for (int o = 1; o < 64; o <<= 1) { const float t = __shfl_up(inc, o); if (lane >= o) inc += t; }
                LAS float* wt = (LAS float*)lds;
                if (lane == 63) wt[wave] = inc;
                __syncthreads();
                float base = inc - run;
                for (int w = 0; w < wave; ++w) base += wt[w];
#pragma unroll
                for (int e = 0; e < 8; ++e) FL[seq * SEQ + tid * 8 + e] = (base + v[e]) * LOG2E;
                __syncthreads();
            }
            pg8::Gemm g{XN, (const bf16_t*)(wl + WL_IN), M, DIN, DM}; pg8::StaticOrder S; S.init(M, DIN, G, bx);
            pg8::EpiProj E{PROJ, DIN};
            pg8::gemm_phase(lds, g, S, E, pg8::NoHook{});
        }
        SEAM(pb + 0);
        if (IN(pb + 1)) {
            unsigned* qhead = ctl + CW_Q + 64 * L;
            for (;;) {
                __syncthreads();
                if (tid == 0) *(volatile LAS unsigned*)(lds + att::LDS_QW) = __hip_atomic_fetch_add(qhead, 1u, __ATOMIC_RELAXED, __HIP_MEMORY_SCOPE_AGENT);
                __syncthreads();
                int u = (int)*(volatile LAS unsigned*)(lds + att::LDS_QW);
                if (u >= MIX_UNITS) break;
                if (u < MIX_FOX) {
                    const int qb = 15 - (u >> 4), bh = u & 15, b = bh >> 3, h = bh & 7;
                    att::AttnArgs A; const size_t r0 = (size_t)b * SEQ * DIN;
                    A.Q = PROJ + r0 + PC_AQ + h * 64; A.K = PROJ + r0 + PC_AK + h * 64; A.V = PROJ + r0 + PC_AV + h * 64; A.rs = DIN;
                    A.q0 = qb * 256; A.kbase = 0; A.jlo = 0; A.jhi = 4 * (qb + 1); A.Fl = FL + bh * SEQ; A.rope = nullptr; A.rrs = 0;
                    A.Ob = OCAT + (size_t)b * SEQ * OC_W + OC_A + h * 64; A.Of = nullptr; A.ors = OC_W; A.lse = nullptr; A.lrs = 0;
                    att::attn_unit<0>(lds, A);
                } else if (u < MIX_FOX + MIX_DIL) {
                    u -= MIX_FOX; const int grp = u >> 7, v = u & 127; const int sh = 2 * grp, dil = 1 << sh;
                    const int nqb = 16 >> sh; const int qb = v % nqb; int t = v / nqb; const int slot = t & 3; t >>= 2; const int res = t % dil; const int b = t / dil;
                    const int head = grp * 4 + slot; const size_t row0 = (size_t)b * SEQ + res;
                    att::AttnArgs A;
                    A.Q = PROJ + row0 * DIN + PC_DQ + head * 64; A.K = PROJ + row0 * DIN + PC_DK + head * 64; A.V = PROJ + row0 * DIN + PC_DV + head * 64; A.rs = (long)DIN * dil;
                    A.q0 = qb * 256; A.kbase = qb * 256 - 128; A.jlo = (qb == 0) ? 2 : 0; A.jhi = 6; A.Fl = nullptr; A.rope = ROPE + row0 * 16; A.rrs = 16L * dil;
                    A.Ob = nullptr; A.Of = ODIL + ((size_t)grp * M + row0) * 256 + slot * 64; A.ors = 256L * dil; A.lse = LSE + ((size_t)grp * M + row0) * 4 + slot; A.lrs = 4L * dil;
                    att::attn_unit<1>(lds, A);
                } else if (u < MIX_FOX + MIX_DIL + MIX_SGU) {
                    u -= MIX_FOX + MIX_DIL; const int g = u & 3, c = (u >> 2) & 31, b = u >> 7; const size_t row0 = (size_t)b * SEQ + c * 128;
                    const int row = tid >> 2, part = tid & 3;
                    const bf16_t* vrow = PROJ + (row0 + row) * DIN + PC_SV;
                    float ss = 0.f;
#pragma unroll
                    for (int i = 0; i < 16; ++i) { const u32x4 w = *(const u32x4*)(vrow + part * 128 + 8 * i);
                        ss += (bf_lo(w.x) * bf_lo(w.x) + bf_hi(w.x) * bf_hi(w.x)) + (bf_lo(w.y) * bf_lo(w.y) + bf_hi(w.y) * bf_hi(w.y)) + (bf_lo(w.z) * bf_lo(w.z) + bf_hi(w.z) * bf_hi(w.z)) + (bf_lo(w.w) * bf_lo(w.w) + bf_hi(w.w) * bf_hi(w.w)); }
                    ss += __shfl_xor(ss, 1); ss += __shfl_xor(ss, 2);
                    const float rinv = 1.0f / sqrtf(ss * (1.0f / 512.0f) + EPS);
                    const float* gsn = sgu_g + L * 512 + 128 * g + 32 * part;
#pragma unroll
                    for (int i = 0; i < 4; ++i) { const u32x4 w = *(const u32x4*)(vrow + 128 * g + 32 * part + 8 * i); const f32x4 ga = *(const f32x4*)(gsn + 8 * i), gb = *(const f32x4*)(gsn + 8 * i + 4);
                        u32x4 o; o.x = cvt_pk_bf16(bf_lo(w.x) * rinv * ga.x, bf_hi(w.x) * rinv * ga.y); o.y = cvt_pk_bf16(bf_lo(w.y) * rinv * ga.z, bf_hi(w.y) * rinv * ga.w);
                        o.z = cvt_pk_bf16(bf_lo(w.z) * rinv * gb.x, bf_hi(w.z) * rinv * gb.y); o.w = cvt_pk_bf16(bf_lo(w.w) * rinv * gb.z, bf_hi(w.w) * rinv * gb.w);
                        *(LAS u32x4*)(lds + att::LDS_SV + part * 8192 + row * 64 + i * 16) = o; }
                    BAR_L();
                    const int r32 = lane & 31, hh = lane >> 5, tb = wave & 3, dp = wave >> 2;
                    f32x16 o0, o1;
#pragma unroll
                    for (int r = 0; r < 16; ++r) { o0[r] = 0.f; o1[r] = 0.f; }
                    const bf16_t* wrow = SGUW + ((size_t)(L * 4 + g) * 128 + 32 * tb + r32) * 128 + 8 * hh;
                    const LAS unsigned char* vp = lds + att::LDS_SV + (2 * dp) * 8192 + ((lane >> 4) & 1) * 32 + (lane & 3) * 8 + (8 * hh + ((lane & 15) >> 2)) * 64;
                    for (int i = 0; i < 2 * tb + 2; ++i) {
                        const bf16x8 a = *(const bf16x8*)(wrow + 16 * i);
                        const s16x4 a0 = att::vtr(vp + i * 1024), a1 = att::vtr(vp + i * 1024 + 256), b0 = att::vtr(vp + 8192 + i * 1024), b1 = att::vtr(vp + 8192 + i * 1024 + 256);
                        const bf16x8 v0 = (bf16x8){a0[0], a0[1], a0[2], a0[3], a1[0], a1[1], a1[2], a1[3]}, v1 = (bf16x8){b0[0], b0[1], b0[2], b0[3], b1[0], b1[1], b1[2], b1[3]};
                        o0 = __builtin_amdgcn_mfma_f32_32x32x16_bf16(a, v0, o0, 0, 0, 0); o1 = __builtin_amdgcn_mfma_f32_32x32x16_bf16(a, v1, o1, 0, 0, 0);
                    }
#pragma unroll
                    for (int r = 0; r < 16; ++r) { const int t = 32 * tb + att::crow(r, hh); const size_t gr = row0 + t; const float bias = sgu_b[(L * 4 + g) * 128 + t];
                        const int d = 128 * g + 64 * dp + r32;
                        const float u0 = bf1(PROJ[gr * DIN + PC_SU + d]), u1 = bf1(PROJ[gr * DIN + PC_SU + d + 32]);
                        OCAT[gr * OC_W + OC_C + d] = (bf16_t)(cvt_pk_bf16(u0 * (o0[r] + bias), 0.f) & 0xffffu); OCAT[gr * OC_W + OC_C + d + 32] = (bf16_t)(cvt_pk_bf16(u1 * (o1[r] + bias), 0.f) & 0xffffu); }
                } else {
                    u -= MIX_FOX + MIX_DIL + MIX_SGU;
                    for (int it = 0; it < 4; ++it) { const int idx = tid + 512 * it, row = 32 * u + (idx >> 6), c = (idx & 63) * 8, t = row & (SEQ - 1);
                        const bf16_t* pr = PROJ + (size_t)row * DIN; float y[3][8];
#pragma unroll
                        for (int k = 0; k < 3; ++k) { const int dt = 2 - k;
                            if (t - dt >= 0) { const u32x4 a = *(const u32x4*)(pr - (size_t)dt * DIN + PC_XB + c), g2 = *(const u32x4*)(pr - (size_t)dt * DIN + PC_GC + c);
                                y[k][0] = bf_lo(a.x) * bf_lo(g2.x); y[k][1] = bf_hi(a.x) * bf_hi(g2.x); y[k][2] = bf_lo(a.y) * bf_lo(g2.y); y[k][3] = bf_hi(a.y) * bf_hi(g2.y);
                                y[k][4] = bf_lo(a.z) * bf_lo(g2.z); y[k][5] = bf_hi(a.z) * bf_hi(g2.z); y[k][6] = bf_lo(a.w) * bf_lo(g2.w); y[k][7] = bf_hi(a.w) * bf_hi(g2.w); }
                            else {
#pragma unroll
                                for (int e = 0; e < 8; ++e) y[k][e] = 0.f; } }
                        const u32x4 gb = *(const u32x4*)(pr + PC_GB + c); float gbf[8] = {bf_lo(gb.x), bf_hi(gb.x), bf_lo(gb.y), bf_hi(gb.y), bf_lo(gb.z), bf_hi(gb.z), bf_lo(gb.w), bf_hi(gb.w)};
                        const float* wk = scw + (size_t)L * 3 * 512 + c; float o[8];
#pragma unroll
                        for (int e = 0; e < 8; ++e) o[e] = gbf[e] * (wk[e] * y[0][e] + wk[512 + e] * y[1][e] + wk[1024 + e] * y[2][e]);
                        u32x4 w; w.x = cvt_pk_bf16(o[0], o[1]); w.y = cvt_pk_bf16(o[2], o[3]); w.z = cvt_pk_bf16(o[4], o[5]); w.w = cvt_pk_bf16(o[6], o[7]);
                        *(u32x4*)(OCAT + (size_t)row * OC_W + OC_B + c) = w; }
                }
            }
            __syncthreads();
        }
        SEAM(pb + 1);
        if (IN(pb + 2)) {
            for (int i = bx * 512 + tid; i < M * 4 * 8; i += G * 512) { const int d8 = i & 7, slot = (i >> 3) & 3, row = i >> 5;
                float l2[3], mx = -3.0e38f;
#pragma unroll
                for (int g = 0; g < 3; ++g) { l2[g] = LSE[((size_t)g * M + row) * 4 + slot]; mx = fmaxf(mx, l2[g]); }
                float wsum = 0.f, o[8];
#pragma unroll
                for (int e = 0; e < 8; ++e) o[e] = 0.f;
#pragma unroll
                for (int g = 0; g < 3; ++g) { const float w = fast_exp2(l2[g] - mx); wsum += w; const float* od = ODIL + ((size_t)g * M + row) * 256 + slot * 64 + d8 * 8;
                    const f32x4 a = *(const f32x4*)od, b = *(const f32x4*)(od + 4); o[0] += w * a.x; o[1] += w * a.y; o[2] += w * a.z; o[3] += w * a.w; o[4] += w * b.x; o[5] += w * b.y; o[6] += w * b.z; o[7] += w * b.w; }
                const float inv = 1.0f / wsum; u32x4 w; w.x = cvt_pk_bf16(o[0] * inv, o[1] * inv); w.y = cvt_pk_bf16(o[2] * inv, o[3] * inv); w.z = cvt_pk_bf16(o[4] * inv, o[5] * inv); w.w = cvt_pk_bf16(o[6] * inv, o[7] * inv);
                *(u32x4*)(OCAT + (size_t)row * OC_W + OC_D + slot * 64 + d8 * 8) = w; }
        }
        SEAM(pb + 2);
        if (IN(pb + 3)) {
            pg8::Gemm g{OCAT, (const bf16_t*)(wl + WL_BR), M, DM, OC_W}; pg8::StaticOrder S; S.init(M, DM, G, bx);
            pg8::EpiMerge E{MG, DM, PROJ + PC_G + 3 * 2048}; pg8::MergeHook H{PROJ + PC_G};
            pg8::gemm_phase(lds, g, S, E, H);
        }
        SEAM(pb + 3);
        if (IN(pb + 4)) {
            pg8::Gemm g{MG, (const bf16_t*)(wl + WL_OUT), M, DM, DM}; pg8::StaticOrder S; S.init(M, DM, G, bx);
            pg8::EpiResid E{xres, X, DM};
            pg8::gemm_phase(lds, g, S, E, pg8::NoHook{});
        }
        SEAM(pb + 4);
        if (IN(pb + 5)) norm_phase<false, false>(X, XN, nullptr, nullptr, nullptr, nullptr, nullptr, lds, gw, NGW, lane, tid);
        SEAM(pb + 5);
        if (IN(pb + 6)) {
            pg8::Gemm g{XN, (const bf16_t*)(wl + WL_UP), M, 2 * DFF, DM}; pg8::StaticOrder S; S.init(M, 2 * DFF, G, bx);
            pg8::EpiPlain E{UP, 2 * DFF};
            pg8::gemm_phase(lds, g, S, E, pg8::NoHook{});
        }
        SEAM(pb + 6);
        if (IN(pb + 7)) {
            const float* cw = ffn_cw + (size_t)L * 3 * 2 * DFF;
            for (int item = bx * 512 + tid; item < 512 * 704; item += G * 512) { const int rb = item / 704, c = (item % 704) * 8, row0 = rb * 16, t0 = row0 & (SEQ - 1);
                float wg[3][8], wv[3][8];
#pragma unroll
                for (int k = 0; k < 3; ++k) { const f32x4 a = *(const f32x4*)(cw + k * 2 * DFF + c), b = *(const f32x4*)(cw + k * 2 * DFF + c + 4), d = *(const f32x4*)(cw + k * 2 * DFF + DFF + c), e2 = *(const f32x4*)(cw + k * 2 * DFF + DFF + c + 4);
                    wg[k][0] = a.x; wg[k][1] = a.y; wg[k][2] = a.z; wg[k][3] = a.w; wg[k][4] = b.x; wg[k][5] = b.y; wg[k][6] = b.z; wg[k][7] = b.w;
                    wv[k][0] = d.x; wv[k][1] = d.y; wv[k][2] = d.z; wv[k][3] = d.w; wv[k][4] = e2.x; wv[k][5] = e2.y; wv[k][6] = e2.z; wv[k][7] = e2.w; }
                u32x4 g0, g1, v0, v1;
                if (t0 >= 2) { const bf16_t* p2 = UP + (size_t)(row0 - 2) * 2 * DFF + c; g0 = *(const u32x4*)p2; v0 = *(const u32x4*)(p2 + DFF); g1 = *(const u32x4*)(p2 + 2 * DFF); v1 = *(const u32x4*)(p2 + 3 * DFF); }
                else { g0 = g1 = v0 = v1 = (u32x4){0u, 0u, 0u, 0u}; }
                for (int r = 0; r < 16; ++r) { const bf16_t* pr = UP + (size_t)(row0 + r) * 2 * DFF + c; const u32x4 g2 = *(const u32x4*)pr, v2 = *(const u32x4*)(pr + DFF);
                    float o[8];
#pragma unroll
                    for (int e = 0; e < 4; ++e) {
                        const float ga = wg[0][2 * e] * bf_lo(g0[e]) + wg[1][2 * e] * bf_lo(g1[e]) + wg[2][2 * e] * bf_lo(g2[e]), gb2 = wg[0][2 * e + 1] * bf_hi(g0[e]) + wg[1][2 * e + 1] * bf_hi(g1[e]) + wg[2][2 * e + 1] * bf_hi(g2[e]);
                        const float va = wv[0][2 * e] * bf_lo(v0[e]) + wv[1][2 * e] * bf_lo(v1[e]) + wv[2][2 * e] * bf_lo(v2[e]), vb = wv[0][2 * e + 1] * bf_hi(v0[e]) + wv[1][2 * e + 1] * bf_hi(v1[e]) + wv[2][2 * e + 1] * bf_hi(v2[e]);
                        o[2 * e] = ga * sigmoid_f(ga) * va; o[2 * e + 1] = gb2 * sigmoid_f(gb2) * vb; }
                    u32x4 w; w.x = cvt_pk_bf16(o[0], o[1]); w.y = cvt_pk_bf16(o[2], o[3]); w.z = cvt_pk_bf16(o[4], o[5]); w.w = cvt_pk_bf16(o[6], o[7]);
                    *(u32x4*)(HID + (size_t)(row0 + r) * DFF + c) = w;
                    g0 = g1; v0 = v1; g1 = g2; v1 = v2; }
            }
        }
        SEAM(pb + 7);
        if (IN(pb + 8)) {
            pg8::Gemm g{HID, (const bf16_t*)(wl + WL_DN), M, DM, DFF}; pg8::StaticOrder S; S.init(M, DM, G, bx);
            pg8::EpiResid E{X, X, DM};
            pg8::gemm_phase(lds, g, S, E, pg8::NoHook{});
        }
        SEAM(pb + 8);
        if (IN(pb + 9)) norm_phase<false, false>(X, XN, nullptr, nullptr, nullptr, nullptr, nullptr, lds, gw, NGW, lane, tid);
        SEAM(pb + 9);
        if (IN(pb + 10)) {
            pg8::Gemm g{XN, (const bf16_t*)(wl + WL_PG), M, DM, DM}; pg8::StaticOrder S; S.init(M, DM, G, bx);
            pg8::EpiPle E{X, PP + (size_t)L * M * DM, DM};
            pg8::gemm_phase(lds, g, S, E, pg8::NoHook{});
        }
        SEAM(pb + 10);
        if (IN(pb + 11)) {
            if (L + 1 < DEPTH) norm_phase<true, false>(X, XN, WFG + (size_t)(L + 1) * 8 * DM, fox_b + (L + 1) * 8, LOGF, nullptr, nullptr, lds, gw, NGW, lane, tid);
            else norm_phase<false, true>(X, nullptr, nullptr, nullptr, nullptr, final_g, X, lds, gw, NGW, lane, tid);
        }
        SEAM(pb + 11);
    }
#undef IN
#undef SEAM
}
#undef x_in
#undef p_in
#undef pos_in
#undef norm_mix_g
#undef w_in
#undef fox_b
#undef scw
#undef sgu_g
#undef sgu_w
#undef sgu_b
#undef w_br_fox
#undef w_br_conv
#undef w_br_sgu
#undef w_br_dil
#undef w_out
#undef norm_ffn_g
#undef w_up
#undef ffn_cw
#undef w_down
#undef norm_ple_g
#undef w_pg
#undef w_pe
#undef final_g
#undef X
#undef WFG
#undef SGUW
#undef ROPE
#undef LOGF
#undef FL
#undef LSE
#undef PB
#undef PP
#undef XN
#undef PROJ
#undef UP
#undef HID
#undef OCAT
#undef MG
#undef ODIL
#undef ws

extern "C" void kernel_launch(void* const* d_in, const int* in_sizes, int n_in, void* d_out, int out_size, void* d_ws, size_t ws_size, hipStream_t stream) {
    static int grid = 0;
    if (grid == 0) {
        if (n_in != 23 || in_sizes[0] != M * DM || out_size != M * DM || ws_size < WS_END) { fprintf(stderr, "kernel_launch: unexpected shapes/workspace (n_in %d, ws %zu < %zu)\n", n_in, ws_size, (size_t)WS_END); grid = -1; return; }
        int dev = 0, cus = 0, per_cu = 0;
        if (hipGetDevice(&dev) != hipSuccess || hipDeviceGetAttribute(&cus, hipDeviceAttributeMultiprocessorCount, dev) != hipSuccess) { grid = -1; return; }
        if (hipFuncSetAttribute((const void*)mk_fwd, hipFuncAttributeMaxDynamicSharedMemorySize, LDS_BYTES) != hipSuccess) { fprintf(stderr, "kernel_launch: hipFuncSetAttribute failed\n"); grid = -1; return; }
        if (hipOccupancyMaxActiveBlocksPerMultiprocessor(&per_cu, (const void*)mk_fwd, 512, LDS_BYTES) != hipSuccess || per_cu < 1) fprintf(stderr, "kernel_launch: occupancy query says %d\n", per_cu);
        (void)hipGetLastError();
        grid = cus;
    }
    if (grid < 0) return;
    if (hipMemsetAsync((char*)d_ws + WS_CTL, 0, CTL_BYTES, stream) != hipSuccess) return;
    Args a{};
    for (int i = 0; i < 23; ++i) a.in[i] = (const float*)d_in[i];
    a.out = (float*)d_out; a.ws = (unsigned char*)d_ws; a.pad = 0;
    const int step = (MK_SPLIT > 0) ? MK_SPLIT : NPHASE;
    int li = 0;
    for (int lo = 0; lo < NPHASE; lo += step, ++li) {
        a.ph_lo = lo; a.ph_hi = (lo + step < NPHASE) ? lo + step : NPHASE; a.li = li;
        hipLaunchKernelGGL(mk_fwd, dim3(grid), dim3(512), LDS_BYTES, stream, a);
        if (hipPeekAtLastError() != hipSuccess) { fprintf(stderr, "kernel_launch: launch %d failed\n", li); break; }
    }
}
```

```cpp
#include <hip/hip_runtime.h>
#include <cstdio>
#include <cstdint>

#ifndef MK_SPLIT
#define MK_SPLIT 0
#endif

#define LAS __attribute__((address_space(3)))
#define GAS __attribute__((address_space(1)))
typedef unsigned short bf16_t;
typedef short bf16x8 __attribute__((ext_vector_type(8)));
typedef short s16x4 __attribute__((ext_vector_type(4)));
typedef float f32x2 __attribute__((ext_vector_type(2)));
typedef float f32x4 __attribute__((ext_vector_type(4)));
typedef float f32x16 __attribute__((ext_vector_type(16)));
typedef unsigned u32x2 __attribute__((ext_vector_type(2)));
typedef unsigned u32x4 __attribute__((ext_vector_type(4)));

constexpr int NB = 2, SEQ = 4096, DM = 2048, DEPTH = 4, M = NB * SEQ;
constexpr int DIN_SRC = 14600, DIN = 14592;
constexpr int DFF = 5632, PLE = 256;
constexpr float EPS = 1e-6f;
constexpr float LOG2E = 1.4426950408889634f;
constexpr float C2 = 0.125f * LOG2E;
constexpr int PC_AQ = 0, PC_AK = 512, PC_AV = 1024, PC_XB = 1536, PC_GB = 2048, PC_GC = 2560, PC_SU = 3072, PC_SV = 3584,
              PC_DQ = 4096, PC_DK = 4864, PC_DV = 5632, PC_G = 6400;
constexpr int OC_W = 1792;
constexpr int OC_A = 0, OC_B = 512, OC_C = 1024, OC_D = 1536;

constexpr size_t MiB = 1u << 20;
constexpr size_t WS_CTL = 0, CTL_BYTES = 2 * MiB;
constexpr size_t WS_WL = 2 * MiB;
constexpr size_t WL_IN = 0, WL_BR = 57 * MiB, WL_OUT = 64 * MiB, WL_UP = 72 * MiB, WL_DN = 116 * MiB, WL_PG = 138 * MiB, WL_PE = 146 * MiB, WL_STRIDE = 147 * MiB;
constexpr size_t WS_SMALL = WS_WL + 4 * WL_STRIDE;
constexpr size_t SM_WFG = 0, SM_SGUW = 256 * 1024, SM_ROPE = 768 * 1024, SM_LOGF = 1280 * 1024, SM_FL = 1536 * 1024, SM_LSE = 1792 * 1024;
constexpr size_t WS_PB = WS_SMALL + 4 * MiB;
constexpr size_t WS_PP = WS_PB + 16 * MiB;
constexpr size_t WS_XN = WS_PP + 128 * MiB;
constexpr size_t WS_PROJ = WS_XN + 32 * MiB;
constexpr size_t WS_HID = WS_PROJ + 228 * MiB;
constexpr size_t WS_OCAT = WS_HID + 88 * MiB;
constexpr size_t WS_MG = WS_OCAT + 28 * MiB;
constexpr size_t WS_ODIL = WS_MG + 32 * MiB;
constexpr size_t WS_END = WS_ODIL + 24 * MiB;
constexpr int CW_BAR = 4096;
constexpr int CW_Q = 1024;

constexpr int LDS_BYTES = 147456;
constexpr int RING_BYTES = 131072;
constexpr int MISC_OFF = RING_BYTES + 320;

#define LDS_WAIT() asm volatile("s_waitcnt lgkmcnt(0)" ::: "memory")
#define VM_WAIT() asm volatile("s_waitcnt vmcnt(0)" ::: "memory")
#define BAR_L() asm volatile("s_waitcnt lgkmcnt(0)\n\ts_barrier" ::: "memory")
typedef __bf16 bf16x2_t __attribute__((ext_vector_type(2)));
__device__ __forceinline__ unsigned cvt_pk_bf16(float lo, float hi) { f32x2 v = {lo, hi}; bf16x2_t b = __builtin_convertvector(v, bf16x2_t); return __builtin_bit_cast(unsigned, b); }
__device__ __forceinline__ float bf_lo(unsigned u) { return __uint_as_float(u << 16); }
__device__ __forceinline__ float bf_hi(unsigned u) { return __uint_as_float(u & 0xffff0000u); }
__device__ __forceinline__ float bf1(bf16_t u) { return __uint_as_float(((unsigned)u) << 16); }
__device__ __forceinline__ float wave_sum(float v) {
#pragma unroll
    for (int o = 1; o < 64; o <<= 1) v += __shfl_xor(v, o);
    return v;
}
__device__ __forceinline__ float fast_exp2(float x) { return __builtin_amdgcn_exp2f(x); }
__device__ __forceinline__ float fast_rcp(float x) { return __builtin_amdgcn_rcpf(x); }
__device__ __forceinline__ float sigmoid_f(float x) { return fast_rcp(1.0f + fast_exp2(-LOG2E * x)); }
__device__ __forceinline__ float gelu_tanh_f(float x) {
    const float z = 0.7978845608028654f * (x + 0.044715f * x * x * x);
    return x * fast_rcp(1.0f + fast_exp2(-2.0f * LOG2E * z));
}

namespace pg8 {
#define PG8_LAS __attribute__((address_space(3)))
constexpr int BM = 256, BK = 64, HALF = 128, HTB = HALF * BK * 2, STAGE_BYTES = 8 * HTB, NXCD = 8, WGM = 8;
__host__ __device__ __forceinline__ int lds_byte(int r, int c) { const int st = (r >> 4) * 2 + (c >> 5), rr = r & 15, cc = c & 31, ob = rr * 64 + cc * 2; return st * 1024 + (ob ^ (((ob >> 9) & 1) << 5)); }
__host__ __device__ __forceinline__ void stage_rc(int b, int& R, int& C) { const int st = b / 1024, sb = b % 1024, swz = sb ^ (((sb >> 9) & 1) << 5); R = (st >> 1) * 16 + swz / 64; C = (st & 1) * 32 + (swz % 64) / 2; }
__host__ __device__ __forceinline__ int perm32(int rho) { const int n = rho >> 4, i = rho & 15; return 8 * (i >> 2) + 4 * n + (i & 3); }
struct Unit { int pm, pn; };
struct Gemm { const bf16_t* A; const bf16_t* Bt; int M, N, K; };
struct StaticOrder {
    int nM, nN, nwg, G, c;
    __host__ __device__ void init(int M_, int N_, int G_, int c_) { nM = M_ / BM; nN = N_ / BM; nwg = nM * nN; G = G_; c = c_; }
    __host__ __device__ bool next(int i, Unit& u) const {
        const long L = (long)i * G + c; if (L >= nwg) return false;
        int wgid = (int)L; { const int q = nwg / NXCD, r = nwg % NXCD, xcd = wgid % NXCD, off = wgid / NXCD; wgid = (xcd < r ? xcd * (q + 1) : r * (q + 1) + (xcd - r) * q) + off; }
        const int nig = WGM * nN, gid = wgid / nig, fm = gid * WGM, gsz = (nM - fm) < WGM ? (nM - fm) : WGM;
        u.pm = fm + ((wgid % nig) % gsz); u.pn = (wgid % nig) / gsz; return true;
    }
    __device__ __forceinline__ void a_ready(const Unit&) const {}
    __device__ __forceinline__ void done(const Unit&) const {}
};
typedef f32x4 Acc[2][2][4][2];

template <int MODE> __device__ __forceinline__ void store_tile_bf16(const Acc& acc, bf16_t* O, int ldc, int row0, int col0) {
#pragma unroll
    for (int ai = 0; ai < 2; ++ai)
#pragma unroll
        for (int m = 0; m < 4; ++m) { bf16_t* rowp = O + (size_t)(row0 + ai * HALF + m * 16) * ldc + col0;
#pragma unroll
            for (int bj = 0; bj < 2; ++bj) { f32x4 v0 = acc[ai][bj][m][0], v1 = acc[ai][bj][m][1];
                if (MODE == 1) { v0 = v0 * C2; v1 = v1 * C2; }
                if (MODE == 2) {
#pragma unroll
                    for (int e = 0; e < 4; ++e) { v0[e] = gelu_tanh_f(v0[e]); v1[e] = gelu_tanh_f(v1[e]); } }
                if (MODE == 3) {
#pragma unroll
                    for (int e = 0; e < 4; ++e) { v0[e] = sigmoid_f(v0[e]); v1[e] = sigmoid_f(v1[e]); } }
                u32x4 w; w.x = cvt_pk_bf16(v0[0], v0[1]); w.y = cvt_pk_bf16(v0[2], v0[3]); w.z = cvt_pk_bf16(v1[0], v1[1]); w.w = cvt_pk_bf16(v1[2], v1[3]);
                *(u32x4*)(rowp + bj * HALF) = w; } }
}
struct NoHook { static constexpr bool ON = false; __device__ __forceinline__ void operator()(Acc&, const Unit&, int, int, int, int, int) const {} };
struct EpiPlain {
    static constexpr bool PERM = true, AFTER_DRAIN = false;
    bf16_t* O; int ldc;
    __device__ __forceinline__ void operator()(Acc& acc, const Unit& u, int wr, int wc, int fr, int fq) const {
        store_tile_bf16<0>(acc, O, ldc, u.pm * BM + wr * 64 + fr, u.pn * BM + wc * 32 + 8 * fq); }
};
struct EpiProj {
    static constexpr bool PERM = true, AFTER_DRAIN = false;
    bf16_t* O; int ldc;
    __device__ __forceinline__ void operator()(Acc& acc, const Unit& u, int wr, int wc, int fr, int fq) const {
        const int pn = u.pn, row0 = u.pm * BM + wr * 64 + fr, col0 = pn * BM + wc * 32 + 8 * fq;
        if (pn < 2 || (pn >= 16 && pn < 19)) store_tile_bf16<1>(acc, O, ldc, row0, col0);
        else if (pn >= 12 && pn < 16) store_tile_bf16<2>(acc, O, ldc, row0, col0);
        else if (pn >= 25) store_tile_bf16<3>(acc, O, ldc, row0, col0);
        else store_tile_bf16<0>(acc, O, ldc, row0, col0);
    }
};
struct EpiResid {
    static constexpr bool PERM = false, AFTER_DRAIN = false;
    const float* base; float* out; int ldc;
    __device__ __forceinline__ void operator()(Acc& acc, const Unit& u, int wr, int wc, int fr, int fq) const {
        const int row0 = u.pm * BM + wr * 64 + fr, col0 = u.pn * BM + wc * 32 + 4 * fq;
#pragma unroll
        for (int ai = 0; ai < 2; ++ai)
#pragma unroll
            for (int mp = 0; mp < 2; ++mp) { f32x4 b[2][2][2];
#pragma unroll
                for (int mm = 0; mm < 2; ++mm) { const size_t off = (size_t)(row0 + ai * HALF + (2 * mp + mm) * 16) * ldc + col0;
#pragma unroll
                    for (int bj = 0; bj < 2; ++bj)
#pragma unroll
                        for (int n = 0; n < 2; ++n) b[mm][bj][n] = *(const f32x4*)(base + off + bj * HALF + n * 16); }
#pragma unroll
                for (int mm = 0; mm < 2; ++mm) { const size_t off = (size_t)(row0 + ai * HALF + (2 * mp + mm) * 16) * ldc + col0;
#pragma unroll
                    for (int bj = 0; bj < 2; ++bj)
#pragma unroll
                        for (int n = 0; n < 2; ++n) *(f32x4*)(out + off + bj * HALF + n * 16) = b[mm][bj][n] + acc[ai][bj][2 * mp + mm][n]; }
                asm volatile("" ::: "memory"); }
    }
};
struct EpiPle {
    static constexpr bool PERM = false, AFTER_DRAIN = false;
    float* X; const bf16_t* PP; int ldc;
    __device__ __forceinline__ void operator()(Acc& acc, const Unit& u, int wr, int wc, int fr, int fq) const {
        const int row0 = u.pm * BM + wr * 64 + fr, col0 = u.pn * BM + wc * 32 + 4 * fq;
#pragma unroll
        for (int ai = 0; ai < 2; ++ai)
#pragma unroll
            for (int mp = 0; mp < 2; ++mp) { f32x4 b[2][2][2]; u32x2 pp[2][2][2];
#pragma unroll
                for (int mm = 0; mm < 2; ++mm) { const size_t off = (size_t)(row0 + ai * HALF + (2 * mp + mm) * 16) * ldc + col0;
#pragma unroll
                    for (int bj = 0; bj < 2; ++bj)
#pragma unroll
                        for (int n = 0; n < 2; ++n) { b[mm][bj][n] = *(const f32x4*)(X + off + bj * HALF + n * 16); pp[mm][bj][n] = *(const u32x2*)(PP + off + bj * HALF + n * 16); } }
#pragma unroll
                for (int mm = 0; mm < 2; ++mm) { const size_t off = (size_t)(row0 + ai * HALF + (2 * mp + mm) * 16) * ldc + col0;
#pragma unroll
                    for (int bj = 0; bj < 2; ++bj)
#pragma unroll
                        for (int n = 0; n < 2; ++n) { const f32x4 a = acc[ai][bj][2 * mp + mm][n], bb = b[mm][bj][n]; const u32x2 p2 = pp[mm][bj][n]; f32x4 r;
                            r[0] = bb[0] + sigmoid_f(a[0]) * bf_lo(p2.x); r[1] = bb[1] + sigmoid_f(a[1]) * bf_hi(p2.x); r[2] = bb[2] + sigmoid_f(a[2]) * bf_lo(p2.y); r[3] = bb[3] + sigmoid_f(a[3]) * bf_hi(p2.y);
                            *(f32x4*)(X + off + bj * HALF + n * 16) = r; } }
                asm volatile("" ::: "memory"); }
    }
};
struct MergeHook {
    static constexpr bool ON = true;
    const bf16_t* G;
    __device__ __forceinline__ void operator()(Acc& acc, const Unit& u, int t, int wr, int wc, int fr, int fq) const {
        const int j = (t >> 3) - 1;
        unsigned off0 = (unsigned)((u.pm * BM + wr * 64 + fr) * DIN + u.pn * BM + wc * 32 + 8 * fq);
        asm volatile("" : "+v"(off0));
        const bf16_t* gj = G + j * 2048;
#pragma unroll
        for (int ai = 0; ai < 2; ++ai) {
#pragma unroll
            for (int m = 0; m < 4; ++m) { const bf16_t* gp = gj + (off0 + (unsigned)((ai * HALF + m * 16) * DIN));
#pragma unroll
                for (int bj = 0; bj < 2; ++bj) { const u32x4 a = *(const u32x4*)(gp + bj * HALF), b = *(const u32x4*)(gp + 2048 + bj * HALF);
                    f32x4 r0, r1;
                    r0[0] = bf_lo(a.x) * fast_rcp(bf_lo(b.x)); r0[1] = bf_hi(a.x) * fast_rcp(bf_hi(b.x)); r0[2] = bf_lo(a.y) * fast_rcp(bf_lo(b.y)); r0[3] = bf_hi(a.y) * fast_rcp(bf_hi(b.y));
                    r1[0] = bf_lo(a.z) * fast_rcp(bf_lo(b.z)); r1[1] = bf_hi(a.z) * fast_rcp(bf_hi(b.z)); r1[2] = bf_lo(a.w) * fast_rcp(bf_lo(b.w)); r1[3] = bf_hi(a.w) * fast_rcp(bf_hi(b.w));
                    acc[ai][bj][m][0] = acc[ai][bj][m][0] * r0; acc[ai][bj][m][1] = acc[ai][bj][m][1] * r1; }
                if (m & 1) asm volatile("" ::: "memory"); } }
    }
};
struct EpiMerge {
    static constexpr bool PERM = true, AFTER_DRAIN = false;
    bf16_t* O; int ldc; const bf16_t* G3;
    __device__ __forceinline__ void operator()(Acc& acc, const Unit& u, int wr, int wc, int fr, int fq) const {
        const int row0 = u.pm * BM + wr * 64 + fr, col0 = u.pn * BM + wc * 32 + 8 * fq;
#pragma unroll
        for (int ai = 0; ai < 2; ++ai) { u32x4 g[4][2];
#pragma unroll
            for (int m = 0; m < 4; ++m)
#pragma unroll
                for (int bj = 0; bj < 2; ++bj) g[m][bj] = *(const u32x4*)(G3 + (size_t)(row0 + ai * HALF + m * 16) * DIN + col0 + bj * HALF);
#pragma unroll
            for (int m = 0; m < 4; ++m)
#pragma unroll
                for (int bj = 0; bj < 2; ++bj) { const u32x4 gg = g[m][bj]; const f32x4 v0 = acc[ai][bj][m][0], v1 = acc[ai][bj][m][1];
                    u32x4 w; w.x = cvt_pk_bf16(v0[0] * bf_lo(gg.x), v0[1] * bf_hi(gg.x)); w.y = cvt_pk_bf16(v0[2] * bf_lo(gg.y), v0[3] * bf_hi(gg.y));
                    w.z = cvt_pk_bf16(v1[0] * bf_lo(gg.z), v1[1] * bf_hi(gg.z)); w.w = cvt_pk_bf16(v1[2] * bf_lo(gg.w), v1[3] * bf_hi(gg.w));
                    *(u32x4*)(O + (size_t)(row0 + ai * HALF + m * 16) * ldc + col0 + bj * HALF) = w; }
            asm volatile("" ::: "memory"); }
    }
};

template <class Epi, class Hook>
__device__ __forceinline__ void gemm_phase(PG8_LAS unsigned char* lds, const Gemm g, const StaticOrder& S, const Epi& E, const Hook& H) {
    int tid = threadIdx.x; asm volatile("" : "+v"(tid));
    const int wid = __builtin_amdgcn_readfirstlane(tid >> 6), lane = tid & 63, wr = wid >> 2, wc = wid & 3, fr = lane & 15, fq = lane >> 4;
    const int K = g.K, nt = K / BK;
    unsigned voffA[2], voffB[2];
#pragma unroll
    for (int i = 0; i < 2; ++i) { int R, C; stage_rc(tid * 16 + i * 8192, R, C); const int Rb = Epi::PERM ? ((R & ~31) + perm32(R & 31)) : R;
        voffA[i] = (unsigned)(R * K + C) * 2u; voffB[i] = (unsigned)(Rb * K + C) * 2u; }
    const size_t kstep = (size_t)(BK * 2);
    const size_t hstep = (size_t)HALF * K * 2;
    const size_t tstep = 2 * hstep;
    const unsigned ldsw = (unsigned)wid * 1024u;
    const int aoff = lds_byte(wr * 64 + fr, fq * 8), boff = lds_byte(wc * 32 + fr, fq * 8);
#define PG8_SA(b, h) (((b) * 2 + (h)) * HTB)
#define PG8_SB(b, h) ((4 + (b) * 2 + (h)) * HTB)
#define PG8_STAGE(bufoff, gbase, voff) do { _Pragma("unroll") for (int _i = 0; _i < 2; ++_i) \
        __builtin_amdgcn_global_load_lds((const unsigned*)((const char*)(gbase) + (voff)[_i]), (PG8_LAS unsigned*)(lds + (bufoff) + ldsw + _i * 8192), 16, 0, 0); } while (0)
#define PG8_LDA(dst, b, h) do { _Pragma("unroll") for (int m = 0; m < 4; ++m) _Pragma("unroll") for (int k = 0; k < 2; ++k) dst[m][k] = *(const PG8_LAS bf16x8*)(lds + PG8_SA(b, h) + aoff + m * 2048 + k * 1024); } while (0)
#define PG8_LDB(dst, b, h) do { _Pragma("unroll") for (int n = 0; n < 2; ++n) _Pragma("unroll") for (int k = 0; k < 2; ++k) dst[n][k] = *(const PG8_LAS bf16x8*)(lds + PG8_SB(b, h) + boff + n * 2048 + k * 1024); } while (0)
#define PG8_MMA(ai, bj, At, Bt) do { __builtin_amdgcn_s_setprio(1); _Pragma("unroll") for (int m = 0; m < 4; ++m) _Pragma("unroll") for (int n = 0; n < 2; ++n) _Pragma("unroll") for (int k = 0; k < 2; ++k) \
        acc[ai][bj][m][n] = __builtin_amdgcn_mfma_f32_16x16x32_bf16(Bt[n][k], At[m][k], acc[ai][bj][m][n], 0, 0, 0); __builtin_amdgcn_s_setprio(0); } while (0)
#define PG8_WAIT_V(n) asm volatile("s_waitcnt vmcnt(" #n ")" ::: "memory")
#define PG8_WAIT_L(n) asm volatile("s_waitcnt lgkmcnt(" #n ")" ::: "memory")
#define PG8_BAR __builtin_amdgcn_s_barrier()
#define PG8_SCHED __builtin_amdgcn_sched_barrier(0)
    Unit cur, nxt; int ui = 0;
    if (!S.next(0, cur)) return;
    Acc acc;
#pragma unroll
    for (int a = 0; a < 2; ++a)
#pragma unroll
        for (int b = 0; b < 2; ++b)
#pragma unroll
            for (int m = 0; m < 4; ++m)
#pragma unroll
                for (int n = 0; n < 2; ++n) acc[a][b][m][n] = (f32x4){0.f, 0.f, 0.f, 0.f};
    bf16x8 At[4][2], B0[2][2], B1[2][2];
    const char* cA = (const char*)g.A + (size_t)cur.pm * tstep; const char* cB = (const char*)g.Bt + (size_t)cur.pn * tstep;
    S.a_ready(cur);
    PG8_STAGE(PG8_SB(0, 0), cB, voffB); PG8_STAGE(PG8_SB(0, 1), cB + hstep, voffB); PG8_STAGE(PG8_SA(0, 0), cA, voffA); PG8_STAGE(PG8_SA(0, 1), cA + hstep, voffA);
    if (wr == 1) PG8_BAR;
    PG8_WAIT_V(2); PG8_BAR;
    PG8_STAGE(PG8_SB(1, 0), cB + kstep, voffB); PG8_STAGE(PG8_SA(1, 0), cA + kstep, voffA); PG8_STAGE(PG8_SB(1, 1), cB + hstep + kstep, voffB);
    PG8_WAIT_V(6); PG8_BAR;
    for (;;) {
        const bool has_next = S.next(ui + 1, nxt);
        const char* nA = has_next ? (const char*)g.A + (size_t)nxt.pm * tstep : cA; const char* nB = has_next ? (const char*)g.Bt + (size_t)nxt.pn * tstep : cB;
        for (int t = 0; t < nt; t += 2) {
            if constexpr (Hook::ON) { if (t != 0 && (t & 7) == 0) H(acc, cur, t, wr, wc, fr, fq); }
            const bool last = (t == nt - 2);
            const char* a1 = cA + (size_t)(t + 1) * kstep;
            const char* a2 = last ? nA : cA + (size_t)(t + 2) * kstep; const char* b2 = last ? nB : cB + (size_t)(t + 2) * kstep;
            const char* a3 = a2 + kstep; const char* b3 = b2 + kstep;
            if (last && has_next) S.a_ready(nxt);
            PG8_LDB(B0, 0, 0); PG8_LDB(B1, 0, 1); PG8_SCHED; PG8_LDA(At, 0, 0); PG8_STAGE(PG8_SA(1, 1), a1 + hstep, voffA);
            PG8_WAIT_V(8); PG8_WAIT_L(0); PG8_BAR; PG8_MMA(0, 0, At, B0); PG8_MMA(0, 1, At, B1); PG8_BAR; PG8_SCHED;
            PG8_LDA(At, 0, 1); PG8_STAGE(PG8_SB(0, 0), b2, voffB); PG8_STAGE(PG8_SB(0, 1), b2 + hstep, voffB); PG8_STAGE(PG8_SA(0, 0), a2, voffA);
            PG8_WAIT_V(8); PG8_WAIT_L(0); PG8_BAR; PG8_MMA(1, 0, At, B0); PG8_MMA(1, 1, At, B1); PG8_BAR; PG8_SCHED;
            PG8_LDB(B0, 1, 0); PG8_LDB(B1, 1, 1); PG8_SCHED; PG8_LDA(At, 1, 0); PG8_STAGE(PG8_SA(0, 1), a2 + hstep, voffA);
            PG8_WAIT_V(8); PG8_WAIT_L(0); PG8_BAR; PG8_MMA(0, 0, At, B0); PG8_MMA(0, 1, At, B1); PG8_BAR; PG8_SCHED;
            PG8_LDA(At, 1, 1); PG8_STAGE(PG8_SB(1, 0), b3, voffB); PG8_STAGE(PG8_SB(1, 1), b3 + hstep, voffB); PG8_STAGE(PG8_SA(1, 0), a3, voffA);
            PG8_WAIT_V(8); PG8_WAIT_L(0); PG8_BAR; PG8_MMA(1, 0, At, B0); PG8_MMA(1, 1, At, B1); PG8_BAR; PG8_SCHED;
        }
        if (wr == 0) PG8_BAR;
        E(acc, cur, wr, wc, fr, fq); S.done(cur);
        if (!has_next) break;
#pragma unroll
        for (int a = 0; a < 2; ++a)
#pragma unroll
            for (int b = 0; b < 2; ++b)
#pragma unroll
                for (int m = 0; m < 4; ++m)
#pragma unroll
                    for (int n = 0; n < 2; ++n) acc[a][b][m][n] = (f32x4){0.f, 0.f, 0.f, 0.f};
        cur = nxt; cA = nA; cB = nB; ++ui;
        if (wr == 1) PG8_BAR;
    }
    PG8_WAIT_V(0);
    PG8_BAR;
#undef PG8_SA
#undef PG8_SB
#undef PG8_STAGE
#undef PG8_LDA
#undef PG8_LDB
#undef PG8_MMA
#undef PG8_WAIT_V
#undef PG8_WAIT_L
#undef PG8_BAR
#undef PG8_SCHED
}
}

#define XB_TMO      128
#define XB_XCNT(j)  (256  + 64 * (j))
#define XB_XSUB(j)  (1280 + 64 * (j))
#define XB_XGEN(j)  (2304 + 64 * (j))
#define XB_TOP      3328
#define XB_TOPGEN   3392
#define XCD_BAR_WORDS 3456
#define XB_SPIN_CAP (1u << 18)
__device__ __forceinline__ unsigned xb_ld(unsigned* p)              { return __hip_atomic_load(p, __ATOMIC_RELAXED, __HIP_MEMORY_SCOPE_AGENT); }
__device__ __forceinline__ unsigned xb_add(unsigned* p, unsigned v) { return __hip_atomic_fetch_add(p, v, __ATOMIC_RELAXED, __HIP_MEMORY_SCOPE_AGENT); }
__device__ __forceinline__ unsigned xb_xcc_id() { return (unsigned)__builtin_amdgcn_s_getreg((3 << 11) | 20) & 0xFu; }
#define XB_SPIN(cond, bar) do { unsigned _sp = 0; while (cond) { __builtin_amdgcn_s_sleep(1); \
    if ((++_sp & 255u) == 0u) { if (xb_ld(&(bar)[XB_TMO])) break; if (_sp > XB_SPIN_CAP) { atomicAdd(&(bar)[XB_TMO], 1u); break; } } } } while (0)
struct XcdBarrier { unsigned* bar; unsigned x; volatile LAS unsigned* st; };
__device__ __forceinline__ XcdBarrier xcd_barrier_post(unsigned* bar, volatile LAS unsigned* st) {
    XcdBarrier b; b.bar = bar; b.x = xb_xcc_id(); b.st = st;
    if (threadIdx.x == 0) (void)xb_add(&bar[XB_XCNT(b.x)], 1u);
    return b;
}
__device__ __forceinline__ void xcd_barrier_complete(unsigned* bar, unsigned x, unsigned& nloc, unsigned& nx) {
    const unsigned G = gridDim.x * gridDim.y * gridDim.z;
    unsigned sum, cnt, mine, sp = 0u;
    for (;;) {
        sum = 0u; cnt = 0u; mine = 0u;
#pragma unroll
        for (unsigned j = 0; j < 16; ++j) { const unsigned c = xb_ld(&bar[XB_XCNT(j)]); sum += c; cnt += (c > 0u) ? 1u : 0u; mine = (j == x) ? c : mine; }
        if (sum == G) break;
        __builtin_amdgcn_s_sleep(1);
        if ((++sp & 255u) == 0u) { if (xb_ld(&bar[XB_TMO])) break; if (sp > XB_SPIN_CAP) { atomicAdd(&bar[XB_TMO], 1u); break; } }
    }
    nloc = mine > 0u ? mine : 1u; nx = cnt > 0u ? cnt : 1u;
}
__device__ __forceinline__ void xcd_barrier(const XcdBarrier& b) {
    asm volatile("s_waitcnt vmcnt(0)" ::: "memory");
    __syncthreads();
    if (threadIdx.x == 0) {
        unsigned* bar = b.bar;
        __builtin_amdgcn_s_waitcnt(0);
        unsigned nloc = b.st[0], nx = b.st[1];
        if (nloc == 0u) { xcd_barrier_complete(bar, b.x, nloc, nx); b.st[0] = nloc; b.st[1] = nx; }
        const unsigned old = xb_add(&bar[XB_XSUB(b.x)], 1u);
        const unsigned gen = old / nloc;
        if (old + 1u == (gen + 1u) * nloc) {
            __builtin_amdgcn_fence(__ATOMIC_RELEASE, "agent");
            asm volatile("s_waitcnt vmcnt(0)" ::: "memory");
            const unsigned og = xb_add(&bar[XB_TOP], 1u);
            const unsigned tg = og / nx;
            if (og + 1u == (tg + 1u) * nx) xb_add(&bar[XB_TOPGEN], 1u);
            else XB_SPIN(xb_ld(&bar[XB_TOPGEN]) == tg, bar);
            __builtin_amdgcn_fence(__ATOMIC_ACQUIRE, "agent");
            xb_add(&bar[XB_XGEN(b.x)], 1u);
            asm volatile("s_waitcnt vmcnt(0)" ::: "memory");
        } else {
            XB_SPIN(xb_ld(&bar[XB_XGEN(b.x)]) == gen, bar);
            __builtin_amdgcn_fence(__ATOMIC_ACQUIRE, "agent");
            asm volatile("s_waitcnt vmcnt(0)" ::: "memory");
        }
    }
    __syncthreads();
}

__device__ __forceinline__ void transpose_item(const float* W, int ldw, int scol0, const float* gk, bf16_t* WT, int ldt, int drow0, int dk0, LAS float* scr, int kb, int nb, int lane) {
    const int k0 = 64 * kb, n0 = 32 * nb;
#pragma unroll 8
    for (int i = 0; i < 32; ++i) { const int kk = 2 * i + (lane >> 5); float v = W[(size_t)(k0 + kk) * ldw + scol0 + n0 + (lane & 31)]; if (gk) v *= gk[k0 + kk]; scr[kk * 33 + (lane & 31)] = v; }
    LDS_WAIT(); asm volatile("" ::: "memory");
    const int c = lane & 7;
#pragma unroll
    for (int j = 0; j < 4; ++j) { const int n = (lane >> 3) + 8 * j; const LAS float* s = scr + (8 * c) * 33 + n;
        u32x4 o; o.x = cvt_pk_bf16(s[0 * 33], s[1 * 33]); o.y = cvt_pk_bf16(s[2 * 33], s[3 * 33]); o.z = cvt_pk_bf16(s[4 * 33], s[5 * 33]); o.w = cvt_pk_bf16(s[6 * 33], s[7 * 33]);
        *(u32x4*)(WT + (size_t)(drow0 + n0 + n) * ldt + dk0 + k0 + 8 * c) = o; }
    LDS_WAIT(); asm volatile("" ::: "memory");
}

struct Args { const float* in[23]; float* out; unsigned char* ws; int ph_lo, ph_hi, li, pad; };

template <bool FORGET, bool FINAL>
__device__ __forceinline__ void norm_phase(const float* X, bf16_t* XN, const float* wfg, const float* fb, float* logf, const float* gfin, float* outf,
                                           LAS unsigned char* lds, int gw, int NGW, int lane, int tid) {
    if (FORGET) {
        LAS f32x4* w4 = (LAS f32x4*)lds;
        for (int i = tid; i < 8 * 2048 / 4; i += 512) w4[i] = ((const f32x4*)wfg)[i];
        __syncthreads();
    }
    for (int m0 = gw * 4; m0 < M; m0 += NGW * 4) {
        f32x4 v[4][8]; float rr[4];
#pragma unroll
        for (int r = 0; r < 4; ++r) { const GAS f32x4* xr = (const GAS f32x4*)(X + (size_t)(m0 + r) * DM) + lane;
#pragma unroll
            for (int j = 0; j < 8; ++j) v[r][j] = xr[64 * j]; }
#pragma unroll
        for (int r = 0; r < 4; ++r) { float s = 0.f;
#pragma unroll
            for (int j = 0; j < 8; ++j) s += (v[r][j].x * v[r][j].x + v[r][j].y * v[r][j].y) + (v[r][j].z * v[r][j].z + v[r][j].w * v[r][j].w);
            rr[r] = 1.0f / sqrtf(wave_sum(s) * (1.0f / DM) + EPS); }
        if (FINAL) {
#pragma unroll
            for (int r = 0; r < 4; ++r) { GAS f32x4* o = (GAS f32x4*)(outf + (size_t)(m0 + r) * DM) + lane;
#pragma unroll
                for (int j = 0; j < 8; ++j) { const f32x4 g = ((const GAS f32x4*)gfin)[64 * j + lane]; o[64 * j] = v[r][j] * rr[r] * g; } }
        } else {
#pragma unroll
            for (int r = 0; r < 4; ++r) { GAS u32x2* o = (GAS u32x2*)(XN + (size_t)(m0 + r) * DM) + lane;
#pragma unroll
                for (int j = 0; j < 8; ++j) { const f32x4 t = v[r][j] * rr[r]; u32x2 w; w.x = cvt_pk_bf16(t.x, t.y); w.y = cvt_pk_bf16(t.z, t.w); o[64 * j] = w; } }
        }
        if (FORGET) {
#pragma unroll 1
            for (int h = 0; h < 8; ++h) {
                float a0 = 0.f, a1 = 0.f, a2 = 0.f, a3 = 0.f;
#pragma unroll
                for (int j = 0; j < 8; ++j) { const f32x4 w = *((LAS f32x4*)lds + h * 512 + 64 * j + lane);
                    a0 += (v[0][j].x * w.x + v[0][j].y * w.y) + (v[0][j].z * w.z + v[0][j].w * w.w);
                    a1 += (v[1][j].x * w.x + v[1][j].y * w.y) + (v[1][j].z * w.z + v[1][j].w * w.w);
                    a2 += (v[2][j].x * w.x + v[2][j].y * w.y) + (v[2][j].z * w.z + v[2][j].w * w.w);
                    a3 += (v[3][j].x * w.x + v[3][j].y * w.y) + (v[3][j].z * w.z + v[3][j].w * w.w); }
                a0 = wave_sum(a0); a1 = wave_sum(a1); a2 = wave_sum(a2); a3 = wave_sum(a3);
                const float bh = fb[h];
                const float z = (lane == 0 ? a0 * rr[0] : lane == 1 ? a1 * rr[1] : lane == 2 ? a2 * rr[2] : a3 * rr[3]) + bh;
                const float ls = z >= 0.f ? -log1pf(expf(-z)) : z - log1pf(expf(z));
                if (lane < 4) logf[(size_t)(m0 + lane) * 8 + h] = ls;
            }
        }
    }
}

namespace att {
constexpr int LDS_K = 0, LDS_V = 8192, LDS_WS = 16384, LDS_SV = 32768, LDS_QW = 20480;
constexpr float NEG = -1e30f;
__device__ __forceinline__ int crow(int r, int hi) { return (r & 3) + 8 * (r >> 2) + 4 * hi; }
__device__ __forceinline__ s16x4 vtr(const LAS unsigned char* p) { return __builtin_bit_cast(s16x4, __builtin_amdgcn_ds_read_tr16_b64_v4i16((LAS s16x4*)p)); }
struct AttnArgs {
    const bf16_t *Q, *K, *V; long rs;
    int q0, kbase, jlo, jhi;
    const float* Fl;
    const float* rope; long rrs;
    bf16_t* Ob; float* Of; long ors;
    float* lse; long lrs;
};
__device__ __forceinline__ u32x4 rope8(u32x4 x1, u32x4 x2, const f32x4 c0, const f32x4 c1, const f32x4 s0, const f32x4 s1, bool first) {
    float a[8], b[8], c[8], s[8], o[8];
    a[0] = bf_lo(x1.x); a[1] = bf_hi(x1.x); a[2] = bf_lo(x1.y); a[3] = bf_hi(x1.y); a[4] = bf_lo(x1.z); a[5] = bf_hi(x1.z); a[6] = bf_lo(x1.w); a[7] = bf_hi(x1.w);
    b[0] = bf_lo(x2.x); b[1] = bf_hi(x2.x); b[2] = bf_lo(x2.y); b[3] = bf_hi(x2.y); b[4] = bf_lo(x2.z); b[5] = bf_hi(x2.z); b[6] = bf_lo(x2.w); b[7] = bf_hi(x2.w);
#pragma unroll
    for (int e = 0; e < 4; ++e) { c[e] = c0[e]; c[4 + e] = c1[e]; s[e] = s0[e]; s[4 + e] = s1[e]; }
#pragma unroll
    for (int e = 0; e < 8; ++e) o[e] = first ? (a[e] * c[e] - b[e] * s[e]) : (a[e] * s[e] + b[e] * c[e]);
    u32x4 w; w.x = cvt_pk_bf16(o[0], o[1]); w.y = cvt_pk_bf16(o[2], o[3]); w.z = cvt_pk_bf16(o[4], o[5]); w.w = cvt_pk_bf16(o[6], o[7]); return w;
}
template <int MODE>
__device__ __forceinline__ void attn_unit(LAS unsigned char* lds, const AttnArgs& A) {
    int tid = threadIdx.x; asm volatile("" : "+v"(tid));
    const int lane = tid & 63, wv = __builtin_amdgcn_readfirstlane(tid >> 6), r32 = lane & 31, hi = lane >> 5;
    LAS float* wsf = (LAS float*)(lds + LDS_WS) + wv * 64;
    const int qi = A.q0 + 32 * wv + r32;
    bf16x8 qr[4];
    { const bf16_t* qrow = A.Q + (long)qi * A.rs;
#pragma unroll
      for (int d0 = 0; d0 < 4; ++d0) qr[d0] = *(const bf16x8*)(qrow + d0 * 16 + hi * 8); }
    if (MODE == 1) {
        const float* rp = A.rope + (long)qi * A.rrs;
        const f32x4 c0 = *(const f32x4*)(rp), c1 = *(const f32x4*)(rp + 4), s0 = *(const f32x4*)(rp + 8), s1 = *(const f32x4*)(rp + 12);
        const u32x4 me = __builtin_bit_cast(u32x4, qr[0]); u32x4 x1, x2;
#pragma unroll
        for (int e = 0; e < 4; ++e) { auto rr = __builtin_amdgcn_permlane32_swap(me[e], me[e], false, false); x1[e] = rr[0]; x2[e] = rr[1]; }
        qr[0] = __builtin_bit_cast(bf16x8, rope8(x1, x2, c0, c1, s0, s1, hi == 0));
    }
    const float flq = (MODE == 0) ? A.Fl[qi] : 0.f;
    float m = NEG, l = 0.f; f32x16 o0, o1;
#pragma unroll
    for (int r = 0; r < 16; ++r) { o0[r] = 0.f; o1[r] = 0.f; }
    const int qw0 = A.q0 + 32 * wv;
    int wlo = A.jlo; const int whi = (qw0 + 31 - A.kbase) >> 6;
    if (MODE == 1) { const int f = (qw0 - 128 - A.kbase) >> 6; wlo = f > wlo ? f : wlo; }
    const int krow = 8 * wv + (lane & 7), kch = lane >> 3, vrow = 8 * wv + (lane >> 3), vch = lane & 7;
    LAS u32x4* kdst = (LAS u32x4*)(lds + LDS_K + kch * 1024 + krow * 16);
    LAS u32x4* vdst = (LAS u32x4*)(lds + LDS_V + (vch >> 2) * 4096 + vrow * 64 + (vch & 3) * 16);
    u32x4 kreg, vreg; f32x4 rc0, rc1, rs0, rs1;
    rc0 = rc1 = rs0 = rs1 = (f32x4){0.f, 0.f, 0.f, 0.f};
#define ATT_LOAD(j) do { const long ks_ = (long)A.kbase + 64 * (j); \
        kreg = *(const u32x4*)(A.K + (ks_ + krow) * A.rs + kch * 8); vreg = *(const u32x4*)(A.V + (ks_ + vrow) * A.rs + vch * 8); \
        if (MODE == 1) { if (kch < 2) { const float* rp_ = A.rope + (ks_ + krow) * A.rrs; rc0 = *(const f32x4*)(rp_); rc1 = *(const f32x4*)(rp_ + 4); rs0 = *(const f32x4*)(rp_ + 8); rs1 = *(const f32x4*)(rp_ + 12); } } } while (0)
    ATT_LOAD(A.jlo);
    for (int j = A.jlo; j < A.jhi; ++j) {
        asm volatile("s_barrier" ::: "memory");
        if (MODE == 1) {
            u32x4 oth;
#pragma unroll
            for (int e = 0; e < 4; ++e) oth[e] = (unsigned)__shfl_xor((int)kreg[e], 8);
            if (kch < 2) kreg = (kch == 0) ? rope8(kreg, oth, rc0, rc1, rs0, rs1, true) : rope8(oth, kreg, rc0, rc1, rs0, rs1, false);
        }
        *kdst = kreg; *vdst = vreg;
        if (j + 1 < A.jhi) ATT_LOAD(j + 1);
        BAR_L();
        if (j >= wlo && j <= whi) {
            const int ks = A.kbase + 64 * j;
            f32x16 p0, p1;
            if (MODE == 0) { const float* fk = A.Fl + ks + 4 * hi;
#pragma unroll
                for (int g4 = 0; g4 < 4; ++g4) { const f32x4 a = *(const f32x4*)(fk + 8 * g4), b = *(const f32x4*)(fk + 32 + 8 * g4);
#pragma unroll
                    for (int e = 0; e < 4; ++e) { p0[4 * g4 + e] = flq - a[e]; p1[4 * g4 + e] = flq - b[e]; } }
            } else {
#pragma unroll
                for (int r = 0; r < 16; ++r) { p0[r] = 0.f; p1[r] = 0.f; } }
            { const LAS unsigned char* kb = lds + LDS_K + hi * 1024 + r32 * 16;
#pragma unroll
              for (int d0 = 0; d0 < 4; ++d0) { const bf16x8 b0 = *(const LAS bf16x8*)(kb + d0 * 2048), b1 = *(const LAS bf16x8*)(kb + d0 * 2048 + 512);
                  p0 = __builtin_amdgcn_mfma_f32_32x32x16_bf16(b0, qr[d0], p0, 0, 0, 0); p1 = __builtin_amdgcn_mfma_f32_32x32x16_bf16(b1, qr[d0], p1, 0, 0, 0); } }
            if (MODE == 0) {
                if (ks + 63 > qw0) {
#pragma unroll
                    for (int r = 0; r < 16; ++r) { const int kv = ks + crow(r, hi); if (kv > qi) p0[r] = NEG; if (kv + 32 > qi) p1[r] = NEG; } }
            } else {
#pragma unroll
                for (int r = 0; r < 16; ++r) { const int d = qi - (ks + crow(r, hi)); if (d < 0 || d > 128) p0[r] = NEG; if (d - 32 < 0 || d - 32 > 128) p1[r] = NEG; }
            }
            float rm = fmaxf(p0[0], p1[0]);
#pragma unroll
            for (int r = 1; r < 16; ++r) rm = fmaxf(rm, fmaxf(p0[r], p1[r]));
            { auto rr = __builtin_amdgcn_permlane32_swap(__float_as_uint(rm), __float_as_uint(rm), false, false); rm = fmaxf(__uint_as_float(rr[0]), __uint_as_float(rr[1])); }
            const float mn = fmaxf(m, rm), f = fast_exp2(m - mn); m = mn;
            float ps = 0.f;
#pragma unroll
            for (int r = 0; r < 16; ++r) { p0[r] = fast_exp2(p0[r] - mn); p1[r] = fast_exp2(p1[r] - mn); ps += p0[r] + p1[r]; }
            l = l * f + ps;
            if (hi == 0) wsf[r32] = f;
            f32x4 fr[4];
#pragma unroll
            for (int g4 = 0; g4 < 4; ++g4) fr[g4] = *(const LAS f32x4*)(wsf + 8 * g4 + 4 * hi);
#pragma unroll
            for (int r = 0; r < 16; ++r) { o0[r] *= fr[r >> 2][r & 3]; o1[r] *= fr[r >> 2][r & 3]; }
            u32x4 pw[4];
#pragma unroll
            for (int e = 0; e < 4; ++e) { pw[0][e] = cvt_pk_bf16(p0[2 * e], p0[2 * e + 1]); pw[1][e] = cvt_pk_bf16(p0[8 + 2 * e], p0[9 + 2 * e]);
                                          pw[2][e] = cvt_pk_bf16(p1[2 * e], p1[2 * e + 1]); pw[3][e] = cvt_pk_bf16(p1[8 + 2 * e], p1[9 + 2 * e]); }
            const LAS unsigned char* vp = lds + LDS_V + ((lane >> 4) & 1) * 32 + (lane & 3) * 8 + (4 * hi + ((lane & 15) >> 2)) * 64;
#pragma unroll
            for (int k4 = 0; k4 < 4; ++k4) {
                const s16x4 a0 = vtr(vp + k4 * 1024), a1 = vtr(vp + k4 * 1024 + 512), b0 = vtr(vp + 4096 + k4 * 1024), b1 = vtr(vp + 4096 + k4 * 1024 + 512);
                const bf16x8 v0 = (bf16x8){a0[0], a0[1], a0[2], a0[3], a1[0], a1[1], a1[2], a1[3]}, v1 = (bf16x8){b0[0], b0[1], b0[2], b0[3], b1[0], b1[1], b1[2], b1[3]};
                o0 = __builtin_amdgcn_mfma_f32_32x32x16_bf16(__builtin_bit_cast(bf16x8, pw[k4]), v0, o0, 0, 0, 0);
                o1 = __builtin_amdgcn_mfma_f32_32x32x16_bf16(__builtin_bit_cast(bf16x8, pw[k4]), v1, o1, 0, 0, 0);
            }
        }
    }
#undef ATT_LOAD
    { auto rr = __builtin_amdgcn_permlane32_swap(__float_as_uint(l), __float_as_uint(l), false, false); l = __uint_as_float(rr[0]) + __uint_as_float(rr[1]); }
    if (hi == 0) wsf[r32] = 1.0f / l;
    f32x4 fr[4];
#pragma unroll
    for (int g4 = 0; g4 < 4; ++g4) fr[g4] = *(const LAS f32x4*)(wsf + 8 * g4 + 4 * hi);
#pragma unroll
    for (int r = 0; r < 16; ++r) { const long row = (long)(qw0 + crow(r, hi)) * A.ors; const float s = fr[r >> 2][r & 3];
        if (MODE == 0) { A.Ob[row + r32] = (bf16_t)(cvt_pk_bf16(o0[r] * s, 0.f) & 0xffffu); A.Ob[row + 32 + r32] = (bf16_t)(cvt_pk_bf16(o1[r] * s, 0.f) & 0xffffu); }
        else { A.Of[row + r32] = o0[r] * s; A.Of[row + 32 + r32] = o1[r] * s; } }
    if (MODE == 1) { if (hi == 0) A.lse[(long)qi * A.lrs] = m + log2f(l); }
}
}

constexpr int NPH_PRO = 2, NPH_LAYER = 12, NPHASE = NPH_PRO + DEPTH * NPH_LAYER;
constexpr int TR_ITEMS = 37632;
constexpr int MIX_FOX = 256, MIX_DIL = 384, MIX_SGU = 256, MIX_CONV = 256, MIX_UNITS = MIX_FOX + MIX_DIL + MIX_SGU + MIX_CONV;
__constant__ double c_rope_inv[8] = {1.0, 0.19392274474868576, 0.03760603093086393, 0.007292664737217109, 0.001414213562373095, 0.0002742481756762073, 5.318295896944988e-05, 1.031338537721246e-05};

__device__ __forceinline__ void sincos_d(double x, float& sn, float& cs) {
    const double q = rint(x * 0.63661977236758134308);
    const double r = (x - q * 1.57079632679489655800e+00) - q * 6.12323399573676603587e-17;
    const int qi = ((int)q) & 3;
    const double r2 = r * r;
    double s = r * (1.0 + r2 * (-1.0 / 6 + r2 * (1.0 / 120 + r2 * (-1.0 / 5040 + r2 * (1.0 / 362880 + r2 * (-1.0 / 39916800 + r2 * (1.0 / 6227020800.0)))))));
    double c = 1.0 + r2 * (-0.5 + r2 * (1.0 / 24 + r2 * (-1.0 / 720 + r2 * (1.0 / 40320 + r2 * (-1.0 / 3628800 + r2 * (1.0 / 479001600.0 + r2 * (-1.0 / 87178291200.0)))))));
    double so = (qi == 0) ? s : (qi == 1) ? c : (qi == 2) ? -s : -c;
    double co = (qi == 0) ? c : (qi == 1) ? -s : (qi == 2) ? -c : s;
    sn = (float)so; cs = (float)co;
}

__global__ void __launch_bounds__(512, 2) mk_fwd(Args args) {
    extern __shared__ __attribute__((aligned(16))) unsigned char lds_raw[];
    LAS unsigned char* lds = (LAS unsigned char*)lds_raw;
    volatile LAS unsigned* MISC = (volatile LAS unsigned*)(lds + MISC_OFF);
    const int tid0 = threadIdx.x;
    const int G = gridDim.x, bx = blockIdx.x, NGW = G * 8;
#define ws (args.ws)
    unsigned* ctl = (unsigned*)(ws + WS_CTL);
    for (int u = tid0; u < (LDS_BYTES - RING_BYTES) / 4; u += 512) ((LAS unsigned*)(lds + RING_BYTES))[u] = 0u;
    __syncthreads();
    XcdBarrier bar = xcd_barrier_post(ctl + CW_BAR + args.li * XCD_BAR_WORDS, MISC + 8);
    const int lo = args.ph_lo, hi = args.ph_hi;
#define IN(k) (lo <= (k) && (k) < hi)
#define SEAM(k) do { if (IN(k) && IN((k) + 1)) xcd_barrier(bar); } while (0)
#define x_in (args.in[0])
#define p_in (args.in[1])
#define pos_in ((const int*)args.in[2])
#define norm_mix_g (args.in[3])
#define w_in (args.in[4])
#define fox_b (args.in[5])
#define scw (args.in[6])
#define sgu_g (args.in[7])
#define sgu_w (args.in[8])
#define sgu_b (args.in[9])
#define w_br_fox (args.in[10])
#define w_br_conv (args.in[11])
#define w_br_sgu (args.in[12])
#define w_br_dil (args.in[13])
#define w_out (args.in[14])
#define norm_ffn_g (args.in[15])
#define w_up (args.in[16])
#define ffn_cw (args.in[17])
#define w_down (args.in[18])
#define norm_ple_g (args.in[19])
#define w_pg (args.in[20])
#define w_pe (args.in[21])
#define final_g (args.in[22])
#define X (args.out)
#define WFG ((float*)(ws + WS_SMALL + SM_WFG))
#define SGUW ((bf16_t*)(ws + WS_SMALL + SM_SGUW))
#define ROPE ((float*)(ws + WS_SMALL + SM_ROPE))
#define LOGF ((float*)(ws + WS_SMALL + SM_LOGF))
#define FL ((float*)(ws + WS_SMALL + SM_FL))
#define LSE ((float*)(ws + WS_SMALL + SM_LSE))
#define PB ((bf16_t*)(ws + WS_PB))
#define PP ((bf16_t*)(ws + WS_PP))
#define XN ((bf16_t*)(ws + WS_XN))
#define PROJ ((bf16_t*)(ws + WS_PROJ))
#define UP ((bf16_t*)(ws + WS_PROJ))
#define HID ((bf16_t*)(ws + WS_HID))
#define OCAT ((bf16_t*)(ws + WS_OCAT))
#define MG ((bf16_t*)(ws + WS_MG))
#define ODIL ((float*)(ws + WS_ODIL))

    if (IN(0)) {
        const int tid = tid0, lane = tid & 63, wave = __builtin_amdgcn_readfirstlane(tid >> 6), gw = bx * 8 + wave;
        LAS float* scr = (LAS float*)(lds + wave * 16384);
        for (int it = gw; it < DEPTH * TR_ITEMS; it += NGW) {
            const int L = it / TR_ITEMS; int r = it % TR_ITEMS;
            unsigned char* wl = ws + WS_WL + (size_t)L * WL_STRIDE;
            const float* win = w_in + (size_t)L * DM * DIN_SRC;
            if (r < 1536) { transpose_item(win, DIN_SRC, 0, norm_mix_g + L * DM, (bf16_t*)(wl + WL_IN), DM, 0, 0, scr, r / 48, r % 48, lane); continue; } r -= 1536;
            if (r < 13056) { transpose_item(win, DIN_SRC, 1544, norm_mix_g + L * DM, (bf16_t*)(wl + WL_IN), DM, 1536, 0, scr, r / 408, r % 408, lane); continue; } r -= 13056;
            if (r < 512) { transpose_item(w_br_fox + (size_t)L * 512 * DM, DM, 0, nullptr, (bf16_t*)(wl + WL_BR), OC_W, 0, OC_A, scr, r / 64, r % 64, lane); continue; } r -= 512;
            if (r < 512) { transpose_item(w_br_conv + (size_t)L * 512 * DM, DM, 0, nullptr, (bf16_t*)(wl + WL_BR), OC_W, 0, OC_B, scr, r / 64, r % 64, lane); continue; } r -= 512;
            if (r < 512) { transpose_item(w_br_sgu + (size_t)L * 512 * DM, DM, 0, nullptr, (bf16_t*)(wl + WL_BR), OC_W, 0, OC_C, scr, r / 64, r % 64, lane); continue; } r -= 512;
            if (r < 256) { transpose_item(w_br_dil + (size_t)L * 256 * DM, DM, 0, nullptr, (bf16_t*)(wl + WL_BR), OC_W, 0, OC_D, scr, r / 64, r % 64, lane); continue; } r -= 256;
            if (r < 2048) { transpose_item(w_out + (size_t)L * DM * DM, DM, 0, nullptr, (bf16_t*)(wl + WL_OUT), DM, 0, 0, scr, r / 64, r % 64, lane); continue; } r -= 2048;
            if (r < 11264) { transpose_item(w_up + (size_t)L * DM * 2 * DFF, 2 * DFF, 0, norm_ffn_g + L * DM, (bf16_t*)(wl + WL_UP), DM, 0, 0, scr, r / 352, r % 352, lane); continue; } r -= 11264;
            if (r < 5632) { transpose_item(w_down + (size_t)L * DFF * DM, DM, 0, nullptr, (bf16_t*)(wl + WL_DN), DFF, 0, 0, scr, r / 64, r % 64, lane); continue; } r -= 5632;
            if (r < 2048) { transpose_item(w_pg + (size_t)L * DM * DM, DM, 0, norm_ple_g + L * DM, (bf16_t*)(wl + WL_PG), DM, 0, 0, scr, r / 64, r % 64, lane); continue; } r -= 2048;
            transpose_item(w_pe + (size_t)L * PLE * DM, DM, 0, nullptr, (bf16_t*)(wl + WL_PE), PLE, 0, 0, scr, r / 64, r % 64, lane);
        }
        const int gt = bx * 512 + tid, NGT = G * 512;
        for (int i = gt; i < DEPTH * 8 * DM; i += NGT) { const int L = i / (8 * DM), h = (i / DM) % 8, k = i % DM;
            WFG[i] = norm_mix_g[L * DM + k] * w_in[(size_t)L * DM * DIN_SRC + (size_t)k * DIN_SRC + 1536 + h]; }
        for (int i = gt; i < DEPTH * 4 * 128 * 128; i += NGT) { const int t = (i >> 7) & 127, s = i & 127; SGUW[i] = (s <= t) ? (bf16_t)(cvt_pk_bf16(sgu_w[i], 0.f) & 0xffffu) : (bf16_t)0; }
        for (int i = gt; i < M * 8; i += NGT) { const int row = i >> 3, jj = i & 7; float sn, cs; sincos_d((double)pos_in[row] * c_rope_inv[jj], sn, cs); ROPE[row * 16 + jj] = cs; ROPE[row * 16 + 8 + jj] = sn; }
        for (int i = gt; i < DEPTH * M * PLE / 8; i += NGT) { const f32x4 a = ((const f32x4*)p_in)[2 * i], b = ((const f32x4*)p_in)[2 * i + 1];
            u32x4 w; w.x = cvt_pk_bf16(a.x, a.y); w.y = cvt_pk_bf16(a.z, a.w); w.z = cvt_pk_bf16(b.x, b.y); w.w = cvt_pk_bf16(b.z, b.w); ((u32x4*)PB)[i] = w; }
    }
    SEAM(0);
    if (IN(1)) {
        const int tid = tid0, lane = tid & 63, wave = __builtin_amdgcn_readfirstlane(tid >> 6), gw = bx * 8 + wave;
        for (int L = 0; L < DEPTH; ++L) {
            pg8::Gemm g{PB + (size_t)L * M * PLE, (const bf16_t*)(ws + WS_WL + (size_t)L * WL_STRIDE + WL_PE), M, DM, PLE}; pg8::StaticOrder S; S.init(M, DM, G, bx);
            pg8::EpiPlain E{PP + (size_t)L * M * DM, DM};
            pg8::gemm_phase(lds, g, S, E, pg8::NoHook{});
        }
        __syncthreads();
        norm_phase<true, false>(x_in, XN, WFG, fox_b, LOGF, nullptr, nullptr, lds, gw, NGW, lane, tid);
    }
    SEAM(1);

    for (int L = 0; L < DEPTH; ++L) {
        int tid = tid0; asm volatile("" : "+v"(tid));
        const int lane = tid & 63, wave = __builtin_amdgcn_readfirstlane(tid >> 6), gw = bx * 8 + wave;
        const int pb = NPH_PRO + L * NPH_LAYER;
        unsigned char* wl = ws + WS_WL + (size_t)L * WL_STRIDE;
        const float* xres = (L == 0) ? x_in : X;
        if (IN(pb + 0)) {
            if (bx >= 32 && bx < 48 && G >= 48) {
                const int seq = bx - 32, b = seq >> 3, h = seq & 7; float v[8], run = 0.f;
#pragma unroll
                for (int e = 0; e < 8; ++e) { run += LOGF[(size_t)(b * SEQ + tid * 8 + e) * 8 + h]; v[e] = run; }
                float inc = run;
#pragma unroll
                for (int o = 1; o < 64; o <<= 1) { const float t = __shfl_up(inc, o); if (lane >= o) inc += t; }
                LAS float* wt = (LAS float*)lds;
                if (lane == 63) wt[wave] = inc;
                __syncthreads();
                float base = inc - run;
                for (int w = 0; w < wave; ++w) base += wt[w];
#pragma unroll
                for (int e = 0; e < 8; ++e) FL[seq * SEQ + tid * 8 + e] = (base + v[e]) * LOG2E;
                __syncthreads();
            }
            pg8::Gemm g{XN, (const bf16_t*)(wl + WL_IN), M, DIN, DM}; pg8::StaticOrder S; S.init(M, DIN, G, bx);
            pg8::EpiProj E{PROJ, DIN};
            pg8::gemm_phase(lds, g, S, E, pg8::NoHook{});
        }
        SEAM(pb + 0);
        if (IN(pb + 1)) {
            unsigned* qhead = ctl + CW_Q + 64 * L;
            for (;;) {
                __syncthreads();
                if (tid == 0) *(volatile LAS unsigned*)(lds + att::LDS_QW) = __hip_atomic_fetch_add(qhead, 1u, __ATOMIC_RELAXED, __HIP_MEMORY_SCOPE_AGENT);
                __syncthreads();
                int u = (int)*(volatile LAS unsigned*)(lds + att::LDS_QW);
                if (u >= MIX_UNITS) break;
                if (u < MIX_FOX) {
                    const int qb = 15 - (u >> 4), bh = u & 15, b = bh >> 3, h = bh & 7;
                    att::AttnArgs A; const size_t r0 = (size_t)b * SEQ * DIN;
                    A.Q = PROJ + r0 + PC_AQ + h * 64; A.K = PROJ + r0 + PC_AK + h * 64; A.V = PROJ + r0 + PC_AV + h * 64; A.rs = DIN;
                    A.q0 = qb * 256; A.kbase = 0; A.jlo = 0; A.jhi = 4 * (qb + 1); A.Fl = FL + bh * SEQ; A.rope = nullptr; A.rrs = 0;
                    A.Ob = OCAT + (size_t)b * SEQ * OC_W + OC_A + h * 64; A.Of = nullptr; A.ors = OC_W; A.lse = nullptr; A.lrs = 0;
                    att::attn_unit<0>(lds, A);
                } else if (u < MIX_FOX + MIX_DIL) {
                    u -= MIX_FOX; const int grp = u >> 7, v = u & 127; const int sh = 2 * grp, dil = 1 << sh;
                    const int nqb = 16 >> sh; const int qb = v % nqb; int t = v / nqb; const int slot = t & 3; t >>= 2; const int res = t % dil; const int b = t / dil;
                    const int head = grp * 4 + slot; const size_t row0 = (size_t)b * SEQ + res;
                    att::AttnArgs A;
                    A.Q = PROJ + row0 * DIN + PC_DQ + head * 64; A.K = PROJ + row0 * DIN + PC_DK + head * 64; A.V = PROJ + row0 * DIN + PC_DV + head * 64; A.rs = (long)DIN * dil;
                    A.q0 = qb * 256; A.kbase = qb * 256 - 128; A.jlo = (qb == 0) ? 2 : 0; A.jhi = 6; A.Fl = nullptr; A.rope = ROPE + row0 * 16; A.rrs = 16L * dil;
                    A.Ob = nullptr; A.Of = ODIL + ((size_t)grp * M + row0) * 256 + slot * 64; A.ors = 256L * dil; A.lse = LSE + ((size_t)grp * M + row0) * 4 + slot; A.lrs = 4L * dil;
                    att::attn_unit<1>(lds, A);
                } else if (u < MIX_FOX + MIX_DIL + MIX_SGU) {
                    u -= MIX_FOX + MIX_DIL; const int g = u & 3, c = (u >> 2) & 31, b = u >> 7; const size_t row0 = (size_t)b * SEQ + c * 128;
                    const int row = tid >> 2, part = tid & 3;
                    const bf16_t* vrow = PROJ + (row0 + row) * DIN + PC_SV;
                    float ss = 0.f;
#pragma unroll
                    for (int i = 0; i < 16; ++i) { const u32x4 w = *(const u32x4*)(vrow + part * 128 + 8 * i);
                        ss += (bf_lo(w.x) * bf_lo(w.x) + bf_hi(w.x) * bf_hi(w.x)) + (bf_lo(w.y) * bf_lo(w.y) + bf_hi(w.y) * bf_hi(w.y)) + (bf_lo(w.z) * bf_lo(w.z) + bf_hi(w.z) * bf_hi(w.z)) + (bf_lo(w.w) * bf_lo(w.w) + bf_hi(w.w) * bf_hi(w.w)); }
                    ss += __shfl_xor(ss, 1); ss += __shfl_xor(ss, 2);
                    const float rinv = 1.0f / sqrtf(ss * (1.0f / 512.0f) + EPS);
                    const float* gsn = sgu_g + L * 512 + 128 * g + 32 * part;
#pragma unroll
                    for (int i = 0; i < 4; ++i) { const u32x4 w = *(const u32x4*)(vrow + 128 * g + 32 * part + 8 * i); const f32x4 ga = *(const f32x4*)(gsn + 8 * i), gb = *(const f32x4*)(gsn + 8 * i + 4);
                        u32x4 o; o.x = cvt_pk_bf16(bf_lo(w.x) * rinv * ga.x, bf_hi(w.x) * rinv * ga.y); o.y = cvt_pk_bf16(bf_lo(w.y) * rinv * ga.z, bf_hi(w.y) * rinv * ga.w);
                        o.z = cvt_pk_bf16(bf_lo(w.z) * rinv * gb.x, bf_hi(w.z) * rinv * gb.y); o.w = cvt_pk_bf16(bf_lo(w.w) * rinv * gb.z, bf_hi(w.w) * rinv * gb.w);
                        *(LAS u32x4*)(lds + att::LDS_SV + part * 8192 + row * 64 + i * 16) = o; }
                    BAR_L();
                    const int r32 = lane & 31, hh = lane >> 5, tb = wave & 3, dp = wave >> 2;
                    f32x16 o0, o1;
#pragma unroll
                    for (int r = 0; r < 16; ++r) { o0[r] = 0.f; o1[r] = 0.f; }
                    const bf16_t* wrow = SGUW + ((size_t)(L * 4 + g) * 128 + 32 * tb + r32) * 128 + 8 * hh;
                    const LAS unsigned char* vp = lds + att::LDS_SV + (2 * dp) * 8192 + ((lane >> 4) & 1) * 32 + (lane & 3) * 8 + (8 * hh + ((lane & 15) >> 2)) * 64;
                    for (int i = 0; i < 2 * tb + 2; ++i) {
                        const bf16x8 a = *(const bf16x8*)(wrow + 16 * i);
                        const s16x4 a0 = att::vtr(vp + i * 1024), a1 = att::vtr(vp + i * 1024 + 256), b0 = att::vtr(vp + 8192 + i * 1024), b1 = att::vtr(vp + 8192 + i * 1024 + 256);
                        const bf16x8 v0 = (bf16x8){a0[0], a0[1], a0[2], a0[3], a1[0], a1[1], a1[2], a1[3]}, v1 = (bf16x8){b0[0], b0[1], b0[2], b0[3], b1[0], b1[1], b1[2], b1[3]};
                        o0 = __builtin_amdgcn_mfma_f32_32x32x16_bf16(a, v0, o0, 0, 0, 0); o1 = __builtin_amdgcn_mfma_f32_32x32x16_bf16(a, v1, o1, 0, 0, 0);
                    }
#pragma unroll
                    for (int r = 0; r < 16; ++r) { const int t = 32 * tb + att::crow(r, hh); const size_t gr = row0 + t; const float bias = sgu_b[(L * 4 + g) * 128 + t];
                        const int d = 128 * g + 64 * dp + r32;
                        const float u0 = bf1(PROJ[gr * DIN + PC_SU + d]), u1 = bf1(PROJ[gr * DIN + PC_SU + d + 32]);
                        OCAT[gr * OC_W + OC_C + d] = (bf16_t)(cvt_pk_bf16(u0 * (o0[r] + bias), 0.f) & 0xffffu); OCAT[gr * OC_W + OC_C + d + 32] = (bf16_t)(cvt_pk_bf16(u1 * (o1[r] + bias), 0.f) & 0xffffu); }
                } else {
                    u -= MIX_FOX + MIX_DIL + MIX_SGU;
                    for (int it = 0; it < 4; ++it) { const int idx = tid + 512 * it, row = 32 * u + (idx >> 6), c = (idx & 63) * 8, t = row & (SEQ - 1);
                        const bf16_t* pr = PROJ + (size_t)row * DIN; float y[3][8];
#pragma unroll
                        for (int k = 0; k < 3; ++k) { const int dt = 2 - k;
                            if (t - dt >= 0) { const u32x4 a = *(const u32x4*)(pr - (size_t)dt * DIN + PC_XB + c), g2 = *(const u32x4*)(pr - (size_t)dt * DIN + PC_GC + c);
                                y[k][0] = bf_lo(a.x) * bf_lo(g2.x); y[k][1] = bf_hi(a.x) * bf_hi(g2.x); y[k][2] = bf_lo(a.y) * bf_lo(g2.y); y[k][3] = bf_hi(a.y) * bf_hi(g2.y);
                                y[k][4] = bf_lo(a.z) * bf_lo(g2.z); y[k][5] = bf_hi(a.z) * bf_hi(g2.z); y[k][6] = bf_lo(a.w) * bf_lo(g2.w); y[k][7] = bf_hi(a.w) * bf_hi(g2.w); }
                            else {
#pragma unroll
                                for (int e = 0; e < 8; ++e) y[k][e] = 0.f; } }
                        const u32x4 gb = *(const u32x4*)(pr + PC_GB + c); float gbf[8] = {bf_lo(gb.x), bf_hi(gb.x), bf_lo(gb.y), bf_hi(gb.y), bf_lo(gb.z), bf_hi(gb.z), bf_lo(gb.w), bf_hi(gb.w)};
                        const float* wk = scw + (size_t)L * 3 * 512 + c; float o[8];
#pragma unroll
                        for (int e = 0; e < 8; ++e) o[e] = gbf[e] * (wk[e] * y[0][e] + wk[512 + e] * y[1][e] + wk[1024 + e] * y[2][e]);
                        u32x4 w; w.x = cvt_pk_bf16(o[0], o[1]); w.y = cvt_pk_bf16(o[2], o[3]); w.z = cvt_pk_bf16(o[4], o[5]); w.w = cvt_pk_bf16(o[6], o[7]);
                        *(u32x4*)(OCAT + (size_t)row * OC_W + OC_B + c) = w; }
                }
            }
            __syncthreads();
        }
        SEAM(pb + 1);
        if (IN(pb + 2)) {
            for (int i = bx * 512 + tid; i < M * 4 * 8; i += G * 512) { const int d8 = i & 7, slot = (i >> 3) & 3, row = i >> 5;
                float l2[3], mx = -3.0e38f;
#pragma unroll
                for (int g = 0; g < 3; ++g) { l2[g] = LSE[((size_t)g * M + row) * 4 + slot]; mx = fmaxf(mx, l2[g]); }
                float wsum = 0.f, o[8];
#pragma unroll
                for (int e = 0; e < 8; ++e) o[e] = 0.f;
#pragma unroll
                for (int g = 0; g < 3; ++g) { const float w = fast_exp2(l2[g] - mx); wsum += w; const float* od = ODIL + ((size_t)g * M + row) * 256 + slot * 64 + d8 * 8;
                    const f32x4 a = *(const f32x4*)od, b = *(const f32x4*)(od + 4); o[0] += w * a.x; o[1] += w * a.y; o[2] += w * a.z; o[3] += w * a.w; o[4] += w * b.x; o[5] += w * b.y; o[6] += w * b.z; o[7] += w * b.w; }
                const float inv = 1.0f / wsum; u32x4 w; w.x = cvt_pk_bf16(o[0] * inv, o[1] * inv); w.y = cvt_pk_bf16(o[2] * inv, o[3] * inv); w.z = cvt_pk_bf16(o[4] * inv, o[5] * inv); w.w = cvt_pk_bf16(o[6] * inv, o[7] * inv);
                *(u32x4*)(OCAT + (size_t)row * OC_W + OC_D + slot * 64 + d8 * 8) = w; }
        }
        SEAM(pb + 2);
        if (IN(pb + 3)) {
            pg8::Gemm g{OCAT, (const bf16_t*)(wl + WL_BR), M, DM, OC_W}; pg8::StaticOrder S; S.init(M, DM, G, bx);
            pg8::EpiMerge E{MG, DM, PROJ + PC_G + 3 * 2048}; pg8::MergeHook H{PROJ + PC_G};
            pg8::gemm_phase(lds, g, S, E, H);
        }
        SEAM(pb + 3);
        if (IN(pb + 4)) {
            pg8::Gemm g{MG, (const bf16_t*)(wl + WL_OUT), M, DM, DM}; pg8::StaticOrder S; S.init(M, DM, G, bx);
            pg8::EpiResid E{xres, X, DM};
            pg8::gemm_phase(lds, g, S, E, pg8::NoHook{});
        }
        SEAM(pb + 4);
        if (IN(pb + 5)) norm_phase<false, false>(X, XN, nullptr, nullptr, nullptr, nullptr, nullptr, lds, gw, NGW, lane, tid);
        SEAM(pb + 5);
        if (IN(pb + 6)) {
            pg8::Gemm g{XN, (const bf16_t*)(wl + WL_UP), M, 2 * DFF, DM}; pg8::StaticOrder S; S.init(M, 2 * DFF, G, bx);
            pg8::EpiPlain E{UP, 2 * DFF};
            pg8::gemm_phase(lds, g, S, E, pg8::NoHook{});
        }
        SEAM(pb + 6);
        if (IN(pb + 7)) {
            const float* cw = ffn_cw + (size_t)L * 3 * 2 * DFF;
            for (int item = bx * 512 + tid; item < 512 * 704; item += G * 512) { const int rb = item / 704, c = (item % 704) * 8, row0 = rb * 16, t0 = row0 & (SEQ - 1);
                float wg[3][8], wv[3][8];
#pragma unroll
                for (int k = 0; k < 3; ++k) { const f32x4 a = *(const f32x4*)(cw + k * 2 * DFF + c), b = *(const f32x4*)(cw + k * 2 * DFF + c + 4), d = *(const f32x4*)(cw + k * 2 * DFF + DFF + c), e2 = *(const f32x4*)(cw + k * 2 * DFF + DFF + c + 4);
                    wg[k][0] = a.x; wg[k][1] = a.y; wg[k][2] = a.z; wg[k][3] = a.w; wg[k][4] = b.x; wg[k][5] = b.y; wg[k][6] = b.z; wg[k][7] = b.w;
                    wv[k][0] = d.x; wv[k][1] = d.y; wv[k][2] = d.z; wv[k][3] = d.w; wv[k][4] = e2.x; wv[k][5] = e2.y; wv[k][6] = e2.z; wv[k][7] = e2.w; }
                u32x4 g0, g1, v0, v1;
                if (t0 >= 2) { const bf16_t* p2 = UP + (size_t)(row0 - 2) * 2 * DFF + c; g0 = *(const u32x4*)p2; v0 = *(const u32x4*)(p2 + DFF); g1 = *(const u32x4*)(p2 + 2 * DFF); v1 = *(const u32x4*)(p2 + 3 * DFF); }
                else { g0 = g1 = v0 = v1 = (u32x4){0u, 0u, 0u, 0u}; }
                for (int r = 0; r < 16; ++r) { const bf16_t* pr = UP + (size_t)(row0 + r) * 2 * DFF + c; const u32x4 g2 = *(const u32x4*)pr, v2 = *(const u32x4*)(pr + DFF);
                    float o[8];
#pragma unroll
                    for (int e = 0; e < 4; ++e) {
                        const float ga = wg[0][2 * e] * bf_lo(g0[e]) + wg[1][2 * e] * bf_lo(g1[e]) + wg[2][2 * e] * bf_lo(g2[e]), gb2 = wg[0][2 * e + 1] * bf_hi(g0[e]) + wg[1][2 * e + 1] * bf_hi(g1[e]) + wg[2][2 * e + 1] * bf_hi(g2[e]);
                        const float va = wv[0][2 * e] * bf_lo(v0[e]) + wv[1][2 * e] * bf_lo(v1[e]) + wv[2][2 * e] * bf_lo(v2[e]), vb = wv[0][2 * e + 1] * bf_hi(v0[e]) + wv[1][2 * e + 1] * bf_hi(v1[e]) + wv[2][2 * e + 1] * bf_hi(v2[e]);
                        o[2 * e] = ga * sigmoid_f(ga) * va; o[2 * e + 1] = gb2 * sigmoid_f(gb2) * vb; }
                    u32x4 w; w.x = cvt_pk_bf16(o[0], o[1]); w.y = cvt_pk_bf16(o[2], o[3]); w.z = cvt_pk_bf16(o[4], o[5]); w.w = cvt_pk_bf16(o[6], o[7]);
                    *(u32x4*)(HID + (size_t)(row0 + r) * DFF + c) = w;
                    g0 = g1; v0 = v1; g1 = g2; v1 = v2; }
            }
        }
        SEAM(pb + 7);
        if (IN(pb + 8)) {
            pg8::Gemm g{HID, (const bf16_t*)(wl + WL_DN), M, DM, DFF}; pg8::StaticOrder S; S.init(M, DM, G, bx);
            pg8::EpiResid E{X, X, DM};
            pg8::gemm_phase(lds, g, S, E, pg8::NoHook{});
        }
        SEAM(pb + 8);
        if (IN(pb + 9)) norm_phase<false, false>(X, XN, nullptr, nullptr, nullptr, nullptr, nullptr, lds, gw, NGW, lane, tid);
        SEAM(pb + 9);
        if (IN(pb + 10)) {
            pg8::Gemm g{XN, (const bf16_t*)(wl + WL_PG), M, DM, DM}; pg8::StaticOrder S; S.init(M, DM, G, bx);
            pg8::EpiPle E{X, PP + (size_t)L * M * DM, DM};
            pg8::gemm_phase(lds, g, S, E, pg8::NoHook{});
        }
        SEAM(pb + 10);
        if (IN(pb + 11)) {
            if (L + 1 < DEPTH) norm_phase<true, false>(X, XN, WFG + (size_t)(L + 1) * 8 * DM, fox_b + (L + 1) * 8, LOGF, nullptr, nullptr, lds, gw, NGW, lane, tid);
            else norm_phase<false, true>(X, nullptr, nullptr, nullptr, nullptr, final_g, X, lds, gw, NGW, lane, tid);
        }
        SEAM(pb + 11);
    }
#undef IN
#undef SEAM
}
#undef x_in
#undef p_in
#undef pos_in
#undef norm_mix_g
#undef w_in
#undef fox_b
#undef scw
#undef sgu_g
#undef sgu_w
#undef sgu_b
#undef w_br_fox
#undef w_br_conv
#undef w_br_sgu
#undef w_br_dil
#undef w_out
#undef norm_ffn_g
#undef w_up
#undef ffn_cw
#undef w_down
#undef norm_ple_g
#undef w_pg
#undef w_pe
#undef final_g
#undef X
#undef WFG
#undef SGUW
#undef ROPE
#undef LOGF
#undef FL
#undef LSE
#undef PB
#undef PP
#undef XN
#undef PROJ
#undef UP
#undef HID
#undef OCAT
#undef MG
#undef ODIL
#undef ws

extern "C" void kernel_launch(void* const* d_in, const int* in_sizes, int n_in, void* d_out, int out_size, void* d_ws, size_t ws_size, hipStream_t stream) {
    static int grid = 0;
    if (grid == 0) {
        if (n_in != 23 || in_sizes[0] != M * DM || out_size != M * DM || ws_size < WS_END) { fprintf(stderr, "kernel_launch: unexpected shapes/workspace (n_in %d, ws %zu < %zu)\n", n_in, ws_size, (size_t)WS_END); grid = -1; return; }
        int dev = 0, cus = 0, per_cu = 0;
        if (hipGetDevice(&dev) != hipSuccess || hipDeviceGetAttribute(&cus, hipDeviceAttributeMultiprocessorCount, dev) != hipSuccess) { grid = -1; return; }
        if (hipFuncSetAttribute((const void*)mk_fwd, hipFuncAttributeMaxDynamicSharedMemorySize, LDS_BYTES) != hipSuccess) { fprintf(stderr, "kernel_launch: hipFuncSetAttribute failed\n"); grid = -1; return; }
        if (hipOccupancyMaxActiveBlocksPerMultiprocessor(&per_cu, (const void*)mk_fwd, 512, LDS_BYTES) != hipSuccess || per_cu < 1) fprintf(stderr, "kernel_launch: occupancy query says %d\n", per_cu);
        (void)hipGetLastError();
        grid = cus;
    }
    if (grid < 0) return;
    if (hipMemsetAsync((char*)d_ws + WS_CTL, 0, CTL_BYTES, stream) != hipSuccess) return;
    Args a{};
    for (int i = 0; i < 23; ++i) a.in[i] = (const float*)d_in[i];
    a.out = (float*)d_out; a.ws = (unsigned char*)d_ws; a.pad = 0;
    const int step = (MK_SPLIT > 0) ? MK_SPLIT : NPHASE;
    int li = 0;
    for (int lo = 0; lo < NPHASE; lo += step, ++li) {
        a.ph_lo = lo; a.ph_hi = (lo + step < NPHASE) ? lo + step : NPHASE; a.li = li;
        hipLaunchKernelGGL(mk_fwd, dim3(grid), dim3(512), LDS_BYTES, stream, a);
        if (hipPeekAtLastError() != hipSuccess) { fprintf(stderr, "kernel_launch: launch %d failed\n", li); break; }
    }
}
```

```cpp
#include <hip/hip_runtime.h>
#include <cstdio>
#include <cstdint>

#ifndef PROBE_PH
#define PROBE_PH -1
#endif
#ifndef MIX_PROBE
#define MIX_PROBE 0
#endif
#ifndef MK_SPLIT
#define MK_SPLIT 0
#endif

#define LAS __attribute__((address_space(3)))
#define GAS __attribute__((address_space(1)))
typedef unsigned short bf16_t;
typedef short bf16x8 __attribute__((ext_vector_type(8)));
typedef short s16x4 __attribute__((ext_vector_type(4)));
typedef float f32x2 __attribute__((ext_vector_type(2)));
typedef float f32x4 __attribute__((ext_vector_type(4)));
typedef float f32x16 __attribute__((ext_vector_type(16)));
typedef unsigned u32x2 __attribute__((ext_vector_type(2)));
typedef unsigned u32x4 __attribute__((ext_vector_type(4)));
typedef int v4i __attribute__((ext_vector_type(4)));


constexpr int NB = 2, SEQ = 4096, DM = 2048, DEPTH = 4, M = NB * SEQ;
constexpr int DIN_SRC = 14600, DIN = 14592;
constexpr int DFF = 5632, PLE = 256;
constexpr float EPS = 1e-6f;
constexpr float LOG2E = 1.4426950408889634f;
constexpr float C2 = 0.125f * LOG2E;
constexpr float WQ_MAX = 0.126f, WQ_INV = 127.0f / WQ_MAX, WQ_S = WQ_MAX / 127.0f;
constexpr int PC_AQ = 0, PC_AK = 512, PC_AV = 1024, PC_XB = 1536, PC_GB = 2048, PC_GC = 2560, PC_SU = 3072, PC_SV = 3584,
              PC_DQ = 4096, PC_DK = 4864, PC_DV = 5632, PC_G = 6400;
constexpr unsigned I8MASK = (3u << 4) | (7u << 22);
constexpr int N8T = __builtin_popcount(I8MASK), NBT = 25 - N8T, N8N = 8192 + N8T * 256;
constexpr int I8_UNITS = (32 + N8T) * 32, I8_V = N8T * 32, MIX_GEMM = 32;
static_assert(N8T == 5, "the unit deal below is written for five int8 value tiles");
__host__ __device__ __forceinline__ int nth_set(unsigned m, int k) { for (int i = 0; i < k; ++i) m &= m - 1u; return __builtin_ctz(m); }
constexpr int OC_W = 1792;
constexpr int OC_A = 0, OC_B = 512, OC_C = 1024, OC_D = 1536;

constexpr size_t MiB = 1u << 20;
constexpr size_t WS_CTL = 0, CTL_BYTES = (MK_SPLIT > 0) ? 2 * MiB : 64 * 1024;
constexpr size_t WS_WL = 2 * MiB;
constexpr size_t WL_IN = 0, WL_G8W = 32 * MiB  , WL_BR = 57 * MiB, WL_OUT = 64 * MiB, WL_UP = 72 * MiB, WL_DN = 116 * MiB, WL_PG = 138 * MiB, WL_PE = 146 * MiB, WL_STRIDE = 147 * MiB;
constexpr size_t WS_SMALL = WS_WL + 4 * WL_STRIDE;
constexpr size_t SM_WFG = 0, SM_SGUW = 256 * 1024, SM_ROPE = 768 * 1024, SM_LOGF = 1280 * 1024, SM_FL = 1536 * 1024, SM_LSE = 1792 * 1024, SM_SS = 2304 * 1024;
constexpr size_t WS_PB = WS_SMALL + 4 * MiB;
constexpr size_t WS_PP = WS_PB + 16 * MiB;
constexpr size_t WS_XN = WS_PP + 128 * MiB;
constexpr size_t WS_PROJ = WS_XN + 32 * MiB;
constexpr size_t WS_HID = WS_PROJ + 228 * MiB;
constexpr size_t WS_OCAT = WS_HID + 88 * MiB;
constexpr size_t WS_MG = WS_OCAT + 28 * MiB;
constexpr size_t WS_ODIL = WS_MG + 32 * MiB;
constexpr size_t WS_PART = WS_ODIL + 24 * MiB;
constexpr size_t WS_FOP = WS_PART + 2 * MiB;
constexpr size_t WS_FML = WS_FOP + 16 * MiB;
constexpr size_t WS_UPB = WS_FML + 1 * MiB;
constexpr size_t WS_XR = WS_UPB + 16 * MiB;
constexpr size_t WS_G8 = WS_XR + 64 * MiB;
constexpr size_t WS_XN8 = WS_G8 + 64 * MiB;
constexpr size_t WS_END = WS_XN8 + 16 * MiB;
constexpr int CW_BAR = 4096;
constexpr int CW_Q = 1024;

constexpr int LDS_BYTES = 147456;
constexpr int RING_BYTES = 131072;
constexpr int MISC_OFF = RING_BYTES + 320;

#define LDS_WAIT() asm volatile("s_waitcnt lgkmcnt(0)" ::: "memory")
#define VM_WAIT() asm volatile("s_waitcnt vmcnt(0)" ::: "memory")
#define BAR_L() asm volatile("s_waitcnt lgkmcnt(0)\n\ts_barrier" ::: "memory")
typedef __bf16 bf16x2_t __attribute__((ext_vector_type(2)));
__device__ __forceinline__ unsigned cvt_pk_bf16(float lo, float hi) { f32x2 v = {lo, hi}; bf16x2_t b = __builtin_convertvector(v, bf16x2_t); return __builtin_bit_cast(unsigned, b); }
__device__ __forceinline__ float ub0(unsigned u) { return (float)(u & 0xffu); }
__device__ __forceinline__ float ub1(unsigned u) { return (float)((u >> 8) & 0xffu); }
__device__ __forceinline__ float ub2(unsigned u) { return (float)((u >> 16) & 0xffu); }
__device__ __forceinline__ float ub3(unsigned u) { return (float)(u >> 24); }
__device__ __forceinline__ float bf_lo(unsigned u) { return __uint_as_float(u << 16); }
__device__ __forceinline__ float bf_hi(unsigned u) { return __uint_as_float(u & 0xffff0000u); }
__device__ __forceinline__ float bf1(bf16_t u) { return __uint_as_float(((unsigned)u) << 16); }
__device__ __forceinline__ float shx(float v, int mask, int lane) { return __int_as_float(__builtin_amdgcn_ds_bpermute((lane ^ mask) << 2, __float_as_int(v))); }
__device__ __forceinline__ unsigned shxu(unsigned v, int mask, int lane) { return (unsigned)__builtin_amdgcn_ds_bpermute((lane ^ mask) << 2, (int)v); }
__device__ __forceinline__ unsigned q8x4(float a, float b, float c, float d) {
    unsigned w = 0u;
    w = __builtin_amdgcn_cvt_pk_u8_f32(fminf(fmaxf(__builtin_rintf(a), -127.f), 127.f) + 128.f, 0, w); w = __builtin_amdgcn_cvt_pk_u8_f32(fminf(fmaxf(__builtin_rintf(b), -127.f), 127.f) + 128.f, 1, w);
    w = __builtin_amdgcn_cvt_pk_u8_f32(fminf(fmaxf(__builtin_rintf(c), -127.f), 127.f) + 128.f, 2, w); w = __builtin_amdgcn_cvt_pk_u8_f32(fminf(fmaxf(__builtin_rintf(d), -127.f), 127.f) + 128.f, 3, w);
    return w ^ 0x80808080u;
}
__device__ __forceinline__ float wave_max(float v, int lane) {
#pragma unroll
    for (int o = 1; o < 64; o <<= 1) v = fmaxf(v, shx(v, o, lane));
    return v;
}
__device__ __forceinline__ float wave_sum(float v, int lane) {
#pragma unroll
    for (int o = 1; o < 64; o <<= 1) v += shx(v, o, lane);
    return v;
}
__device__ __forceinline__ float fast_exp2(float x) { return __builtin_amdgcn_exp2f(x); }
__device__ __forceinline__ float fast_rcp(float x) { return __builtin_amdgcn_rcpf(x); }
__device__ __forceinline__ float sigmoid_f(float x) { return fast_rcp(1.0f + fast_exp2(-LOG2E * x)); }
__device__ __forceinline__ float gelu_tanh_f(float x) {
    const float z = 0.7978845608028654f * (x + 0.044715f * x * x * x);
    return x * fast_rcp(1.0f + fast_exp2(-2.0f * LOG2E * z));
}

namespace pg8 {
#define PG8_LAS __attribute__((address_space(3)))
constexpr int BM = 256, BK = 64, HALF = 128, HTB = HALF * BK * 2, STAGE_BYTES = 8 * HTB, NXCD = 8, WGM = 4;
__host__ __device__ __forceinline__ int lds_byte(int r, int c) { const int st = (r >> 4) * 2 + (c >> 5), rr = r & 15, cc = c & 31, ob = rr * 64 + cc * 2; return st * 1024 + (ob ^ (((ob >> 9) & 1) << 5)); }
__host__ __device__ __forceinline__ void stage_rc(int b, int& R, int& C) { const int st = b / 1024, sb = b % 1024, swz = sb ^ (((sb >> 9) & 1) << 5); R = (st >> 1) * 16 + swz / 64; C = (st & 1) * 32 + (swz % 64) / 2; }
__host__ __device__ __forceinline__ int perm32(int rho) { const int n = rho >> 4, i = rho & 15; return 8 * (i >> 2) + 4 * n + (i & 3); }
struct Unit { int pm, pn, kq; };
struct Gemm { const bf16_t* A; const bf16_t* Bt; int M, N, K; };
struct StaticOrder {
    int nM, nN, nwg, G, c;
    __host__ __device__ __forceinline__ void init(int M_, int N_, int G_, int c_) { nM = M_ / BM; nN = N_ / BM; nwg = nM * nN; G = G_; c = c_; }
    __host__ __device__ __forceinline__ bool next(int i, Unit& u) const { return map((long)i * G + c, u); }
    __host__ __device__ __forceinline__ bool map(long L, Unit& u) const {
        if (L >= nwg) return false;
        int wgid = (int)L; { const int q = nwg / NXCD, r = nwg % NXCD, xcd = wgid % NXCD, off = wgid / NXCD; wgid = (xcd < r ? xcd * (q + 1) : r * (q + 1) + (xcd - r) * q) + off; }
        const int nig = WGM * nN, gid = wgid / nig, fm = gid * WGM, gsz = (nM - fm) < WGM ? (nM - fm) : WGM;
        u.pm = fm + ((wgid % nig) % gsz); u.pn = (wgid % nig) / gsz; u.kq = 0; return true;
    }
    __device__ __forceinline__ void a_ready(const Unit&) const {}
    __device__ __forceinline__ void done(const Unit&) const {}
    __device__ __forceinline__ int nt(const Unit&, int K) const { return K / BK; }
    __device__ __forceinline__ size_t koff(const Unit&, int) const { return 0; }
};
struct OneUnit {
    int pm, pn;
    __device__ __forceinline__ bool next(int i, Unit& u) const { if (i != 0) return false; u.pm = pm; u.pn = pn; u.kq = 0; return true; }
    __device__ __forceinline__ void a_ready(const Unit&) const {}
    __device__ __forceinline__ void done(const Unit&) const {}
    __device__ __forceinline__ int nt(const Unit&, int K) const { return K / BK; }
    __device__ __forceinline__ size_t koff(const Unit&, int) const { return 0; }
};
struct ProjOrder {
    StaticOrder so;
    __device__ __forceinline__ void init(int M_, int N_, int G_, int c_) { so.init(M_, N_, G_, c_); }
    __device__ __forceinline__ bool next(int i, Unit& u) const { if (!so.next(i, u)) return false; u.pn = nth_set(~I8MASK & 0x1ffffffu, u.pn); return true; }
    __device__ __forceinline__ void a_ready(const Unit&) const {}
    __device__ __forceinline__ void done(const Unit&) const {}
    __device__ __forceinline__ int nt(const Unit&, int K) const { return K / BK; }
    __device__ __forceinline__ size_t koff(const Unit&, int) const { return 0; }
};
struct Gate8Order {
    StaticOrder so; int c;
    __device__ __forceinline__ void init(int M_, int N_, int G_, int c_) { so.init(M_, N_, G_, c_); c = c_; }
    __device__ __forceinline__ bool next(int i, Unit& u) const {
        if (so.G != 256) return so.next(i, u);
        long L;
        if (c < 128) { if (i == 0) L = c; else if (i < 4) L = I8_V + (i - 1) * 128 + c; else return false; }
        else { const int cc = c - 128;
            if (cc < 32) { if (i == 0) L = 128 + cc; else if (i < 5) L = I8_V + 384 + cc + 128 * (i - 1); else return false; }
            else { if (i < 5) L = I8_V + 384 + cc + 128 * i; else return false; } }
        return so.map(L, u);
    }
    __device__ __forceinline__ void a_ready(const Unit&) const {}
    __device__ __forceinline__ void done(const Unit&) const {}
    __device__ __forceinline__ int nt(const Unit&, int K) const { return K / BK; }
    __device__ __forceinline__ size_t koff(const Unit&, int) const { return 0; }
};
struct UpOrder {
    StaticOrder so; int G, c;
    __device__ __forceinline__ void init(int M_, int G_, int c_) { so.init(M_, 40 * BM, G_, c_); G = G_; c = c_; }
    __device__ __forceinline__ bool next(int i, Unit& u) const {
        if (so.next(i, u)) return true;
        const long L = (long)i * G + c - so.nwg; if (L < 0 || L >= 256) return false;
        const int tt = (int)L >> 1; u.pm = tt & 31; u.pn = 40 + (tt >> 5); u.kq = 1 + ((int)L & 1); return true;
    }
    __device__ __forceinline__ void a_ready(const Unit&) const {}
    __device__ __forceinline__ void done(const Unit&) const {}
    __device__ __forceinline__ int nt(const Unit& u, int K) const { return u.kq ? K / (2 * BK) : K / BK; }
    __device__ __forceinline__ size_t koff(const Unit& u, int K) const { return u.kq == 2 ? (size_t)K : 0; }
};
typedef f32x4 Acc[2][2][4][2];

template <int MODE> __device__ __forceinline__ void store_tile_bf16(const Acc& acc, bf16_t* O, int ldc, int row0, int col0) {
#pragma unroll
    for (int ai = 0; ai < 2; ++ai)
#pragma unroll
        for (int m = 0; m < 4; ++m) { bf16_t* rowp = O + (size_t)(row0 + ai * HALF + m * 16) * ldc + col0;
#pragma unroll
            for (int bj = 0; bj < 2; ++bj) { f32x4 v0 = acc[ai][bj][m][0], v1 = acc[ai][bj][m][1];
                if (MODE == 1) { v0 = v0 * C2; v1 = v1 * C2; }
                if (MODE == 2) {
#pragma unroll
                    for (int e = 0; e < 4; ++e) { v0[e] = gelu_tanh_f(v0[e]); v1[e] = gelu_tanh_f(v1[e]); } }
                if (MODE == 3) {
#pragma unroll
                    for (int e = 0; e < 4; ++e) { v0[e] = sigmoid_f(v0[e]); v1[e] = sigmoid_f(v1[e]); } }
                u32x4 w; w.x = cvt_pk_bf16(v0[0], v0[1]); w.y = cvt_pk_bf16(v0[2], v0[3]); w.z = cvt_pk_bf16(v1[0], v1[1]); w.w = cvt_pk_bf16(v1[2], v1[3]);
                *(u32x4*)(rowp + bj * HALF) = w; } }
}
struct NoHook { static constexpr bool ON = false; __device__ __forceinline__ void operator()(Acc&, const Unit&, int, int, int, int, int) const {} };
struct EpiPlain {
    static constexpr bool PERM = true, AFTER_DRAIN = false;
    bf16_t* O; int ldc;
    __device__ __forceinline__ void operator()(Acc& acc, const Unit& u, int wr, int wc, int fr, int fq) const {
        store_tile_bf16<0>(acc, O, ldc, u.pm * BM + wr * 64 + fr, u.pn * BM + wc * 32 + 8 * fq); }
};
struct EpiProj {
    static constexpr bool PERM = true, AFTER_DRAIN = false;
    bf16_t* O; int ldc; unsigned char* G; const float* RS;
    __device__ __forceinline__ void operator()(Acc& acc, const Unit& u, int wr, int wc, int fr, int fq) const {
        const int pn = u.pn, row0 = u.pm * BM + wr * 64 + fr, col0 = pn * BM + wc * 32 + 8 * fq;
#pragma unroll
        for (int ai = 0; ai < 2; ++ai)
#pragma unroll
            for (int m = 0; m < 4; ++m) { const float sc = RS[row0 + ai * HALF + m * 16];
#pragma unroll
                for (int bj = 0; bj < 2; ++bj) { acc[ai][bj][m][0] = acc[ai][bj][m][0] * sc; acc[ai][bj][m][1] = acc[ai][bj][m][1] * sc; } }
        if (pn < 2 || (pn >= 16 && pn < 19)) store_tile_bf16<1>(acc, O, ldc, row0, col0);
        else if (pn >= 12 && pn < 16) store_tile_bf16<2>(acc, O, ldc, row0, col0);
        else if (pn >= 25) {
            const int gc0 = col0 - PC_G;
#pragma unroll
            for (int ai = 0; ai < 2; ++ai)
#pragma unroll
                for (int m = 0; m < 4; ++m) { unsigned char* rowp = G + (size_t)(row0 + ai * HALF + m * 16) * 8192 + gc0;
#pragma unroll
                    for (int bj = 0; bj < 2; ++bj) { u32x2 w = {0u, 0u};
#pragma unroll
                        for (int e = 0; e < 4; ++e) { w.x = __builtin_amdgcn_cvt_pk_u8_f32(fmaxf(255.0f * sigmoid_f(acc[ai][bj][m][0][e]) + 0.5f, 1.0f), e, w.x);
                                                      w.y = __builtin_amdgcn_cvt_pk_u8_f32(fmaxf(255.0f * sigmoid_f(acc[ai][bj][m][1][e]) + 0.5f, 1.0f), e, w.y); }
                        *(u32x2*)(rowp + bj * HALF) = w; } }
        }
        else store_tile_bf16<0>(acc, O, ldc, row0, col0);
    }
};
__device__ __forceinline__ void row_scales(float (&rs)[2][4], const float* PART, int row0, int fr, int fq) {
    const int ln = fq * 16 + fr;
#pragma unroll
    for (int ai = 0; ai < 2; ++ai)
#pragma unroll
        for (int m = 0; m < 4; ++m) { const float* p = PART + (size_t)(row0 + ai * HALF + m * 16) * 32 + 8 * fq; const f32x4 a = *(const f32x4*)p, b = *(const f32x4*)(p + 4);
            float s = ((a.x + a.y) + (a.z + a.w)) + ((b.x + b.y) + (b.z + b.w)); s += shx(s, 16, ln); s += shx(s, 32, ln);
            rs[ai][m] = 1.0f / sqrtf(s * (1.0f / DM) + EPS); }
}
struct EpiUp8 {
    static constexpr bool PERM = true, AFTER_DRAIN = false;
    bf16_t* O; int ldc; const float* AS; const float* WS1; bf16_t* O2; int ldc2, c2;
    __device__ __forceinline__ void operator()(Acc& acc, const Unit& u, int wr, int wc, int fr, int fq) const {
        const int row0 = u.pm * BM + wr * 64 + fr; const float wqs = *WS1;
#pragma unroll
        for (int ai = 0; ai < 2; ++ai)
#pragma unroll
            for (int m = 0; m < 4; ++m) { const float sc = AS[row0 + ai * HALF + m * 16] * wqs;
#pragma unroll
                for (int bj = 0; bj < 2; ++bj)
#pragma unroll
                    for (int n = 0; n < 2; ++n) { const v4i a = __builtin_bit_cast(v4i, acc[ai][bj][m][n]); acc[ai][bj][m][n] = (f32x4){(float)a[0], (float)a[1], (float)a[2], (float)a[3]} * sc; } }
        if (u.kq == 2) store_tile_bf16<0>(acc, O2, ldc2, row0, u.pn * BM - c2 + wc * 32 + 8 * fq);
        else store_tile_bf16<0>(acc, O, ldc, row0, u.pn * BM + wc * 32 + 8 * fq); }
};
struct EpiGate8 {
    static constexpr bool PERM = true, AFTER_DRAIN = false;
    unsigned char* G; const float* AS; const float* WS1; bf16_t* O; int ldc;
    __device__ __forceinline__ void operator()(Acc& acc, const Unit& u, int wr, int wc, int fr, int fq) const {
        const int row0 = u.pm * BM + wr * 64 + fr; const float wqs = *WS1;
        if (u.pn < N8T) {
#pragma unroll
            for (int ai = 0; ai < 2; ++ai)
#pragma unroll
                for (int m = 0; m < 4; ++m) { const float sc = AS[row0 + ai * HALF + m * 16] * wqs;
#pragma unroll
                    for (int bj = 0; bj < 2; ++bj)
#pragma unroll
                        for (int n = 0; n < 2; ++n) { const v4i a = __builtin_bit_cast(v4i, acc[ai][bj][m][n]); acc[ai][bj][m][n] = (f32x4){(float)a[0], (float)a[1], (float)a[2], (float)a[3]} * sc; } }
            const int pt = nth_set(I8MASK, u.pn), col0 = pt * BM + wc * 32 + 8 * fq;
            if (pt < 2 || (pt >= 16 && pt < 19)) store_tile_bf16<1>(acc, O, ldc, row0, col0);
            else if (pt >= 12 && pt < 16) store_tile_bf16<2>(acc, O, ldc, row0, col0);
            else store_tile_bf16<0>(acc, O, ldc, row0, col0);
            return;
        }
        const int gc0 = (u.pn - N8T) * BM + wc * 32 + 8 * fq;
        float as8[2][4];
#pragma unroll
        for (int ai = 0; ai < 2; ++ai)
#pragma unroll
            for (int m = 0; m < 4; ++m) as8[ai][m] = AS[row0 + ai * HALF + m * 16];
#pragma unroll
        for (int ai = 0; ai < 2; ++ai)
#pragma unroll
            for (int m = 0; m < 4; ++m) { unsigned char* rowp = G + (size_t)(row0 + ai * HALF + m * 16) * 8192 + gc0; const float sc = -LOG2E * as8[ai][m] * wqs;
#pragma unroll
                for (int bj = 0; bj < 2; ++bj) { u32x2 w = {0u, 0u}; const v4i a0 = __builtin_bit_cast(v4i, acc[ai][bj][m][0]), a1 = __builtin_bit_cast(v4i, acc[ai][bj][m][1]);
#pragma unroll
                    for (int e = 0; e < 4; ++e) { w.x = __builtin_amdgcn_cvt_pk_u8_f32(fmaxf(__builtin_fmaf(255.0f, fast_rcp(1.0f + fast_exp2(sc * (float)a0[e])), 0.5f), 1.0f), e, w.x);
                                                  w.y = __builtin_amdgcn_cvt_pk_u8_f32(fmaxf(__builtin_fmaf(255.0f, fast_rcp(1.0f + fast_exp2(sc * (float)a1[e])), 0.5f), 1.0f), e, w.y); }
                    *(u32x2*)(rowp + bj * HALF) = w; } }
    }
};
struct EpiResidN {
    static constexpr bool PERM = true, AFTER_DRAIN = false;
    bf16_t* XR; float* SS;
    __device__ __forceinline__ void operator()(Acc& acc, const Unit& u, int wr, int wc, int fr, int fq) const {
        const int row0 = u.pm * BM + wr * 64 + fr, col0 = u.pn * BM + wc * 32 + 8 * fq;
#pragma unroll
        for (int ai = 0; ai < 2; ++ai) { u32x4 b[4][2];
#pragma unroll
            for (int m = 0; m < 4; ++m)
#pragma unroll
                for (int bj = 0; bj < 2; ++bj) b[m][bj] = *(const u32x4*)(XR + (size_t)(row0 + ai * HALF + m * 16) * DM + col0 + bj * HALF);
#pragma unroll
            for (int m = 0; m < 4; ++m) { const int row = row0 + ai * HALF + m * 16; float ss = 0.f;
#pragma unroll
                for (int bj = 0; bj < 2; ++bj) { const u32x4 x = b[m][bj];
                    const f32x4 v0 = (f32x4){bf_lo(x.x), bf_hi(x.x), bf_lo(x.y), bf_hi(x.y)} + acc[ai][bj][m][0], v1 = (f32x4){bf_lo(x.z), bf_hi(x.z), bf_lo(x.w), bf_hi(x.w)} + acc[ai][bj][m][1];
                    u32x4 w; w.x = cvt_pk_bf16(v0[0], v0[1]); w.y = cvt_pk_bf16(v0[2], v0[3]); w.z = cvt_pk_bf16(v1[0], v1[1]); w.w = cvt_pk_bf16(v1[2], v1[3]);
                    *(u32x4*)(XR + (size_t)row * DM + col0 + bj * HALF) = w;
                    ss += (v0[0] * v0[0] + v0[1] * v0[1]) + (v0[2] * v0[2] + v0[3] * v0[3]) + (v1[0] * v1[0] + v1[1] * v1[1]) + (v1[2] * v1[2] + v1[3] * v1[3]); }
                if (SS) { const int ln = fq * 16 + fr; ss += shx(ss, 16, ln); ss += shx(ss, 32, ln);
                    if (fq == 0) SS[(size_t)row * 32 + 4 * u.pn + wc] = ss; } }
            asm volatile("" ::: "memory"); }
    }
};
struct EpiPle {
    static constexpr bool PERM = true, AFTER_DRAIN = false;
    const bf16_t* XR; bf16_t* XO; const bf16_t* PP; const float* SS;
    __device__ __forceinline__ void operator()(Acc& acc, const Unit& u, int wr, int wc, int fr, int fq) const {
        const int row0 = u.pm * BM + wr * 64 + fr, col0 = u.pn * BM + wc * 32 + 8 * fq; float rs[2][4]; row_scales(rs, SS, row0, fr, fq);
#pragma unroll
        for (int ai = 0; ai < 2; ++ai)
#pragma unroll
            for (int mp = 0; mp < 2; ++mp) { u32x4 b[2][2], pp[2][2];
#pragma unroll
                for (int mm = 0; mm < 2; ++mm)
#pragma unroll
                    for (int bj = 0; bj < 2; ++bj) { const size_t off = (size_t)(row0 + ai * HALF + (2 * mp + mm) * 16) * DM + col0 + bj * HALF; b[mm][bj] = *(const u32x4*)(XR + off); pp[mm][bj] = *(const u32x4*)(PP + off); }
#pragma unroll
                for (int mm = 0; mm < 2; ++mm) { const float r = rs[ai][2 * mp + mm];
#pragma unroll
                    for (int bj = 0; bj < 2; ++bj) { const size_t off = (size_t)(row0 + ai * HALF + (2 * mp + mm) * 16) * DM + col0 + bj * HALF; const u32x4 x = b[mm][bj], p = pp[mm][bj];
                        const f32x4 a0 = acc[ai][bj][2 * mp + mm][0] * r, a1 = acc[ai][bj][2 * mp + mm][1] * r; u32x4 w;
                        w.x = cvt_pk_bf16(bf_lo(x.x) + sigmoid_f(a0[0]) * bf_lo(p.x), bf_hi(x.x) + sigmoid_f(a0[1]) * bf_hi(p.x)); w.y = cvt_pk_bf16(bf_lo(x.y) + sigmoid_f(a0[2]) * bf_lo(p.y), bf_hi(x.y) + sigmoid_f(a0[3]) * bf_hi(p.y));
                        w.z = cvt_pk_bf16(bf_lo(x.z) + sigmoid_f(a1[0]) * bf_lo(p.z), bf_hi(x.z) + sigmoid_f(a1[1]) * bf_hi(p.z)); w.w = cvt_pk_bf16(bf_lo(x.w) + sigmoid_f(a1[2]) * bf_lo(p.w), bf_hi(x.w) + sigmoid_f(a1[3]) * bf_hi(p.w));
                        *(u32x4*)(XO + off) = w; } }
                asm volatile("" ::: "memory"); }
    }
};
struct MergeHook {
    static constexpr bool ON = true;
    const unsigned char* G;
    __device__ __forceinline__ void operator()(Acc& acc, const Unit& u, int t, int wr, int wc, int fr, int fq) const {
        const int j = (t >> 3) - 1;
        unsigned off0 = (unsigned)((u.pm * BM + wr * 64 + fr) * 8192 + u.pn * BM + wc * 32 + 8 * fq);
        asm volatile("" : "+v"(off0));
        const unsigned char* gj = G + j * 2048;
#pragma unroll
        for (int ai = 0; ai < 2; ++ai) {
#pragma unroll
            for (int m = 0; m < 4; ++m) { const unsigned char* gp = gj + (off0 + (unsigned)((ai * HALF + m * 16) * 8192));
#pragma unroll
                for (int bj = 0; bj < 2; ++bj) { const u32x2 a = *(const u32x2*)(gp + bj * HALF), b = *(const u32x2*)(gp + 2048 + bj * HALF);
                    f32x4 r0, r1;
                    r0[0] = ub0(a.x) * fast_rcp(ub0(b.x)); r0[1] = ub1(a.x) * fast_rcp(ub1(b.x));
                    r0[2] = ub2(a.x) * fast_rcp(ub2(b.x)); r0[3] = ub3(a.x) * fast_rcp(ub3(b.x));
                    r1[0] = ub0(a.y) * fast_rcp(ub0(b.y)); r1[1] = ub1(a.y) * fast_rcp(ub1(b.y));
                    r1[2] = ub2(a.y) * fast_rcp(ub2(b.y)); r1[3] = ub3(a.y) * fast_rcp(ub3(b.y));
                    acc[ai][bj][m][0] = acc[ai][bj][m][0] * r0; acc[ai][bj][m][1] = acc[ai][bj][m][1] * r1; } }
            }
    }
};
struct EpiMerge {
    static constexpr bool PERM = true, AFTER_DRAIN = false;
    bf16_t* O; int ldc; const unsigned char* G3;
    __device__ __forceinline__ void operator()(Acc& acc, const Unit& u, int wr, int wc, int fr, int fq) const {
        const int row0 = u.pm * BM + wr * 64 + fr, col0 = u.pn * BM + wc * 32 + 8 * fq; const float s = 1.0f / 255.0f;
#pragma unroll
        for (int ai = 0; ai < 2; ++ai) { u32x2 g[4][2];
#pragma unroll
            for (int m = 0; m < 4; ++m)
#pragma unroll
                for (int bj = 0; bj < 2; ++bj) g[m][bj] = *(const u32x2*)(G3 + (size_t)(row0 + ai * HALF + m * 16) * 8192 + col0 + bj * HALF);
#pragma unroll
            for (int m = 0; m < 4; ++m)
#pragma unroll
                for (int bj = 0; bj < 2; ++bj) { const u32x2 gg = g[m][bj]; const f32x4 v0 = acc[ai][bj][m][0] * s, v1 = acc[ai][bj][m][1] * s;
                    u32x4 w; w.x = cvt_pk_bf16(v0[0] * ub0(gg.x), v0[1] * ub1(gg.x)); w.y = cvt_pk_bf16(v0[2] * ub2(gg.x), v0[3] * ub3(gg.x));
                    w.z = cvt_pk_bf16(v1[0] * ub0(gg.y), v1[1] * ub1(gg.y)); w.w = cvt_pk_bf16(v1[2] * ub2(gg.y), v1[3] * ub3(gg.y));
                    *(u32x4*)(O + (size_t)(row0 + ai * HALF + m * 16) * ldc + col0 + bj * HALF) = w; }
            asm volatile("" ::: "memory"); }
    }
};

template <class Epi, class Hook, class Sched, bool I8 = false>
__device__ __forceinline__ void gemm_phase(PG8_LAS unsigned char* lds, const Gemm g, const Sched& S, const Epi& E, const Hook& H, int tid) {
    asm volatile("" : "+v"(tid));
    const int wid = __builtin_amdgcn_readfirstlane(tid >> 6), lane = tid & 63, wr = wid >> 2, wc = wid & 3, fr = lane & 15, fq = lane >> 4;
    const int K = g.K;
    unsigned voffA[2], voffB[2];
#pragma unroll
    for (int i = 0; i < 2; ++i) { int R, C; stage_rc(tid * 16 + i * 8192, R, C); const int Rb = Epi::PERM ? ((R & ~31) + perm32(R & 31)) : R;
        voffA[i] = (unsigned)(R * K + C) * 2u; voffB[i] = (unsigned)(Rb * K + C) * 2u; }
    const size_t kstep = (size_t)(BK * 2);
    const size_t hstep = (size_t)HALF * K * 2;
    const size_t tstep = 2 * hstep;
    const unsigned ldsw = (unsigned)wid * 1024u;
    const int aoff = lds_byte(wr * 64 + fr, fq * 8), boff = lds_byte(wc * 32 + fr, fq * 8);
#define PG8_SA(b, h) (((b) * 2 + (h)) * HTB)
#define PG8_SB(b, h) ((4 + (b) * 2 + (h)) * HTB)
#define PG8_STAGE(bufoff, gbase, voff) do { _Pragma("unroll") for (int _i = 0; _i < 2; ++_i) \
        __builtin_amdgcn_global_load_lds((const unsigned*)((const char*)(gbase) + (voff)[_i]), (PG8_LAS unsigned*)(lds + (bufoff) + ldsw + _i * 8192), 16, 0, 0); } while (0)
#define PG8_LDA(dst, b, h) do { _Pragma("unroll") for (int m = 0; m < 4; ++m) _Pragma("unroll") for (int k = 0; k < 2; ++k) dst[m][k] = *(const PG8_LAS bf16x8*)(lds + PG8_SA(b, h) + aoff + m * 2048 + k * 1024); } while (0)
#define PG8_LDB(dst, b, h) do { _Pragma("unroll") for (int n = 0; n < 2; ++n) _Pragma("unroll") for (int k = 0; k < 2; ++k) dst[n][k] = *(const PG8_LAS bf16x8*)(lds + PG8_SB(b, h) + boff + n * 2048 + k * 1024); } while (0)
#define PG8_MMA(ai, bj, At, Bt) do { __builtin_amdgcn_s_setprio(1); _Pragma("unroll") for (int m = 0; m < 4; ++m) _Pragma("unroll") for (int n = 0; n < 2; ++n) _Pragma("unroll") for (int k = 0; k < 2; ++k) { \
        if constexpr (I8) acc[ai][bj][m][n] = __builtin_bit_cast(f32x4, __builtin_amdgcn_mfma_i32_16x16x64_i8(__builtin_bit_cast(v4i, Bt[n][k]), __builtin_bit_cast(v4i, At[m][k]), __builtin_bit_cast(v4i, acc[ai][bj][m][n]), 0, 0, 0)); \
        else acc[ai][bj][m][n] = __builtin_amdgcn_mfma_f32_16x16x32_bf16(Bt[n][k], At[m][k], acc[ai][bj][m][n], 0, 0, 0); } \
        __builtin_amdgcn_s_setprio(0); } while (0)
#define PG8_WAIT_V(n) asm volatile("s_waitcnt vmcnt(" #n ")" ::: "memory")
#define PG8_WAIT_L(n) asm volatile("s_waitcnt lgkmcnt(" #n ")" ::: "memory")
#define PG8_BAR __builtin_amdgcn_s_barrier()
#define PG8_SCHED __builtin_amdgcn_sched_barrier(0)
    Unit cur, nxt; int ui = 0;
    if (!S.next(0, cur)) return;
    Acc acc;
#pragma unroll
    for (int a = 0; a < 2; ++a)
#pragma unroll
        for (int b = 0; b < 2; ++b)
#pragma unroll
            for (int m = 0; m < 4; ++m)
#pragma unroll
                for (int n = 0; n < 2; ++n) acc[a][b][m][n] = (f32x4){0.f, 0.f, 0.f, 0.f};
    bf16x8 At[4][2], B0[2][2], B1[2][2];
    int nt = S.nt(cur, K);
    const char* cA = (const char*)g.A + (size_t)cur.pm * tstep + S.koff(cur, K); const char* cB = (const char*)g.Bt + (size_t)cur.pn * tstep + S.koff(cur, K);
    S.a_ready(cur);
    PG8_STAGE(PG8_SB(0, 0), cB, voffB); PG8_STAGE(PG8_SB(0, 1), cB + hstep, voffB); PG8_STAGE(PG8_SA(0, 0), cA, voffA); PG8_STAGE(PG8_SA(0, 1), cA + hstep, voffA);
    if (wr == 1) PG8_BAR;
    PG8_WAIT_V(2); PG8_BAR;
    PG8_STAGE(PG8_SB(1, 0), cB + kstep, voffB); PG8_STAGE(PG8_SA(1, 0), cA + kstep, voffA); PG8_STAGE(PG8_SB(1, 1), cB + hstep + kstep, voffB);
    PG8_WAIT_V(6); PG8_BAR;
    for (;;) {
        const bool has_next = S.next(ui + 1, nxt);
        const char* nA = has_next ? (const char*)g.A + (size_t)nxt.pm * tstep + S.koff(nxt, K) : cA; const char* nB = has_next ? (const char*)g.Bt + (size_t)nxt.pn * tstep + S.koff(nxt, K) : cB;
        for (int t = 0; t < nt; t += 2) {
            if constexpr (Hook::ON) { if (t != 0 && (t & 7) == 0) H(acc, cur, t, wr, wc, fr, fq); }
            const bool last = (t == nt - 2);
            const char* a1 = cA + (size_t)(t + 1) * kstep;
            const char* a2 = last ? nA : cA + (size_t)(t + 2) * kstep; const char* b2 = last ? nB : cB + (size_t)(t + 2) * kstep;
            const char* a3 = a2 + kstep; const char* b3 = b2 + kstep;
            if (last && has_next) S.a_ready(nxt);
            PG8_LDB(B0, 0, 0); PG8_LDB(B1, 0, 1); PG8_SCHED; PG8_LDA(At, 0, 0); PG8_STAGE(PG8_SA(1, 1), a1 + hstep, voffA);
            PG8_WAIT_V(8); PG8_WAIT_L(0); PG8_BAR; PG8_MMA(0, 0, At, B0); PG8_MMA(0, 1, At, B1); PG8_BAR; PG8_SCHED;
            PG8_LDA(At, 0, 1); PG8_STAGE(PG8_SB(0, 0), b2, voffB); PG8_STAGE(PG8_SB(0, 1), b2 + hstep, voffB); PG8_STAGE(PG8_SA(0, 0), a2, voffA);
            PG8_WAIT_V(8); PG8_WAIT_L(0); PG8_BAR; PG8_MMA(1, 0, At, B0); PG8_MMA(1, 1, At, B1); PG8_BAR; PG8_SCHED;
            PG8_LDB(B0, 1, 0); PG8_LDB(B1, 1, 1); PG8_SCHED; PG8_LDA(At, 1, 0); PG8_STAGE(PG8_SA(0, 1), a2 + hstep, voffA);
            PG8_WAIT_V(8); PG8_WAIT_L(0); PG8_BAR; PG8_MMA(0, 0, At, B0); PG8_MMA(0, 1, At, B1); PG8_BAR; PG8_SCHED;
            PG8_LDA(At, 1, 1); PG8_STAGE(PG8_SB(1, 0), b3, voffB); PG8_STAGE(PG8_SB(1, 1), b3 + hstep, voffB); PG8_STAGE(PG8_SA(1, 0), a3, voffA);
            PG8_WAIT_V(8); PG8_WAIT_L(0); PG8_BAR; PG8_MMA(1, 0, At, B0); PG8_MMA(1, 1, At, B1); PG8_BAR; PG8_SCHED;
        }
        if (wr == 0) PG8_BAR;
        E(acc, cur, wr, wc, fr, fq); S.done(cur);
        if (!has_next) break;
#pragma unroll
        for (int a = 0; a < 2; ++a)
#pragma unroll
            for (int b = 0; b < 2; ++b)
#pragma unroll
                for (int m = 0; m < 4; ++m)
#pragma unroll
                    for (int n = 0; n < 2; ++n) acc[a][b][m][n] = (f32x4){0.f, 0.f, 0.f, 0.f};
        cur = nxt; cA = nA; cB = nB; ++ui; nt = S.nt(cur, K);
        if (wr == 1) PG8_BAR;
    }
    PG8_WAIT_V(0);
    PG8_BAR;
#undef PG8_SA
#undef PG8_SB
#undef PG8_STAGE
#undef PG8_LDA
#undef PG8_LDB
#undef PG8_MMA
#undef PG8_WAIT_V
#undef PG8_WAIT_L
#undef PG8_BAR
#undef PG8_SCHED
}
}

#define XB_TMO      128
#define XB_XCNT(j)  (256  + 64 * (j))
#define XB_XSUB(j)  (1280 + 64 * (j))
#define XB_XGEN(j)  (2304 + 64 * (j))
#define XB_TOP      3328
#define XB_TOPGEN   3392
#define XCD_BAR_WORDS 3456
#define XB_SPIN_CAP (1u << 18)
__device__ __forceinline__ unsigned xb_ld(unsigned* p)              { return __hip_atomic_load(p, __ATOMIC_RELAXED, __HIP_MEMORY_SCOPE_AGENT); }
__device__ __forceinline__ unsigned xb_add(unsigned* p, unsigned v) { return __hip_atomic_fetch_add(p, v, __ATOMIC_RELAXED, __HIP_MEMORY_SCOPE_AGENT); }
__device__ __forceinline__ unsigned xb_xcc_id() { return (unsigned)__builtin_amdgcn_s_getreg((3 << 11) | 20) & 0xFu; }
#define XB_SPIN(cond, bar) do { unsigned _sp = 0; while (cond) { __builtin_amdgcn_s_sleep(1); \
    if ((++_sp & 255u) == 0u) { if (xb_ld(&(bar)[XB_TMO])) break; if (_sp > XB_SPIN_CAP) { atomicAdd(&(bar)[XB_TMO], 1u); break; } } } } while (0)
struct XcdBarrier { unsigned* bar; unsigned x; volatile LAS unsigned* st; };
__device__ __forceinline__ XcdBarrier xcd_barrier_post(unsigned* bar, volatile LAS unsigned* st) {
    XcdBarrier b; b.bar = bar; b.x = xb_xcc_id(); b.st = st;
    if (threadIdx.x == 0) (void)xb_add(&bar[XB_XCNT(b.x)], 1u);
    return b;
}
__device__ __forceinline__ void xcd_barrier_complete(unsigned* bar, unsigned x, unsigned& nloc, unsigned& nx) {
    const unsigned G = gridDim.x * gridDim.y * gridDim.z;
    unsigned sum, cnt, mine, sp = 0u;
    for (;;) {
        sum = 0u; cnt = 0u; mine = 0u;
#pragma unroll
        for (unsigned j = 0; j < 16; ++j) { const unsigned c = xb_ld(&bar[XB_XCNT(j)]); sum += c; cnt += (c > 0u) ? 1u : 0u; mine = (j == x) ? c : mine; }
        if (sum == G) break;
        __builtin_amdgcn_s_sleep(1);
        if ((++sp & 255u) == 0u) { if (xb_ld(&bar[XB_TMO])) break; if (sp > XB_SPIN_CAP) { atomicAdd(&bar[XB_TMO], 1u); break; } }
    }
    nloc = mine > 0u ? mine : 1u; nx = cnt > 0u ? cnt : 1u;
}
__device__ __forceinline__ void xcd_barrier(const XcdBarrier& b) {
    asm volatile("s_waitcnt vmcnt(0)" ::: "memory");
    __syncthreads();
    if (threadIdx.x == 0) {
        unsigned* bar = b.bar;
        __builtin_amdgcn_s_waitcnt(0);
        unsigned nloc = b.st[0], nx = b.st[1];
        if (nloc == 0u) { xcd_barrier_complete(bar, b.x, nloc, nx); b.st[0] = nloc; b.st[1] = nx; }
        const unsigned old = xb_add(&bar[XB_XSUB(b.x)], 1u);
        const unsigned gen = old / nloc;
        if (old + 1u == (gen + 1u) * nloc) {
            __builtin_amdgcn_fence(__ATOMIC_RELEASE, "agent");
            asm volatile("s_waitcnt vmcnt(0)" ::: "memory");
            const unsigned og = xb_add(&bar[XB_TOP], 1u);
            const unsigned tg = og / nx;
            if (og + 1u == (tg + 1u) * nx) xb_add(&bar[XB_TOPGEN], 1u);
            else XB_SPIN(xb_ld(&bar[XB_TOPGEN]) == tg, bar);
            __builtin_amdgcn_fence(__ATOMIC_ACQUIRE, "agent");
            xb_add(&bar[XB_XGEN(b.x)], 1u);
            asm volatile("s_waitcnt vmcnt(0)" ::: "memory");
        } else {
            XB_SPIN(xb_ld(&bar[XB_XGEN(b.x)]) == gen, bar);
            __builtin_amdgcn_fence(__ATOMIC_ACQUIRE, "agent");
            asm volatile("s_waitcnt vmcnt(0)" ::: "memory");
        }
    }
    __syncthreads();
}

__device__ const float c_one[1] = {1.0f};
struct TrDesc { const float* W; const float* gk; bf16_t* WT; int ldw, scol0, ldt, drow0, dk0, kb, nb, f8; float qinv; };
__device__ __forceinline__ void tr_load(f32x4 (&v)[8], float (&g)[8], const TrDesc& d, int lane) {
    const float* p = d.W + (size_t)(64 * d.kb + (lane >> 3)) * d.ldw + d.scol0 + 32 * d.nb + 4 * (lane & 7);
    const GAS float* gp = d.gk ? (const GAS float*)d.gk + 64 * d.kb + (lane >> 3) : (const GAS float*)c_one; const int gs = d.gk ? 8 : 0;
#pragma unroll
    for (int i = 0; i < 8; ++i) v[i] = __builtin_nontemporal_load((const f32x4*)(p + (size_t)(8 * i) * d.ldw));
#pragma unroll
    for (int i = 0; i < 8; ++i) g[i] = gp[i * gs];
}
__device__ __forceinline__ void tr_store(const f32x4 (&v)[8], const float (&g)[8], const TrDesc& d, LAS float* scr, int lane) {
    const int kr = lane >> 3, q = lane & 7;
#pragma unroll
    for (int i = 0; i < 8; ++i) { LAS float* s = scr + (8 * i + kr) * 33 + 4 * q; s[0] = v[i].x * g[i]; s[1] = v[i].y * g[i]; s[2] = v[i].z * g[i]; s[3] = v[i].w * g[i]; }
    LDS_WAIT(); asm volatile("" ::: "memory");
    const int c = lane & 7;
#pragma unroll
    for (int j = 0; j < 4; ++j) { const int n = (lane >> 3) + 8 * j; const LAS float* s = scr + (8 * c) * 33 + n;
        u32x4 o; o.x = cvt_pk_bf16(s[0 * 33], s[1 * 33]); o.y = cvt_pk_bf16(s[2 * 33], s[3 * 33]); o.z = cvt_pk_bf16(s[4 * 33], s[5 * 33]); o.w = cvt_pk_bf16(s[6 * 33], s[7 * 33]);
        if (d.f8) { const float qv = d.qinv; u32x2 o8; o8.x = q8x4(qv * s[0 * 33], qv * s[1 * 33], qv * s[2 * 33], qv * s[3 * 33]); o8.y = q8x4(qv * s[4 * 33], qv * s[5 * 33], qv * s[6 * 33], qv * s[7 * 33]);
            __builtin_nontemporal_store(o8, (u32x2*)((unsigned char*)d.WT + (size_t)(d.drow0 + 32 * d.nb + n) * d.ldt + d.dk0 + 64 * d.kb + 8 * c)); }
        else __builtin_nontemporal_store(o, (u32x4*)(d.WT + (size_t)(d.drow0 + 32 * d.nb + n) * d.ldt + d.dk0 + 64 * d.kb + 8 * c)); }
    LDS_WAIT(); asm volatile("" ::: "memory");
}

struct Args { const float* in[23]; float* out; unsigned char* ws; int ph_lo, ph_hi, li, pad; };

template <bool FORGET, bool FINAL, bool INBF>
__device__ __forceinline__ void norm_phase(const float* X, const bf16_t* Xb, bf16_t* XN, float* RS, unsigned* XN8, float* AS8, const float* gq, const float* wfg, const float* fb, float* logf, const float* gfin, float* outf,
                                           LAS unsigned char* lds, int gw, int NGW, int lane, int tid) {
    if (FORGET) {
        LAS f32x4* w4 = (LAS f32x4*)lds;
        for (int i = tid; i < 8 * 2048 / 4; i += 512) w4[i] = ((const f32x4*)wfg)[i];
        __syncthreads();
    }
    for (int m0 = gw * 4; m0 < M; m0 += NGW * 4) {
        f32x4 v[4][8]; float rr[4];
#pragma unroll
        for (int r = 0; r < 4; ++r) {
            if (INBF) { const GAS u32x4* xr = (const GAS u32x4*)(Xb + (size_t)(m0 + r) * DM) + lane;
#pragma unroll
                for (int jj = 0; jj < 4; ++jj) { const u32x4 w = xr[64 * jj]; v[r][2 * jj] = (f32x4){bf_lo(w.x), bf_hi(w.x), bf_lo(w.y), bf_hi(w.y)}; v[r][2 * jj + 1] = (f32x4){bf_lo(w.z), bf_hi(w.z), bf_lo(w.w), bf_hi(w.w)}; }
            } else { const GAS f32x4* xr = (const GAS f32x4*)(X + (size_t)(m0 + r) * DM) + lane;
#pragma unroll
                for (int j = 0; j < 8; ++j) v[r][j] = xr[64 * j]; } }
#define NQ(j) (INBF ? (128 * ((j) >> 1) + 2 * lane + ((j) & 1)) : (64 * (j) + lane))
#pragma unroll
        for (int r = 0; r < 4; ++r) { float s = 0.f;
#pragma unroll
            for (int j = 0; j < 8; ++j) s += (v[r][j].x * v[r][j].x + v[r][j].y * v[r][j].y) + (v[r][j].z * v[r][j].z + v[r][j].w * v[r][j].w);
            rr[r] = 1.0f / sqrtf(wave_sum(s, lane) * (1.0f / DM) + EPS); }
        if (FINAL) {
            f32x4 gf4[8];
#pragma unroll
            for (int j = 0; j < 8; ++j) gf4[j] = ((const GAS f32x4*)gfin)[NQ(j)];
#pragma unroll
            for (int r = 0; r < 4; ++r) { GAS f32x4* o = (GAS f32x4*)(outf + (size_t)(m0 + r) * DM);
#pragma unroll
                for (int j = 0; j < 8; ++j) o[NQ(j)] = v[r][j] * rr[r] * gf4[j]; }
        } else {
            f32x4 gq4[8];
#pragma unroll
            for (int j = 0; j < 8; ++j) gq4[j] = ((const GAS f32x4*)gq)[NQ(j)];
#pragma unroll
            for (int r = 0; r < 4; ++r) { GAS u32x2* o = (GAS u32x2*)(XN + (size_t)(m0 + r) * DM); GAS unsigned* o8 = (GAS unsigned*)(XN8 + (size_t)(m0 + r) * (DM / 4));
                float mx = 0.f;
#pragma unroll
                for (int j = 0; j < 8; ++j) { const f32x4 y = v[r][j] * gq4[j]; mx = fmaxf(mx, fmaxf(fmaxf(fabsf(y.x), fabsf(y.y)), fmaxf(fabsf(y.z), fabsf(y.w)))); }
                mx = fmaxf(wave_max(mx, lane) * rr[r], 1e-20f); const float qi = rr[r] * 127.0f / mx;
                if (lane == 0) { AS8[m0 + r] = mx * (1.0f / 127.0f); if (RS) RS[m0 + r] = rr[r]; }
#pragma unroll
                for (int j = 0; j < 8; ++j) { if (XN) { const f32x4 t = v[r][j] * rr[r]; u32x2 w; w.x = cvt_pk_bf16(t.x, t.y); w.y = cvt_pk_bf16(t.z, t.w); o[NQ(j)] = w; }
                    const f32x4 y = v[r][j] * gq4[j] * qi; o8[NQ(j)] = q8x4(y.x, y.y, y.z, y.w); } }
        }
        if (FORGET) {
#pragma unroll 1
            for (int h = 0; h < 8; ++h) {
                float a0 = 0.f, a1 = 0.f, a2 = 0.f, a3 = 0.f;
#pragma unroll
                for (int j = 0; j < 8; ++j) { const f32x4 w = *((LAS f32x4*)lds + h * 512 + NQ(j));
                    a0 += (v[0][j].x * w.x + v[0][j].y * w.y) + (v[0][j].z * w.z + v[0][j].w * w.w);
                    a1 += (v[1][j].x * w.x + v[1][j].y * w.y) + (v[1][j].z * w.z + v[1][j].w * w.w);
                    a2 += (v[2][j].x * w.x + v[2][j].y * w.y) + (v[2][j].z * w.z + v[2][j].w * w.w);
                    a3 += (v[3][j].x * w.x + v[3][j].y * w.y) + (v[3][j].z * w.z + v[3][j].w * w.w); }
                a0 = wave_sum(a0, lane); a1 = wave_sum(a1, lane); a2 = wave_sum(a2, lane); a3 = wave_sum(a3, lane);
                const float bh = fb[h];
                const float z = (lane == 0 ? a0 * rr[0] : lane == 1 ? a1 * rr[1] : lane == 2 ? a2 * rr[2] : a3 * rr[3]) + bh;
                const float az = fabsf(z);
                const float ls = fminf(z, 0.f) - 0.6931471805599453f * __builtin_amdgcn_logf(1.0f + fast_exp2(-LOG2E * az));
                if (lane < 4) logf[(size_t)h * M + m0 + lane] = ls;
            }
        }
    }
#undef NQ
}

namespace att {
constexpr int LDS_K = 0, LDS_V = 8192, LDS_BUF = 16384, LDS_SV = 32768, LDS_WS = 65536, LDS_QW = 67584, LDS_FL = 69632;
constexpr float NEG = -1e30f;
__device__ __forceinline__ int crow(int r, int hi) { return (r & 3) + 8 * (r >> 2) + 4 * hi; }
__device__ __forceinline__ s16x4 vtr(const LAS unsigned char* p) { return __builtin_bit_cast(s16x4, __builtin_amdgcn_ds_read_tr16_b64_v4i16((LAS s16x4*)p)); }
__device__ __forceinline__ float max3f(float a, float b, float c) { float r; asm("v_max3_f32 %0, %1, %2, %3" : "=v"(r) : "v"(a), "v"(b), "v"(c)); return r; }
__device__ __forceinline__ float rowmax32(const f32x16& p0, const f32x16& p1) {
    float a = max3f(p0[0], p0[1], p1[0]), b = max3f(p0[2], p0[3], p1[1]); a = max3f(a, p1[2], p1[3]);
#pragma unroll
    for (int r = 4; r < 16; r += 4) { a = max3f(a, p0[r], p0[r + 1]); b = max3f(b, p0[r + 2], p0[r + 3]); a = max3f(a, p1[r], p1[r + 1]); b = max3f(b, p1[r + 2], p1[r + 3]); }
    return fmaxf(a, b);
}
struct AttnArgs {
    const bf16_t *Q, *K, *V; long rs;
    int q0, kbase, jlo, jhi;
    const float* Fl;
    const float* rope; long rrs;
    bf16_t* Ob; float* Of; long ors;
    float* lse; long lrs;
};
__device__ __forceinline__ u32x4 rope8(u32x4 x1, u32x4 x2, const f32x4 c0, const f32x4 c1, const f32x4 s0, const f32x4 s1, bool first) {
    float a[8], b[8], c[8], s[8], o[8];
    a[0] = bf_lo(x1.x); a[1] = bf_hi(x1.x); a[2] = bf_lo(x1.y); a[3] = bf_hi(x1.y); a[4] = bf_lo(x1.z); a[5] = bf_hi(x1.z); a[6] = bf_lo(x1.w); a[7] = bf_hi(x1.w);
    b[0] = bf_lo(x2.x); b[1] = bf_hi(x2.x); b[2] = bf_lo(x2.y); b[3] = bf_hi(x2.y); b[4] = bf_lo(x2.z); b[5] = bf_hi(x2.z); b[6] = bf_lo(x2.w); b[7] = bf_hi(x2.w);
#pragma unroll
    for (int e = 0; e < 4; ++e) { c[e] = c0[e]; c[4 + e] = c1[e]; s[e] = s0[e]; s[4 + e] = s1[e]; }
#pragma unroll
    for (int e = 0; e < 8; ++e) o[e] = first ? (a[e] * c[e] - b[e] * s[e]) : (a[e] * s[e] + b[e] * c[e]);
    u32x4 w; w.x = cvt_pk_bf16(o[0], o[1]); w.y = cvt_pk_bf16(o[2], o[3]); w.z = cvt_pk_bf16(o[4], o[5]); w.w = cvt_pk_bf16(o[6], o[7]); return w;
}
template <int MODE>
__device__ __forceinline__ void attn_unit(LAS unsigned char* lds, const AttnArgs& A, int tid) {
    asm volatile("" : "+v"(tid));
    const int lane = tid & 63, wv = __builtin_amdgcn_readfirstlane(tid >> 6), r32 = lane & 31, hi = lane >> 5;
    LAS float* wsf = (LAS float*)(lds + LDS_WS) + wv * 64;
    const int qi = A.q0 + 32 * wv + r32;
    bf16x8 qr[4];
    { const bf16_t* qrow = A.Q + (long)qi * A.rs;
#pragma unroll
      for (int d0 = 0; d0 < 4; ++d0) qr[d0] = *(const bf16x8*)(qrow + d0 * 16 + hi * 8); }
    const int krow = 8 * wv + (lane & 7), kch = lane >> 3, vrow = 8 * wv + (lane >> 3), vch = lane & 7;
    const int kdo = LDS_K + kch * 1024 + krow * 16, vdo = LDS_V + (vch >> 2) * 4096 + vrow * 64 + (vch & 3) * 16;
    u32x4 kreg, vreg; f32x4 rc0, rc1, rs0, rs1;
    rc0 = rc1 = rs0 = rs1 = (f32x4){0.f, 0.f, 0.f, 0.f};
#define ATT_LOAD(j) do { const long ks_ = (long)A.kbase + 64 * (j); \
        kreg = *(const u32x4*)(A.K + (ks_ + krow) * A.rs + kch * 8); vreg = *(const u32x4*)(A.V + (ks_ + vrow) * A.rs + vch * 8); \
        if (MODE == 1) { if (kch < 2) { const float* rp_ = A.rope + (ks_ + krow) * A.rrs; rc0 = *(const f32x4*)(rp_); rc1 = *(const f32x4*)(rp_ + 4); rs0 = *(const f32x4*)(rp_ + 8); rs1 = *(const f32x4*)(rp_ + 12); } } } while (0)
    ATT_LOAD(A.jhi - 1);
    if (MODE == 1) {
        const float* rp = A.rope + (long)qi * A.rrs;
        const f32x4 c0 = *(const f32x4*)(rp), c1 = *(const f32x4*)(rp + 4), s0 = *(const f32x4*)(rp + 8), s1 = *(const f32x4*)(rp + 12);
        const u32x4 me = __builtin_bit_cast(u32x4, qr[0]); u32x4 x1, x2;
#pragma unroll
        for (int e = 0; e < 4; ++e) { auto rr = __builtin_amdgcn_permlane32_swap(me[e], me[e], false, false); x1[e] = rr[0]; x2[e] = rr[1]; }
        qr[0] = __builtin_bit_cast(bf16x8, rope8(x1, x2, c0, c1, s0, s1, hi == 0));
    }
    const float flq = (MODE != 1) ? A.Fl[qi] : 0.f;
    float m = (MODE == 1) ? NEG : 0.f, l = 0.f; f32x16 o0, o1; bool first = true;
#pragma unroll
    for (int r = 0; r < 16; ++r) { o0[r] = 0.f; o1[r] = 0.f; }
    const int qw0 = A.q0 + 32 * wv;
    int wlo = A.jlo; const int whi = (qw0 + 31 - A.kbase) >> 6;
    if (MODE == 1) { const int f = (qw0 - 128 - A.kbase) >> 6; wlo = f > wlo ? f : wlo; }
    const int k0 = A.kbase + 64 * A.jlo;
    if (MODE != 1) {
        LAS f32x4* fl4 = (LAS f32x4*)(lds + LDS_FL); const int n4 = 16 * (A.jhi - A.jlo);
        for (int i = tid; i < n4; i += 512) fl4[i] = *(const f32x4*)(A.Fl + k0 + 4 * i);
    }
#define ATT_WRITE(buf) do { if (MODE == 1) { u32x4 oth; _Pragma("unroll") for (int e = 0; e < 4; ++e) oth[e] = shxu(kreg[e], 8, lane); \
            if (kch < 2) kreg = (kch == 0) ? rope8(kreg, oth, rc0, rc1, rs0, rs1, true) : rope8(oth, kreg, rc0, rc1, rs0, rs1, false); } \
        *(LAS u32x4*)(lds + (buf) * LDS_BUF + kdo) = kreg; *(LAS u32x4*)(lds + (buf) * LDS_BUF + vdo) = vreg; } while (0)
    const int nst = A.jhi - A.jlo;
    asm volatile("s_barrier" ::: "memory");
    ATT_WRITE(0);
    if (nst > 1) ATT_LOAD(A.jhi - 2);
    BAR_L();
    for (int st = 0; st < nst; ++st) {
        const int j = A.jhi - 1 - st, cur = st & 1;
        if (j >= wlo && j <= whi) {
            const int ks = A.kbase + 64 * j;
            const LAS unsigned char* tb = lds + cur * LDS_BUF;
            f32x16 p0, p1;
            const float fm = flq - m;
            if (MODE != 1) { const LAS float* fk = (const LAS float*)(lds + LDS_FL) + (ks - k0) + 4 * hi;
#pragma unroll
                for (int g4 = 0; g4 < 4; ++g4) { const f32x4 a = *(const LAS f32x4*)(fk + 8 * g4), b = *(const LAS f32x4*)(fk + 32 + 8 * g4);
#pragma unroll
                    for (int e = 0; e < 4; ++e) { p0[4 * g4 + e] = fm - a[e]; p1[4 * g4 + e] = fm - b[e]; } }
            } else {
#pragma unroll
                for (int r = 0; r < 16; ++r) { p0[r] = 0.f; p1[r] = 0.f; } }
            { const LAS unsigned char* kb = tb + LDS_K + hi * 1024 + r32 * 16;
#pragma unroll
              for (int d0 = 0; d0 < 4; ++d0) { const bf16x8 b0 = *(const LAS bf16x8*)(kb + d0 * 2048), b1 = *(const LAS bf16x8*)(kb + d0 * 2048 + 512);
                  p0 = __builtin_amdgcn_mfma_f32_32x32x16_bf16(b0, qr[d0], p0, 0, 0, 0); p1 = __builtin_amdgcn_mfma_f32_32x32x16_bf16(b1, qr[d0], p1, 0, 0, 0); } }
            if (MODE != 1) {
                if (ks + 63 > qw0) {
#pragma unroll
                    for (int r = 0; r < 16; ++r) { const int kv = ks + crow(r, hi); if (kv > qi) p0[r] = NEG; if (kv + 32 > qi) p1[r] = NEG; } }
            } else {
#pragma unroll
                for (int r = 0; r < 16; ++r) { const int d = qi - (ks + crow(r, hi)); if (d < 0 || d > 128) p0[r] = NEG; if (d - 32 < 0 || d - 32 > 128) p1[r] = NEG; }
            }
            asm volatile("s_nop 15\n\ts_nop 7" : "+v"(p0), "+v"(p1));
            float rm = rowmax32(p0, p1);
            { auto rr = __builtin_amdgcn_permlane32_swap(__float_as_uint(rm), __float_as_uint(rm), false, false); rm = fmaxf(__uint_as_float(rr[0]), __uint_as_float(rr[1])); }
            float f = 1.0f; bool resc;
            if (MODE != 1) {
                const float d = first ? rm : fmaxf(rm, 0.f);
                resc = first || (__builtin_amdgcn_ballot_w64(rm > 0.f) != 0ull);
                if (resc) { m += d;
#pragma unroll
                    for (int r = 0; r < 16; ++r) { p0[r] -= d; p1[r] -= d; }
                    if (!first) { f = fast_exp2(-d); l *= f; } else resc = false; }
            } else {
                const float mn = fmaxf(m, rm); f = fast_exp2(m - mn); m = mn; l *= f;
#pragma unroll
                for (int r = 0; r < 16; ++r) { p0[r] -= mn; p1[r] -= mn; }
                resc = __builtin_amdgcn_ballot_w64(f != 1.0f) != 0ull;
            }
            first = false;
#pragma unroll
            for (int r = 0; r < 16; ++r) p0[r] = fast_exp2(p0[r]);
#pragma unroll
            for (int r = 0; r < 16; ++r) p1[r] = fast_exp2(p1[r]);
            { float s0 = 0.f, s1 = 0.f, s2 = 0.f, s3 = 0.f;
#pragma unroll
              for (int r = 0; r < 16; r += 2) { s0 += p0[r]; s1 += p0[r + 1]; s2 += p1[r]; s3 += p1[r + 1]; }
              l += (s0 + s1) + (s2 + s3); }
            if (resc) {
                if (hi == 0) wsf[r32] = f;
                f32x4 fr[4];
#pragma unroll
                for (int g4 = 0; g4 < 4; ++g4) fr[g4] = *(const LAS f32x4*)(wsf + 8 * g4 + 4 * hi);
#pragma unroll
                for (int r = 0; r < 16; ++r) { o0[r] *= fr[r >> 2][r & 3]; o1[r] *= fr[r >> 2][r & 3]; }
            }
            u32x4 pw[4];
#pragma unroll
            for (int e = 0; e < 4; ++e) { pw[0][e] = cvt_pk_bf16(p0[2 * e], p0[2 * e + 1]); pw[1][e] = cvt_pk_bf16(p0[8 + 2 * e], p0[9 + 2 * e]);
                                          pw[2][e] = cvt_pk_bf16(p1[2 * e], p1[2 * e + 1]); pw[3][e] = cvt_pk_bf16(p1[8 + 2 * e], p1[9 + 2 * e]); }
            const LAS unsigned char* vp = tb + LDS_V + ((lane >> 4) & 1) * 32 + (lane & 3) * 8 + (4 * hi + ((lane & 15) >> 2)) * 64;
#pragma unroll
            for (int k4 = 0; k4 < 4; ++k4) {
                const s16x4 a0 = vtr(vp + k4 * 1024), a1 = vtr(vp + k4 * 1024 + 512), b0 = vtr(vp + 4096 + k4 * 1024), b1 = vtr(vp + 4096 + k4 * 1024 + 512);
                const bf16x8 v0 = (bf16x8){a0[0], a0[1], a0[2], a0[3], a1[0], a1[1], a1[2], a1[3]}, v1 = (bf16x8){b0[0], b0[1], b0[2], b0[3], b1[0], b1[1], b1[2], b1[3]};
                o0 = __builtin_amdgcn_mfma_f32_32x32x16_bf16(__builtin_bit_cast(bf16x8, pw[k4]), v0, o0, 0, 0, 0);
                o1 = __builtin_amdgcn_mfma_f32_32x32x16_bf16(__builtin_bit_cast(bf16x8, pw[k4]), v1, o1, 0, 0, 0);
            }
        }
        if (st + 1 < nst) { ATT_WRITE(cur ^ 1); if (st + 2 < nst) ATT_LOAD(j - 2); }
        BAR_L();
    }
#undef ATT_WRITE
#undef ATT_LOAD
    { auto rr = __builtin_amdgcn_permlane32_swap(__float_as_uint(l), __float_as_uint(l), false, false); l = __uint_as_float(rr[0]) + __uint_as_float(rr[1]); }
    if (hi == 0) wsf[r32] = (MODE == 2) ? 1.0f : 1.0f / l;
    f32x4 fr[4];
#pragma unroll
    for (int g4 = 0; g4 < 4; ++g4) fr[g4] = *(const LAS f32x4*)(wsf + 8 * g4 + 4 * hi);
#pragma unroll
    for (int r = 0; r < 16; ++r) { const long row = (long)(qw0 + crow(r, hi)) * A.ors; const float s = fr[r >> 2][r & 3];
        if (MODE == 0) { A.Ob[row + r32] = (bf16_t)(cvt_pk_bf16(o0[r] * s, 0.f) & 0xffffu); A.Ob[row + 32 + r32] = (bf16_t)(cvt_pk_bf16(o1[r] * s, 0.f) & 0xffffu); }
        else { A.Of[row + r32] = o0[r] * s; A.Of[row + 32 + r32] = o1[r] * s; } }
    if (MODE == 1) { if (hi == 0) A.lse[(long)qi * A.lrs] = m + log2f(l); }
    if (MODE == 2) { if (hi == 0) { A.lse[(long)qi * A.lrs] = m; A.lse[(long)qi * A.lrs + 1] = l; } }
}
}

constexpr int NPH_PRO = 2, NPH_LAYER = 11, NPHASE = NPH_PRO + DEPTH * NPH_LAYER;
constexpr int TR_ITEMS = 37632;
constexpr int MIX_TR = 588, MIX_TRI = 64;
constexpr int MIX_FOX = 384, MIX_DIL = 384, MIX_SGU = 256, MIX_CONV = 256, MIX_UNITS = MIX_GEMM + MIX_FOX + MIX_DIL + MIX_SGU + MIX_CONV;
__constant__ double c_rope_inv[8] = {1.0, 0.19392274474868576, 0.03760603093086393, 0.007292664737217109, 0.001414213562373095, 0.0002742481756762073, 5.318295896944988e-05, 1.031338537721246e-05};

__device__ __forceinline__ void sincos_d(double x, float& sn, float& cs) {
    const double q = rint(x * 0.63661977236758134308);
    const double r = (x - q * 1.57079632679489655800e+00) - q * 6.12323399573676603587e-17;
    const int qi = ((int)q) & 3;
    const double r2 = r * r;
    double s = r * (1.0 + r2 * (-1.0 / 6 + r2 * (1.0 / 120 + r2 * (-1.0 / 5040 + r2 * (1.0 / 362880 + r2 * (-1.0 / 39916800 + r2 * (1.0 / 6227020800.0)))))));
    double c = 1.0 + r2 * (-0.5 + r2 * (1.0 / 24 + r2 * (-1.0 / 720 + r2 * (1.0 / 40320 + r2 * (-1.0 / 3628800 + r2 * (1.0 / 479001600.0 + r2 * (-1.0 / 87178291200.0)))))));
    double so = (qi == 0) ? s : (qi == 1) ? c : (qi == 2) ? -s : -c;
    double co = (qi == 0) ? c : (qi == 1) ? -s : (qi == 2) ? -c : s;
    sn = (float)so; cs = (float)co;
}

__device__ __forceinline__ int opaque_i(int k) { asm volatile("" : "+s"(k)); return k; }
__device__ __forceinline__ int lane_id_now() { int l; asm volatile("v_mbcnt_lo_u32_b32 %0, -1, 0\n\tv_mbcnt_hi_u32_b32 %0, -1, %0" : "=v"(l)); return l; }
__global__ void __launch_bounds__(512, 2) mk_fwd(Args args) {
    extern __shared__ __attribute__((aligned(16))) unsigned char lds_raw[];
    LAS unsigned char* lds = (LAS unsigned char*)lds_raw;
    volatile LAS unsigned* MISC = (volatile LAS unsigned*)(lds + MISC_OFF);
    const int wave0 = __builtin_amdgcn_readfirstlane(threadIdx.x >> 6);
#define MK_TID() (wave0 * 64 + lane_id_now())
    const int G = gridDim.x, bx = blockIdx.x, NGW = G * 8;
#define WS_LOCAL() unsigned char* ws = args.ws; float* X = args.out; asm volatile("" : "+s"(ws), "+s"(X)); (void)X
    unsigned* ctl = (unsigned*)(args.ws + WS_CTL);
    for (int u = MK_TID(); u < (LDS_BYTES - RING_BYTES) / 4; u += 512) ((LAS unsigned*)(lds + RING_BYTES))[u] = 0u;
    __syncthreads();
    XcdBarrier bar = xcd_barrier_post(ctl + CW_BAR + args.li * XCD_BAR_WORDS, MISC + 8);
    const int lo = args.ph_lo, hi = args.ph_hi;
#define IN(k) (lo <= (k) && (k) < hi)
#if PROBE_PH >= 0
    if (threadIdx.x == 0) { const unsigned long long t_ = __builtin_amdgcn_s_memrealtime(); MISC[20] = (unsigned)t_; MISC[21] = (unsigned)(t_ >> 32); }
#define PROBE_SEL(k) ((PROBE_PH < 100) ? ((k) == PROBE_PH) : ((k) >= NPH_PRO && ((k) - NPH_PRO) % NPH_LAYER == PROBE_PH - 100))
#define SEAM(k) do { if (IN(k) && IN((k) + 1)) xcd_barrier(bar); if (threadIdx.x == 0) { const unsigned long long tn_ = __builtin_amdgcn_s_memrealtime(), tp_ = (unsigned long long)MISC[20] | ((unsigned long long)MISC[21] << 32), du_ = tn_ - tp_; \
        if (PROBE_SEL(k)) { while (__builtin_amdgcn_s_memrealtime() - tn_ < du_) __builtin_amdgcn_s_sleep(8); } } __syncthreads(); \
        if (threadIdx.x == 0) { const unsigned long long t_ = __builtin_amdgcn_s_memrealtime(); MISC[20] = (unsigned)t_; MISC[21] = (unsigned)(t_ >> 32); } } while (0)
#else
#define SEAM(k) do { if (IN(k) && IN((k) + 1)) xcd_barrier(bar); } while (0)
#endif
#define x_in (args.in[opaque_i(0)])
#define p_in (args.in[opaque_i(1)])
#define pos_in ((const int*)args.in[opaque_i(2)])
#define norm_mix_g (args.in[opaque_i(3)])
#define w_in (args.in[opaque_i(4)])
#define fox_b (args.in[opaque_i(5)])
#define scw (args.in[opaque_i(6)])
#define sgu_g (args.in[opaque_i(7)])
#define sgu_w (args.in[opaque_i(8)])
#define sgu_b (args.in[opaque_i(9)])
#define w_br_fox (args.in[opaque_i(10)])
#define w_br_conv (args.in[opaque_i(11)])
#define w_br_sgu (args.in[opaque_i(12)])
#define w_br_dil (args.in[opaque_i(13)])
#define w_out (args.in[opaque_i(14)])
#define norm_ffn_g (args.in[opaque_i(15)])
#define w_up (args.in[opaque_i(16)])
#define ffn_cw (args.in[opaque_i(17)])
#define w_down (args.in[opaque_i(18)])
#define norm_ple_g (args.in[opaque_i(19)])
#define w_pg (args.in[opaque_i(20)])
#define w_pe (args.in[opaque_i(21)])
#define final_g (args.in[opaque_i(22)])
#define WFG ((float*)(ws + WS_SMALL + SM_WFG))
#define SGUW ((bf16_t*)(ws + WS_SMALL + SM_SGUW))
#define ROPE ((float*)(ws + WS_SMALL + SM_ROPE))
#define LOGF ((float*)(ws + WS_SMALL + SM_LOGF))
#define FL ((float*)(ws + WS_SMALL + SM_FL))
#define LSE ((float*)(ws + WS_SMALL + SM_LSE))
#define SSQ ((float*)(ws + WS_PART))
#define RSC ((float*)(ws + WS_SMALL + SM_SS))
#define FOP ((float*)(ws + WS_FOP))
#define FML ((float*)(ws + WS_FML))
#define UPB ((bf16_t*)(ws + WS_UPB))
#define G8 ((unsigned char*)(ws + WS_G8))
#define XN8 ((unsigned*)(ws + WS_XN8))
#define AS8 ((float*)(ws + WS_SMALL + SM_SS + 65536))
#define QSC ((float*)(ws + WS_SMALL + SM_SS + 98304))
#define XR ((bf16_t*)(ws + WS_XR) + (size_t)(L & 1) * M * DM)
#define XRN ((bf16_t*)(ws + WS_XR) + (size_t)((L + 1) & 1) * M * DM)
#define PB ((bf16_t*)(ws + WS_PB))
#define PP ((bf16_t*)(ws + WS_PP))
#define XN ((bf16_t*)(ws + WS_XN))
#define PROJ ((bf16_t*)(ws + WS_PROJ))
#define UP ((bf16_t*)(ws + WS_PROJ))
#define HID ((bf16_t*)(ws + WS_HID))
#define OCAT ((bf16_t*)(ws + WS_OCAT))
#define MG ((bf16_t*)(ws + WS_MG))
#define ODIL ((float*)(ws + WS_ODIL))

    if (IN(0)) { WS_LOCAL();
        const int tid = MK_TID(), lane = tid & 63, wave = wave0, gw = bx * 8 + wave;
        LAS float* qsl = (LAS float*)(lds + RING_BYTES + 4096);
        { float sq[8];
#pragma unroll
          for (int mth = 0; mth < 8; ++mth) { const int Ls = mth >> 1; float a = 0.f;
              for (int j = 0; j < 16; ++j) { const int i = tid + 512 * j;
                  const float w = (mth & 1) ? w_up[(size_t)Ls * DM * 2 * DFF + i] : w_in[(size_t)Ls * DM * DIN_SRC + (size_t)(i >> 11) * DIN_SRC + 6408 + (i & 2047)];
                  a += w * w; }
              sq[mth] = wave_sum(a, lane); }
          if (lane == 0) {
#pragma unroll
              for (int mth = 0; mth < 8; ++mth) qsl[8 + wave * 8 + mth] = sq[mth]; }
          __syncthreads();
          if (tid < 8) { float t = 0.f; for (int w = 0; w < 8; ++w) t += qsl[8 + w * 8 + tid];
              const float rng = 4.0f * sqrtf(t * (1.0f / 8192.0f)) + 1e-30f; qsl[tid] = 127.0f / rng; if (bx == 0) QSC[tid] = rng * (1.0f / 127.0f); }
          __syncthreads(); }
        LAS float* scr = (LAS float*)(lds + wave * 16384);
#define TR_DECODE(d, it_) do { const int L_ = (it_) / TR_ITEMS; int r_ = (it_) % TR_ITEMS; unsigned char* wl_ = ws + WS_WL + (size_t)L_ * WL_STRIDE; const float* win_ = w_in + (size_t)L_ * DM * DIN_SRC; \
            if (r_ < 1536 + 13056) { const bool pa_ = r_ < 1536; if (!pa_) r_ -= 1536; \
                if (pa_) d = TrDesc{win_, norm_mix_g + L_ * DM, (bf16_t*)(wl_ + WL_IN), DIN_SRC, 0, DM, 0, 0, r_ / 48, r_ % 48, 0, 0.f}; \
                else d = TrDesc{win_, norm_mix_g + L_ * DM, (bf16_t*)(wl_ + WL_IN), DIN_SRC, 1544, DM, 1536, 0, r_ / 408, r_ % 408, 0, 0.f}; \
                const int pc_ = d.drow0 + 32 * d.nb, pt_ = pc_ >> 8;        \
                if (pc_ >= PC_G || ((I8MASK >> pt_) & 1u)) { d.WT = (bf16_t*)(wl_ + WL_G8W); d.f8 = 1; d.gk = nullptr; d.qinv = qsl[2 * L_]; \
                    d.drow0 += (pc_ >= PC_G) ? (N8T * 256 - PC_G) : (__builtin_popcount(I8MASK & ((1u << pt_) - 1u)) - pt_) * 256; } } \
            else if ((r_ -= 1536 + 13056) < 512) { d = TrDesc{w_br_fox + (size_t)L_ * 512 * DM, nullptr, (bf16_t*)(wl_ + WL_BR), DM, 0, OC_W, 0, OC_A, r_ / 64, r_ % 64, 0, 0.f}; } \
            else if ((r_ -= 512) < 512) { d = TrDesc{w_br_conv + (size_t)L_ * 512 * DM, nullptr, (bf16_t*)(wl_ + WL_BR), DM, 0, OC_W, 0, OC_B, r_ / 64, r_ % 64, 0, 0.f}; } \
            else if ((r_ -= 512) < 512) { d = TrDesc{w_br_sgu + (size_t)L_ * 512 * DM, nullptr, (bf16_t*)(wl_ + WL_BR), DM, 0, OC_W, 0, OC_C, r_ / 64, r_ % 64, 0, 0.f}; } \
            else if ((r_ -= 512) < 256) { d = TrDesc{w_br_dil + (size_t)L_ * 256 * DM, nullptr, (bf16_t*)(wl_ + WL_BR), DM, 0, OC_W, 0, OC_D, r_ / 64, r_ % 64, 0, 0.f}; } \
            else if ((r_ -= 256) < 2048) { d = TrDesc{w_out + (size_t)L_ * DM * DM, nullptr, (bf16_t*)(wl_ + WL_OUT), DM, 0, DM, 0, 0, r_ / 64, r_ % 64, 0, 0.f}; } \
            else if ((r_ -= 2048) < 11264) { d = TrDesc{w_up + (size_t)L_ * DM * 2 * DFF, nullptr, (bf16_t*)(wl_ + WL_UP), 2 * DFF, 0, DM, 0, 0, r_ / 352, r_ % 352, 1, qsl[2 * L_ + 1]}; }   \
            else if ((r_ -= 11264) < 5632) { d = TrDesc{w_down + (size_t)L_ * DFF * DM, nullptr, (bf16_t*)(wl_ + WL_DN), DM, 0, DFF, 0, 0, r_ / 64, r_ % 64, 0, 0.f}; } \
            else if ((r_ -= 5632) < 2048) { d = TrDesc{w_pg + (size_t)L_ * DM * DM, norm_ple_g + L_ * DM, (bf16_t*)(wl_ + WL_PG), DM, 0, DM, 0, 0, r_ / 64, r_ % 64, 0, 0.f}; } \
            else { r_ -= 2048; d = TrDesc{w_pe + (size_t)L_ * PLE * DM, nullptr, (bf16_t*)(wl_ + WL_PE), DM, 0, PLE, 0, 0, r_ / 64, r_ % 64, 0, 0.f}; } } while (0)
#define TR_RUN(it0_, end_, stride_) do { TrDesc d0, d1, d2, d3; f32x4 v0[8], v1[8], v2[8], v3[8]; float g0[8], g1[8], g2[8], g3[8]; int it = (it0_);     \
            for (; it + 3 * (stride_) < (end_); it += 4 * (stride_)) { TR_DECODE(d0, it); tr_load(v0, g0, d0, lane); TR_DECODE(d1, it + (stride_)); tr_load(v1, g1, d1, lane); TR_DECODE(d2, it + 2 * (stride_)); tr_load(v2, g2, d2, lane); \
                TR_DECODE(d3, it + 3 * (stride_)); tr_load(v3, g3, d3, lane); \
                tr_store(v0, g0, d0, scr, lane); tr_store(v1, g1, d1, scr, lane); tr_store(v2, g2, d2, scr, lane); tr_store(v3, g3, d3, scr, lane); } \
            for (; it < (end_); it += (stride_)) { TR_DECODE(d0, it); tr_load(v0, g0, d0, lane); tr_store(v0, g0, d0, scr, lane); } } while (0)
        TR_RUN(gw, TR_ITEMS, NGW);
        const int gt = bx * 512 + tid, NGT = G * 512;
        for (int i = gt; i < DEPTH * 8 * DM; i += NGT) { const int L = i / (8 * DM), h = (i / DM) % 8, k = i % DM;
            WFG[i] = norm_mix_g[L * DM + k] * w_in[(size_t)L * DM * DIN_SRC + (size_t)k * DIN_SRC + 1536 + h]; }
        for (int i = gt; i < DEPTH * 4 * 128 * 128; i += NGT) { const int t = (i >> 7) & 127, s = i & 127; SGUW[i] = (s <= t) ? (bf16_t)(cvt_pk_bf16(sgu_w[i], 0.f) & 0xffffu) : (bf16_t)0; }
        for (int i = gt; i < M * 8; i += NGT) { const int row = i >> 3, jj = i & 7; float sn, cs; sincos_d((double)pos_in[row] * c_rope_inv[jj], sn, cs); ROPE[row * 16 + jj] = cs; ROPE[row * 16 + 8 + jj] = sn; }
#define CVT_STREAM(src_, dst_, n_) do { const f32x4* s_ = (const f32x4*)(src_); u32x4* d_ = (u32x4*)(dst_); \
            for (int i = gt; i < (n_); i += 4 * NGT) { f32x4 a[4], b[4]; \
                _Pragma("unroll") for (int k = 0; k < 4; ++k) { const int ii = i + k * NGT; if (ii < (n_)) { a[k] = s_[2 * ii]; b[k] = s_[2 * ii + 1]; } else { a[k] = (f32x4){0.f, 0.f, 0.f, 0.f}; b[k] = a[k]; } } \
                _Pragma("unroll") for (int k = 0; k < 4; ++k) { const int ii = i + k * NGT; u32x4 w; w.x = cvt_pk_bf16(a[k].x, a[k].y); w.y = cvt_pk_bf16(a[k].z, a[k].w); w.z = cvt_pk_bf16(b[k].x, b[k].y); w.w = cvt_pk_bf16(b[k].z, b[k].w); \
                    if (ii < (n_)) d_[ii] = w; } } } while (0)
        CVT_STREAM(x_in, ws + WS_XR, M * DM / 8);
        CVT_STREAM(p_in, PB, DEPTH * M * PLE / 8);
#undef CVT_STREAM
    }
    SEAM(0);
    if (IN(1)) { WS_LOCAL();
        const int tid = MK_TID(), lane = tid & 63, gw = bx * 8 + wave0;
        norm_phase<true, false, false>(x_in, nullptr, nullptr, RSC, XN8, AS8, norm_mix_g, WFG, fox_b, LOGF, nullptr, nullptr, lds, gw, NGW, lane, tid);
    }
    SEAM(1);

    for (int L = 0; L < DEPTH; ++L) {
        const int pb = NPH_PRO + L * NPH_LAYER;
#define wl (ws + WS_WL + (size_t)L * WL_STRIDE)
        if (IN(pb + 0)) { WS_LOCAL();
            const int bxs = opaque_i(bx);
            if (bxs >= 32 && bxs < 48 && G >= 48) {
                const int wave = opaque_i(wave0), tid = wave * 64 + lane_id_now(), lane = tid & 63, gw = bx * 8 + wave; (void)lane; (void)gw;
                const int seq = bxs - 32, b = seq >> 3, h = seq & 7; float v[8], run = 0.f;
                { const f32x4 la = *(const f32x4*)(LOGF + (size_t)h * M + b * SEQ + tid * 8), lb = *(const f32x4*)(LOGF + (size_t)h * M + b * SEQ + tid * 8 + 4);
                  const float lv[8] = {la.x, la.y, la.z, la.w, lb.x, lb.y, lb.z, lb.w};
#pragma unroll
                  for (int e = 0; e < 8; ++e) { run += lv[e]; v[e] = run; } }
                float inc = run;
#pragma unroll
                for (int o = 1; o < 64; o <<= 1) { const float t = __int_as_float(__builtin_amdgcn_ds_bpermute(((lane - o) & 63) << 2, __float_as_int(inc))); if (lane >= o) inc += t; }
                LAS float* wt = (LAS float*)lds;
                if (lane == 63) wt[wave] = inc;
                __syncthreads();
                float base = inc - run;
                for (int w = 0; w < wave; ++w) base += wt[w];
#pragma unroll
                for (int e = 0; e < 8; ++e) FL[seq * SEQ + tid * 8 + e] = (base + v[e]) * LOG2E;
                __syncthreads();
            }
            pg8::Gemm g{XR, (const bf16_t*)(wl + WL_IN), M, NBT * 256, DM}; pg8::ProjOrder S; S.init(M, NBT * 256, G, bx);
            pg8::EpiProj E{PROJ, DIN, G8, RSC};
            pg8::gemm_phase(lds, g, S, E, pg8::NoHook{}, MK_TID());
            pg8::Gemm g8{(const bf16_t*)XN8, (const bf16_t*)(wl + WL_G8W), M, N8N, opaque_i(DM / 2)}; pg8::Gate8Order S8; S8.init(M, N8N, G, bx);
            pg8::EpiGate8 E8{G8, AS8, QSC + 2 * L, PROJ, DIN};
            pg8::gemm_phase<pg8::EpiGate8, pg8::NoHook, pg8::Gate8Order, true>(lds, g8, S8, E8, pg8::NoHook{}, MK_TID());
        }
        SEAM(pb + 0);
        if (IN(pb + 1)) { WS_LOCAL();
            unsigned* qhead = ctl + CW_Q + 64 * L;
            unsigned qcur = 0u;
            if (MK_TID() == 0) qcur = __hip_atomic_fetch_add(qhead, 1u, __ATOMIC_RELAXED, __HIP_MEMORY_SCOPE_AGENT);
            for (;;) {
                const int wave = opaque_i(wave0), tid = wave * 64 + lane_id_now(), lane = tid & 63; (void)lane;
                __syncthreads();
                if (tid == 0) *(volatile LAS unsigned*)(lds + att::LDS_QW) = qcur;
                __syncthreads();
                int u = (int)*(volatile LAS unsigned*)(lds + att::LDS_QW);
                const int nq_ = MIX_UNITS + ((L + 1 < DEPTH) ? MIX_TR : 0);
#if MIX_PROBE
                const int nx_ = MIX_PROBE == 1 ? MIX_FOX : MIX_PROBE == 2 ? MIX_DIL : MIX_PROBE == 3 ? MIX_SGU : MIX_PROBE == 4 ? MIX_CONV : ((L + 1 < DEPTH) ? MIX_TR : 0);
                if (u >= nq_ + nx_) break;
                const int ex_ = u - nq_;
#else
                if (u >= nq_) break;
#endif
                if (u < MIX_GEMM) {
                    pg8::StaticOrder so; so.init(M, N8N, 256, 0); pg8::Unit gu; so.map(I8_V + 896 + u, gu);
                    pg8::Gemm g8{(const bf16_t*)XN8, (const bf16_t*)(wl + WL_G8W), M, N8N, opaque_i(DM / 2)}; pg8::OneUnit S1{gu.pm, gu.pn}; pg8::EpiGate8 E8{G8, AS8, QSC + 2 * L, PROJ, DIN};
                    pg8::gemm_phase<pg8::EpiGate8, pg8::NoHook, pg8::OneUnit, true>(lds, g8, S1, E8, pg8::NoHook{}, MK_TID());
                    if (MK_TID() == 0) qcur = __hip_atomic_fetch_add(qhead, 1u, __ATOMIC_RELAXED, __HIP_MEMORY_SCOPE_AGENT);
                    continue;
                }
                u -= MIX_GEMM;
                unsigned qnext = 0u;
                if (tid == 0) qnext = __hip_atomic_fetch_add(qhead, 1u, __ATOMIC_RELAXED, __HIP_MEMORY_SCOPE_AGENT);
                int cu = -1;
                if (L + 1 < DEPTH) { const int k = u / 19, r = u - 19 * k; if (k < 98) { if (r < 13) u = 13 * k + r; else cu = 6 * k + r - 13; } else u -= MIX_TR; }
#if MIX_PROBE
                if (ex_ >= 0) { cu = -1; u = ex_ + (MIX_PROBE == 2 ? MIX_FOX : MIX_PROBE == 3 ? MIX_FOX + MIX_DIL : MIX_PROBE == 4 ? MIX_FOX + MIX_DIL + MIX_SGU : 0); if (MIX_PROBE == 5) cu = ex_; }
#endif
                if (cu >= 0) {
                    LAS float* scr = (LAS float*)(lds + wave * 8448); LAS float* qsl = (LAS float*)(lds + RING_BYTES + 4096);
                    const int b0 = (L + 1) * TR_ITEMS + cu * MIX_TRI;
                    TR_RUN(b0 + wave, b0 + MIX_TRI, 8);
                } else if (u < MIX_FOX) {
                    const bool split = u < 256; int qb, seg, bh;
                    if (split) { qb = 15 - (u >> 5); seg = (u >> 4) & 1; bh = u & 15; } else { const int v = u - 256; qb = 7 - (v >> 4); seg = 0; bh = v & 15; }
                    const int b = bh >> 3, h = bh & 7;
                    att::AttnArgs A; const size_t r0 = (size_t)b * SEQ * DIN;
                    A.Q = PROJ + r0 + PC_AQ + h * 64; A.K = PROJ + r0 + PC_AK + h * 64; A.V = PROJ + r0 + PC_AV + h * 64; A.rs = DIN;
                    A.q0 = qb * 256; A.kbase = 0; A.Fl = FL + bh * SEQ; A.rope = nullptr; A.rrs = 0;
                    if (split) {
                        A.jlo = seg ? 2 * (qb + 1) : 0; A.jhi = seg ? 4 * (qb + 1) : 2 * (qb + 1);
                        A.Ob = nullptr; A.Of = FOP + (((long)seg * 4096 + (long)b * 2048 - 2048) * 8 + h) * 64; A.ors = 8 * 64;
                        A.lse = FML + (((long)seg * 4096 + (long)b * 2048 - 2048) * 8 + h) * 2; A.lrs = 16;
                        att::attn_unit<2>(lds, A, tid);
                    } else {
                        A.jlo = 0; A.jhi = 4 * (qb + 1);
                        A.Ob = OCAT + (size_t)b * SEQ * OC_W + OC_A + h * 64; A.Of = nullptr; A.ors = OC_W; A.lse = nullptr; A.lrs = 0;
                        att::attn_unit<0>(lds, A, tid);
                    }
                } else if (u < MIX_FOX + MIX_DIL) {
                    u -= MIX_FOX; const int grp = u >> 7, v = u & 127; const int sh = 2 * grp, dil = 1 << sh;
                    const int nqb = 16 >> sh; const int qb = v % nqb; int t = v / nqb; const int slot = t & 3; t >>= 2; const int res = t % dil; const int b = t / dil;
                    const int head = grp * 4 + slot; const size_t row0 = (size_t)b * SEQ + res;
                    att::AttnArgs A;
                    A.Q = PROJ + row0 * DIN + PC_DQ + head * 64; A.K = PROJ + row0 * DIN + PC_DK + head * 64; A.V = PROJ + row0 * DIN + PC_DV + head * 64; A.rs = (long)DIN * dil;
                    A.q0 = qb * 256; A.kbase = qb * 256 - 128; A.jlo = (qb == 0) ? 2 : 0; A.jhi = 6; A.Fl = nullptr; A.rope = ROPE + row0 * 16; A.rrs = 16L * dil;
                    A.Ob = nullptr; A.Of = ODIL + ((size_t)grp * M + row0) * 256 + slot * 64; A.ors = 256L * dil; A.lse = LSE + ((size_t)grp * M + row0) * 4 + slot; A.lrs = 4L * dil;
                    att::attn_unit<1>(lds, A, tid);
                } else if (u < MIX_FOX + MIX_DIL + MIX_SGU) {
                    u -= MIX_FOX + MIX_DIL; const int g = u & 3, c = (u >> 2) & 31, b = u >> 7; const size_t row0 = (size_t)b * SEQ + c * 128;
                    const int row = tid >> 2, part = tid & 3;
                    const int r32 = lane & 31, hh = lane >> 5, tb = wave & 3, dp = wave >> 2;
                    const bf16_t* wrow = SGUW + ((size_t)(L * 4 + g) * 128 + 32 * tb + r32) * 128 + 8 * hh;
                    bf16x8 wa[8];
#pragma unroll
                    for (int i = 0; i < 8; ++i) wa[i] = *(const bf16x8*)(wrow + 16 * i);
                    const bf16_t* vrow = PROJ + (row0 + row) * DIN + PC_SV;
                    const float* gsn = sgu_g + L * 512 + 128 * g + 32 * part;
                    u32x4 wg[4]; f32x4 gga[4], ggb[4];
#pragma unroll
                    for (int i = 0; i < 4; ++i) { wg[i] = *(const u32x4*)(vrow + 128 * g + 32 * part + 8 * i); gga[i] = *(const f32x4*)(gsn + 8 * i); ggb[i] = *(const f32x4*)(gsn + 8 * i + 4); }
                    float ss = 0.f;
#pragma unroll
                    for (int i = 0; i < 16; ++i) { const u32x4 w = *(const u32x4*)(vrow + part * 128 + 8 * i);
                        ss += (bf_lo(w.x) * bf_lo(w.x) + bf_hi(w.x) * bf_hi(w.x)) + (bf_lo(w.y) * bf_lo(w.y) + bf_hi(w.y) * bf_hi(w.y)) + (bf_lo(w.z) * bf_lo(w.z) + bf_hi(w.z) * bf_hi(w.z)) + (bf_lo(w.w) * bf_lo(w.w) + bf_hi(w.w) * bf_hi(w.w)); }
                    ss += shx(ss, 1, lane); ss += shx(ss, 2, lane);
                    const float rinv = 1.0f / sqrtf(ss * (1.0f / 512.0f) + EPS);
#pragma unroll
                    for (int i = 0; i < 4; ++i) { const u32x4 w = wg[i]; const f32x4 ga = gga[i], gb = ggb[i];
                        u32x4 o; o.x = cvt_pk_bf16(bf_lo(w.x) * rinv * ga.x, bf_hi(w.x) * rinv * ga.y); o.y = cvt_pk_bf16(bf_lo(w.y) * rinv * ga.z, bf_hi(w.y) * rinv * ga.w);
                        o.z = cvt_pk_bf16(bf_lo(w.z) * rinv * gb.x, bf_hi(w.z) * rinv * gb.y); o.w = cvt_pk_bf16(bf_lo(w.w) * rinv * gb.z, bf_hi(w.w) * rinv * gb.w);
                        *(LAS u32x4*)(lds + att::LDS_SV + part * 8192 + row * 64 + i * 16) = o; }
                    BAR_L();
                    float bia[16]; bf16_t uu0[16], uu1[16];
#pragma unroll
                    for (int r = 0; r < 16; ++r) { const int t = 32 * tb + att::crow(r, hh); const size_t gr = row0 + t; const int d = 128 * g + 64 * dp + r32;
                        bia[r] = sgu_b[(L * 4 + g) * 128 + t]; uu0[r] = PROJ[gr * DIN + PC_SU + d]; uu1[r] = PROJ[gr * DIN + PC_SU + d + 32]; }
                    f32x16 o0, o1;
#pragma unroll
                    for (int r = 0; r < 16; ++r) { o0[r] = 0.f; o1[r] = 0.f; }
                    const LAS unsigned char* vp = lds + att::LDS_SV + (2 * dp) * 8192 + ((lane >> 4) & 1) * 32 + (lane & 3) * 8 + (8 * hh + ((lane & 15) >> 2)) * 64;
#pragma unroll
                    for (int i = 0; i < 8; ++i) { if (i >= 2 * tb + 2) break;
                        const bf16x8 a = wa[i];
                        const s16x4 a0 = att::vtr(vp + i * 1024), a1 = att::vtr(vp + i * 1024 + 256), b0 = att::vtr(vp + 8192 + i * 1024), b1 = att::vtr(vp + 8192 + i * 1024 + 256);
                        const bf16x8 v0 = (bf16x8){a0[0], a0[1], a0[2], a0[3], a1[0], a1[1], a1[2], a1[3]}, v1 = (bf16x8){b0[0], b0[1], b0[2], b0[3], b1[0], b1[1], b1[2], b1[3]};
                        o0 = __builtin_amdgcn_mfma_f32_32x32x16_bf16(a, v0, o0, 0, 0, 0); o1 = __builtin_amdgcn_mfma_f32_32x32x16_bf16(a, v1, o1, 0, 0, 0);
                    }
#pragma unroll
                    for (int r = 0; r < 16; ++r) { const int t = 32 * tb + att::crow(r, hh); const size_t gr = row0 + t; const float bias = bia[r];
                        const int d = 128 * g + 64 * dp + r32;
                        const float u0 = bf1(uu0[r]), u1 = bf1(uu1[r]);
                        OCAT[gr * OC_W + OC_C + d] = (bf16_t)(cvt_pk_bf16(u0 * (o0[r] + bias), 0.f) & 0xffffu); OCAT[gr * OC_W + OC_C + d + 32] = (bf16_t)(cvt_pk_bf16(u1 * (o1[r] + bias), 0.f) & 0xffffu); }
                } else {
                    u -= MIX_FOX + MIX_DIL + MIX_SGU;
                    {
                        const int c = (tid & 63) * 8, rbase = 32 * u + 4 * (tid >> 6), t0 = rbase & (SEQ - 1);
                        const bf16_t* pr = PROJ + (size_t)rbase * DIN; u32x4 xa[6], gc[6], gb[4];
#pragma unroll
                        for (int k = 0; k < 6; ++k) { if (k >= 2 || t0 >= 2) { xa[k] = *(const u32x4*)(pr + (long)(k - 2) * DIN + PC_XB + c); gc[k] = *(const u32x4*)(pr + (long)(k - 2) * DIN + PC_GC + c); }
                                                      else { xa[k] = (u32x4){0u, 0u, 0u, 0u}; gc[k] = (u32x4){0u, 0u, 0u, 0u}; } }
#pragma unroll
                        for (int i = 0; i < 4; ++i) gb[i] = *(const u32x4*)(pr + (size_t)i * DIN + PC_GB + c);
                        const float* wk = scw + (size_t)L * 3 * 512 + c; float w0[8], w1[8], w2[8];
#pragma unroll
                        for (int e = 0; e < 8; ++e) { w0[e] = wk[e]; w1[e] = wk[512 + e]; w2[e] = wk[1024 + e]; }
                        float y[6][8];
#pragma unroll
                        for (int k = 0; k < 6; ++k) { const u32x4 a = xa[k], g2 = gc[k];
                            y[k][0] = bf_lo(a.x) * bf_lo(g2.x); y[k][1] = bf_hi(a.x) * bf_hi(g2.x); y[k][2] = bf_lo(a.y) * bf_lo(g2.y); y[k][3] = bf_hi(a.y) * bf_hi(g2.y);
                            y[k][4] = bf_lo(a.z) * bf_lo(g2.z); y[k][5] = bf_hi(a.z) * bf_hi(g2.z); y[k][6] = bf_lo(a.w) * bf_lo(g2.w); y[k][7] = bf_hi(a.w) * bf_hi(g2.w); }
#pragma unroll
                        for (int i = 0; i < 4; ++i) { const u32x4 g = gb[i]; const float gbf[8] = {bf_lo(g.x), bf_hi(g.x), bf_lo(g.y), bf_hi(g.y), bf_lo(g.z), bf_hi(g.z), bf_lo(g.w), bf_hi(g.w)}; float o[8];
#pragma unroll
                            for (int e = 0; e < 8; ++e) o[e] = gbf[e] * (w0[e] * y[i][e] + w1[e] * y[i + 1][e] + w2[e] * y[i + 2][e]);
                            u32x4 w; w.x = cvt_pk_bf16(o[0], o[1]); w.y = cvt_pk_bf16(o[2], o[3]); w.z = cvt_pk_bf16(o[4], o[5]); w.w = cvt_pk_bf16(o[6], o[7]);
                            *(u32x4*)(OCAT + (size_t)(rbase + i) * OC_W + OC_B + c) = w; }
                    }
                }
                qcur = qnext;
            }
            __syncthreads();
        }
#undef TR_RUN
#undef TR_DECODE
        SEAM(pb + 1);
        if (IN(pb + 2)) { WS_LOCAL();
            const int wave = opaque_i(wave0), tid = wave * 64 + lane_id_now(), lane = tid & 63, gw = bx * 8 + wave; (void)lane; (void)gw;
            if (G * 512 * 2 == M * 4 * 8) {
                const int gt = bx * 512 + tid, NT = G * 512;
                float l2[2][3]; f32x4 da[2][3], db[2][3]; float fm0[2], fl0[2], fm1[2], fl1[2]; f32x4 fa0[2], fa1[2], fb0[2], fb1[2];
#pragma unroll
                for (int q = 0; q < 2; ++q) { const int i = gt + q * NT, d8 = i & 7, slot = (i >> 3) & 3, row = i >> 5;
#pragma unroll
                    for (int g = 0; g < 3; ++g) { l2[q][g] = LSE[((size_t)g * M + row) * 4 + slot]; const float* od = ODIL + ((size_t)g * M + row) * 256 + slot * 64 + d8 * 8; da[q][g] = *(const f32x4*)od; db[q][g] = *(const f32x4*)(od + 4); }
                    const int h = (i >> 3) & 7, rr = i >> 6;
                    fm0[q] = FML[((size_t)rr * 8 + h) * 2]; fl0[q] = FML[((size_t)rr * 8 + h) * 2 + 1]; fm1[q] = FML[((size_t)(4096 + rr) * 8 + h) * 2]; fl1[q] = FML[((size_t)(4096 + rr) * 8 + h) * 2 + 1];
                    const float* p0 = FOP + ((size_t)rr * 8 + h) * 64 + d8 * 8; const float* p1 = FOP + ((size_t)(4096 + rr) * 8 + h) * 64 + d8 * 8;
                    fa0[q] = *(const f32x4*)p0; fa1[q] = *(const f32x4*)(p0 + 4); fb0[q] = *(const f32x4*)p1; fb1[q] = *(const f32x4*)(p1 + 4); }
#pragma unroll
                for (int q = 0; q < 2; ++q) { const int i = gt + q * NT, d8 = i & 7, slot = (i >> 3) & 3, row = i >> 5;
                    const float mx = fmaxf(fmaxf(l2[q][0], l2[q][1]), l2[q][2]); float wsum = 0.f; f32x4 oa = {0.f, 0.f, 0.f, 0.f}, ob = {0.f, 0.f, 0.f, 0.f};
#pragma unroll
                    for (int g = 0; g < 3; ++g) { const float w = fast_exp2(l2[q][g] - mx); wsum += w; oa = oa + da[q][g] * w; ob = ob + db[q][g] * w; }
                    const float inv = 1.0f / wsum; u32x4 w; w.x = cvt_pk_bf16(oa.x * inv, oa.y * inv); w.y = cvt_pk_bf16(oa.z * inv, oa.w * inv); w.z = cvt_pk_bf16(ob.x * inv, ob.y * inv); w.w = cvt_pk_bf16(ob.z * inv, ob.w * inv);
                    *(u32x4*)(OCAT + (size_t)row * OC_W + OC_D + slot * 64 + d8 * 8) = w;
                    const int h = (i >> 3) & 7, rr = i >> 6, b = rr >> 11, t = 2048 + (rr & 2047);
                    const float mm = fmaxf(fm0[q], fm1[q]), w0 = fast_exp2(fm0[q] - mm), w1 = fast_exp2(fm1[q] - mm), inv2 = 1.0f / (w0 * fl0[q] + w1 * fl1[q]);
                    const f32x4 o0 = (fa0[q] * w0 + fb0[q] * w1) * inv2, o1 = (fa1[q] * w0 + fb1[q] * w1) * inv2;
                    u32x4 w2; w2.x = cvt_pk_bf16(o0.x, o0.y); w2.y = cvt_pk_bf16(o0.z, o0.w); w2.z = cvt_pk_bf16(o1.x, o1.y); w2.w = cvt_pk_bf16(o1.z, o1.w);
                    *(u32x4*)(OCAT + ((size_t)b * SEQ + t) * OC_W + OC_A + h * 64 + d8 * 8) = w2; }
            } else {
            for (int i = bx * 512 + tid; i < M * 4 * 8; i += G * 512) { const int d8 = i & 7, slot = (i >> 3) & 3, row = i >> 5;
                float l2[3], mx = -3.0e38f;
#pragma unroll
                for (int g = 0; g < 3; ++g) { l2[g] = LSE[((size_t)g * M + row) * 4 + slot]; mx = fmaxf(mx, l2[g]); }
                float wsum = 0.f, o[8];
#pragma unroll
                for (int e = 0; e < 8; ++e) o[e] = 0.f;
#pragma unroll
                for (int g = 0; g < 3; ++g) { const float w = fast_exp2(l2[g] - mx); wsum += w; const float* od = ODIL + ((size_t)g * M + row) * 256 + slot * 64 + d8 * 8;
                    const f32x4 a = *(const f32x4*)od, b = *(const f32x4*)(od + 4); o[0] += w * a.x; o[1] += w * a.y; o[2] += w * a.z; o[3] += w * a.w; o[4] += w * b.x; o[5] += w * b.y; o[6] += w * b.z; o[7] += w * b.w; }
                const float inv = 1.0f / wsum; u32x4 w; w.x = cvt_pk_bf16(o[0] * inv, o[1] * inv); w.y = cvt_pk_bf16(o[2] * inv, o[3] * inv); w.z = cvt_pk_bf16(o[4] * inv, o[5] * inv); w.w = cvt_pk_bf16(o[6] * inv, o[7] * inv);
                *(u32x4*)(OCAT + (size_t)row * OC_W + OC_D + slot * 64 + d8 * 8) = w; }
            for (int i = bx * 512 + tid; i < 4096 * 8 * 8; i += G * 512) {
                const int d8 = i & 7, h = (i >> 3) & 7, rr = i >> 6; const int b = rr >> 11, t = 2048 + (rr & 2047);
                const float m0 = FML[((size_t)rr * 8 + h) * 2], l0 = FML[((size_t)rr * 8 + h) * 2 + 1], m1 = FML[((size_t)(4096 + rr) * 8 + h) * 2], l1 = FML[((size_t)(4096 + rr) * 8 + h) * 2 + 1];
                const float mm = fmaxf(m0, m1), w0 = fast_exp2(m0 - mm), w1 = fast_exp2(m1 - mm), inv = 1.0f / (w0 * l0 + w1 * l1);
                const float* p0 = FOP + ((size_t)rr * 8 + h) * 64 + d8 * 8; const float* p1 = FOP + ((size_t)(4096 + rr) * 8 + h) * 64 + d8 * 8;
                const f32x4 a0 = *(const f32x4*)p0, a1 = *(const f32x4*)(p0 + 4), b0 = *(const f32x4*)p1, b1 = *(const f32x4*)(p1 + 4);
                const f32x4 o0 = (a0 * w0 + b0 * w1) * inv, o1 = (a1 * w0 + b1 * w1) * inv;
                u32x4 w; w.x = cvt_pk_bf16(o0.x, o0.y); w.y = cvt_pk_bf16(o0.z, o0.w); w.z = cvt_pk_bf16(o1.x, o1.y); w.w = cvt_pk_bf16(o1.z, o1.w);
                *(u32x4*)(OCAT + ((size_t)b * SEQ + t) * OC_W + OC_A + h * 64 + d8 * 8) = w; }
            }
            {
                pg8::Gemm g2{PB + (size_t)L * M * PLE, (const bf16_t*)(wl + WL_PE), M, DM, opaque_i(PLE)};   pg8::StaticOrder S2; S2.init(M, DM, G, bx);
                pg8::EpiPlain E2{PP + (size_t)L * M * DM, DM};
                __syncthreads();
                pg8::gemm_phase(lds, g2, S2, E2, pg8::NoHook{}, MK_TID());
            }
        }
        SEAM(pb + 2);
        if (IN(pb + 3)) { WS_LOCAL();
            pg8::Gemm g{OCAT, (const bf16_t*)(wl + WL_BR), M, DM, OC_W}; pg8::StaticOrder S; S.init(M, DM, G, bx);
            pg8::EpiMerge E{MG, DM, G8 + 3 * 2048}; pg8::MergeHook H{G8};
            pg8::gemm_phase(lds, g, S, E, H, MK_TID());
        }
        SEAM(pb + 3);
        if (IN(pb + 4)) { WS_LOCAL();
            pg8::Gemm g{MG, (const bf16_t*)(wl + WL_OUT), M, DM, DM}; pg8::StaticOrder S; S.init(M, DM, G, bx);
            pg8::EpiResidN E{XR, nullptr};
            pg8::gemm_phase(lds, g, S, E, pg8::NoHook{}, MK_TID());
        }
        SEAM(pb + 4);
        if (IN(pb + 5)) { WS_LOCAL();
            const int wave = opaque_i(wave0), tid = wave * 64 + lane_id_now(), lane = tid & 63, gw = bx * 8 + wave; (void)lane; (void)gw;
            norm_phase<false, false, true>(nullptr, XR, nullptr, nullptr, XN8, AS8, norm_ffn_g + L * DM, nullptr, nullptr, nullptr, nullptr, nullptr, lds, gw, NGW, lane, tid);
        }
        SEAM(pb + 5);
        if (IN(pb + 6)) { WS_LOCAL();
            pg8::Gemm g{(const bf16_t*)XN8, (const bf16_t*)(wl + WL_UP), M, 2 * DFF, opaque_i(DM / 2)}; pg8::UpOrder S; S.init(M, G, bx);
            pg8::EpiUp8 E{UP, 2 * DFF, AS8, QSC + 2 * L + 1, UPB, 1024, 40 * 256};
            pg8::gemm_phase<pg8::EpiUp8, pg8::NoHook, pg8::UpOrder, true>(lds, g, S, E, pg8::NoHook{}, MK_TID());
        }
        SEAM(pb + 6);
        if (IN(pb + 7)) { WS_LOCAL();
            const int wave = opaque_i(wave0), tid = wave * 64 + lane_id_now(), lane = tid & 63, gw = bx * 8 + wave; (void)lane; (void)gw;
            const float* cw = ffn_cw + (size_t)L * 3 * 2 * DFF;
            for (int item = bx * 512 + tid; item < 1024 * 704; item += G * 512) { const int rb = item / 704, c = (item % 704) * 8, row0 = rb * 8, t0 = row0 & (SEQ - 1);
                u32x4 gq[10], vq[10];
#pragma unroll
                for (int r = 0; r < 10; ++r) { if (r >= 2 || t0 >= 2) { const bf16_t* pr = UP + (size_t)(row0 + r - 2) * 2 * DFF + c; gq[r] = *(const u32x4*)pr; vq[r] = *(const u32x4*)(pr + DFF); }
                                               else { gq[r] = (u32x4){0u, 0u, 0u, 0u}; vq[r] = (u32x4){0u, 0u, 0u, 0u}; } }
                if (c >= 4608) {
#pragma unroll
                    for (int r = 0; r < 10; ++r) { if (r >= 2 || t0 >= 2) { const u32x4 b2 = *(const u32x4*)(UPB + (size_t)(row0 + r - 2) * 1024 + (c - 4608)); u32x4 s;
#pragma unroll
                            for (int e = 0; e < 4; ++e) s[e] = cvt_pk_bf16(bf_lo(vq[r][e]) + bf_lo(b2[e]), bf_hi(vq[r][e]) + bf_hi(b2[e]));
                            vq[r] = s; } } }
                float rq[10];
#pragma unroll
                for (int r = 0; r < 10; ++r) rq[r] = 1.0f;
                float wg[3][8], wv[3][8];
#pragma unroll
                for (int k = 0; k < 3; ++k) { const f32x4 a = *(const f32x4*)(cw + k * 2 * DFF + c), b = *(const f32x4*)(cw + k * 2 * DFF + c + 4), d = *(const f32x4*)(cw + k * 2 * DFF + DFF + c), e2 = *(const f32x4*)(cw + k * 2 * DFF + DFF + c + 4);
                    wg[k][0] = a.x; wg[k][1] = a.y; wg[k][2] = a.z; wg[k][3] = a.w; wg[k][4] = b.x; wg[k][5] = b.y; wg[k][6] = b.z; wg[k][7] = b.w;
                    wv[k][0] = d.x; wv[k][1] = d.y; wv[k][2] = d.z; wv[k][3] = d.w; wv[k][4] = e2.x; wv[k][5] = e2.y; wv[k][6] = e2.z; wv[k][7] = e2.w; }
#pragma unroll
                for (int r = 0; r < 8; ++r) { const u32x4 g0 = gq[r], g1 = gq[r + 1], g2 = gq[r + 2], v0 = vq[r], v1 = vq[r + 1], v2 = vq[r + 2];
                    float o[8];
#pragma unroll
                    for (int e = 0; e < 4; ++e) {
                        const float q0 = rq[r], q1 = rq[r + 1], q2 = rq[r + 2];
                        const float ga = wg[0][2 * e] * q0 * bf_lo(g0[e]) + wg[1][2 * e] * q1 * bf_lo(g1[e]) + wg[2][2 * e] * q2 * bf_lo(g2[e]), gb2 = wg[0][2 * e + 1] * q0 * bf_hi(g0[e]) + wg[1][2 * e + 1] * q1 * bf_hi(g1[e]) + wg[2][2 * e + 1] * q2 * bf_hi(g2[e]);
                        const float va = wv[0][2 * e] * q0 * bf_lo(v0[e]) + wv[1][2 * e] * q1 * bf_lo(v1[e]) + wv[2][2 * e] * q2 * bf_lo(v2[e]), vb = wv[0][2 * e + 1] * q0 * bf_hi(v0[e]) + wv[1][2 * e + 1] * q1 * bf_hi(v1[e]) + wv[2][2 * e + 1] * q2 * bf_hi(v2[e]);
                        o[2 * e] = ga * sigmoid_f(ga) * va; o[2 * e + 1] = gb2 * sigmoid_f(gb2) * vb; }
                    u32x4 w; w.x = cvt_pk_bf16(o[0], o[1]); w.y = cvt_pk_bf16(o[2], o[3]); w.z = cvt_pk_bf16(o[4], o[5]); w.w = cvt_pk_bf16(o[6], o[7]);
                    *(u32x4*)(HID + (size_t)(row0 + r) * DFF + c) = w; }
            }
        }
        SEAM(pb + 7);
        if (IN(pb + 8)) { WS_LOCAL();
            pg8::Gemm g{HID, (const bf16_t*)(wl + WL_DN), M, DM, DFF}; pg8::StaticOrder S; S.init(M, DM, G, bx);
            pg8::EpiResidN E{XR, SSQ + (size_t)M * 32};
            pg8::gemm_phase(lds, g, S, E, pg8::NoHook{}, MK_TID());
        }
        SEAM(pb + 8);
        if (IN(pb + 9)) { WS_LOCAL();
            pg8::Gemm g{XR, (const bf16_t*)(wl + WL_PG), M, DM, DM}; pg8::StaticOrder S; S.init(M, DM, G, bx);
            pg8::EpiPle E{XR, XRN, PP + (size_t)L * M * DM, SSQ + (size_t)M * 32};
            pg8::gemm_phase(lds, g, S, E, pg8::NoHook{}, MK_TID());
        }
        SEAM(pb + 9);
        if (IN(pb + 10)) { WS_LOCAL();
            const int wave = opaque_i(wave0), tid = wave * 64 + lane_id_now(), lane = tid & 63, gw = bx * 8 + wave; (void)lane; (void)gw;
            if (L + 1 < DEPTH) norm_phase<true, false, true>(nullptr, XRN, nullptr, RSC, XN8, AS8, norm_mix_g + (L + 1) * DM, WFG + (size_t)(L + 1) * 8 * DM, fox_b + (L + 1) * 8, LOGF, nullptr, nullptr, lds, gw, NGW, lane, tid);
            else norm_phase<false, true, true>(nullptr, XRN, nullptr, nullptr, nullptr, nullptr, nullptr, nullptr, nullptr, nullptr, final_g, X, lds, gw, NGW, lane, tid);
        }
        SEAM(pb + 10);
    }
#undef IN
#undef SEAM
#undef MK_TID
}
#undef x_in
#undef p_in
#undef pos_in
#undef norm_mix_g
#undef w_in
#undef fox_b
#undef scw
#undef sgu_g
#undef sgu_w
#undef sgu_b
#undef w_br_fox
#undef w_br_conv
#undef w_br_sgu
#undef w_br_dil
#undef w_out
#undef norm_ffn_g
#undef w_up
#undef ffn_cw
#undef w_down
#undef norm_ple_g
#undef w_pg
#undef w_pe
#undef final_g
#undef WFG
#undef SGUW
#undef ROPE
#undef LOGF
#undef FL
#undef LSE
#undef SSQ
#undef RSC
#undef FOP
#undef FML
#undef UPB
#undef G8
#undef XN8
#undef AS8
#undef QSC
#undef XR
#undef XRN
#undef PB
#undef PP
#undef XN
#undef PROJ
#undef UP
#undef HID
#undef OCAT
#undef MG
#undef ODIL
#undef WS_LOCAL
#undef wl

extern "C" void kernel_launch(void* const* d_in, const int* in_sizes, int n_in, void* d_out, int out_size, void* d_ws, size_t ws_size, hipStream_t stream) {
    static int grid = 0;
    if (grid == 0) {
        if (n_in != 23 || in_sizes[0] != M * DM || out_size != M * DM || ws_size < WS_END) { fprintf(stderr, "kernel_launch: unexpected shapes/workspace (n_in %d, ws %zu < %zu)\n", n_in, ws_size, (size_t)WS_END); grid = -1; return; }
        int dev = 0, cus = 0, per_cu = 0;
        if (hipGetDevice(&dev) != hipSuccess || hipDeviceGetAttribute(&cus, hipDeviceAttributeMultiprocessorCount, dev) != hipSuccess) { grid = -1; return; }
        if (hipFuncSetAttribute((const void*)mk_fwd, hipFuncAttributeMaxDynamicSharedMemorySize, LDS_BYTES) != hipSuccess) { fprintf(stderr, "kernel_launch: hipFuncSetAttribute failed\n"); grid = -1; return; }
        if (hipOccupancyMaxActiveBlocksPerMultiprocessor(&per_cu, (const void*)mk_fwd, 512, LDS_BYTES) != hipSuccess || per_cu < 1) fprintf(stderr, "kernel_launch: occupancy query says %d\n", per_cu);
        (void)hipGetLastError();
        grid = cus;
    }
    if (grid < 0) return;
    if (hipMemsetAsync((char*)d_ws + WS_CTL, 0, CTL_BYTES, stream) != hipSuccess) return;
    Args a{};
    for (int i = 0; i < 23; ++i) a.in[i] = (const float*)d_in[i];
    a.out = (float*)d_out; a.ws = (unsigned char*)d_ws; a.pad = 0;
    const int step = (MK_SPLIT > 0) ? MK_SPLIT : NPHASE;
    int li = 0;
    for (int lo = 0; lo < NPHASE; lo += step, ++li) {
        a.ph_lo = lo; a.ph_hi = (lo + step < NPHASE) ? lo + step : NPHASE; a.li = li;
        hipLaunchKernelGGL(mk_fwd, dim3(grid), dim3(512), LDS_BYTES, stream, a);
        if (hipPeekAtLastError() != hipSuccess) { fprintf(stderr, "kernel_launch: launch %d failed\n", li); break; }
    }
}
```

```cpp
#include <hip/hip_runtime.h>
#include <cstdio>
#include <cstdint>

#ifndef PROBE_PH
#define PROBE_PH -1
#endif
#ifndef MIX_PROBE
#define MIX_PROBE 0
#endif
#ifndef MK_SPLIT
#define MK_SPLIT 0
#endif

#define LAS __attribute__((address_space(3)))
#define GAS __attribute__((address_space(1)))
typedef unsigned short bf16_t;
typedef short bf16x8 __attribute__((ext_vector_type(8)));
typedef short s16x4 __attribute__((ext_vector_type(4)));
typedef float f32x2 __attribute__((ext_vector_type(2)));
typedef float f32x4 __attribute__((ext_vector_type(4)));
typedef float f32x16 __attribute__((ext_vector_type(16)));
typedef unsigned u32x2 __attribute__((ext_vector_type(2)));
typedef unsigned u32x4 __attribute__((ext_vector_type(4)));
typedef int v4i __attribute__((ext_vector_type(4)));


constexpr int NB = 2, SEQ = 4096, DM = 2048, DEPTH = 4, M = NB * SEQ;
constexpr int DIN_SRC = 14600, DIN = 14592;
constexpr int DFF = 5632, PLE = 256;
constexpr float EPS = 1e-6f;
constexpr float LOG2E = 1.4426950408889634f;
constexpr float C2 = 0.125f * LOG2E;
constexpr float WQ_MAX = 0.126f, WQ_INV = 127.0f / WQ_MAX, WQ_S = WQ_MAX / 127.0f;
constexpr int PC_AQ = 0, PC_AK = 512, PC_AV = 1024, PC_XB = 1536, PC_GB = 2048, PC_GC = 2560, PC_SU = 3072, PC_SV = 3584,
              PC_DQ = 4096, PC_DK = 4864, PC_DV = 5632, PC_G = 6400;
constexpr unsigned I8MASK = (3u << 4) | (7u << 22);
constexpr int N8T = __builtin_popcount(I8MASK), NBT = 25 - N8T, N8N = 8192 + N8T * 256;
constexpr int PB_EXTRA = (NBT * 32) % 256, I8_UNITS = (32 + N8T) * 32, I8_X = (I8_UNITS - (PB_EXTRA ? 2 * (256 - PB_EXTRA) : 0)) / 256;
constexpr int I8_INPHASE = I8_X * 256 + (PB_EXTRA ? 2 * (256 - PB_EXTRA) : 0), MIX_GEMM = I8_UNITS - I8_INPHASE;
__host__ __device__ __forceinline__ int nth_set(unsigned m, int k) { for (int i = 0; i < k; ++i) m &= m - 1u; return __builtin_ctz(m); }
constexpr int OC_W = 1792;
constexpr int OC_A = 0, OC_B = 512, OC_C = 1024, OC_D = 1536;

constexpr size_t MiB = 1u << 20;
constexpr size_t WS_CTL = 0, CTL_BYTES = (MK_SPLIT > 0) ? 2 * MiB : 64 * 1024;
constexpr size_t WS_WL = 2 * MiB;
constexpr size_t WL_IN = 0, WL_G8W = 32 * MiB  , WL_BR = 57 * MiB, WL_OUT = 64 * MiB, WL_UP = 72 * MiB, WL_DN = 116 * MiB, WL_PG = 138 * MiB, WL_PE = 146 * MiB, WL_STRIDE = 147 * MiB;
constexpr size_t WS_SMALL = WS_WL + 4 * WL_STRIDE;
constexpr size_t SM_WFG = 0, SM_SGUW = 256 * 1024, SM_ROPE = 768 * 1024, SM_LOGF = 1280 * 1024, SM_FL = 1536 * 1024, SM_LSE = 1792 * 1024, SM_SS = 2304 * 1024;
constexpr size_t WS_PB = WS_SMALL + 4 * MiB;
constexpr size_t WS_PP = WS_PB + 16 * MiB;
constexpr size_t WS_XN = WS_PP + 128 * MiB;
constexpr size_t WS_PROJ = WS_XN + 32 * MiB;
constexpr size_t WS_HID = WS_PROJ + 228 * MiB;
constexpr size_t WS_OCAT = WS_HID + 88 * MiB;
constexpr size_t WS_MG = WS_OCAT + 28 * MiB;
constexpr size_t WS_ODIL = WS_MG + 32 * MiB;
constexpr size_t WS_PART = WS_ODIL + 24 * MiB;
constexpr size_t WS_FOP = WS_PART + 2 * MiB;
constexpr size_t WS_FML = WS_FOP + 16 * MiB;
constexpr size_t WS_UPB = WS_FML + 1 * MiB;
constexpr size_t WS_XR = WS_UPB + 16 * MiB;
constexpr size_t WS_G8 = WS_XR + 64 * MiB;
constexpr size_t WS_XN8 = WS_G8 + 64 * MiB;
constexpr size_t WS_END = WS_XN8 + 16 * MiB;
constexpr int CW_BAR = 4096;
constexpr int CW_Q = 1024;

constexpr int LDS_BYTES = 147456;
constexpr int RING_BYTES = 131072;
constexpr int MISC_OFF = RING_BYTES + 320;

#define LDS_WAIT() asm volatile("s_waitcnt lgkmcnt(0)" ::: "memory")
#define VM_WAIT() asm volatile("s_waitcnt vmcnt(0)" ::: "memory")
#define BAR_L() asm volatile("s_waitcnt lgkmcnt(0)\n\ts_barrier" ::: "memory")
typedef __bf16 bf16x2_t __attribute__((ext_vector_type(2)));
__device__ __forceinline__ unsigned cvt_pk_bf16(float lo, float hi) { f32x2 v = {lo, hi}; bf16x2_t b = __builtin_convertvector(v, bf16x2_t); return __builtin_bit_cast(unsigned, b); }
__device__ __forceinline__ float ub0(unsigned u) { return (float)(u & 0xffu); }
__device__ __forceinline__ float ub1(unsigned u) { return (float)((u >> 8) & 0xffu); }
__device__ __forceinline__ float ub2(unsigned u) { return (float)((u >> 16) & 0xffu); }
__device__ __forceinline__ float ub3(unsigned u) { return (float)(u >> 24); }
__device__ __forceinline__ float bf_lo(unsigned u) { return __uint_as_float(u << 16); }
__device__ __forceinline__ float bf_hi(unsigned u) { return __uint_as_float(u & 0xffff0000u); }
__device__ __forceinline__ float bf1(bf16_t u) { return __uint_as_float(((unsigned)u) << 16); }
__device__ __forceinline__ float shx(float v, int mask, int lane) { return __int_as_float(__builtin_amdgcn_ds_bpermute((lane ^ mask) << 2, __float_as_int(v))); }
__device__ __forceinline__ unsigned shxu(unsigned v, int mask, int lane) { return (unsigned)__builtin_amdgcn_ds_bpermute((lane ^ mask) << 2, (int)v); }
__device__ __forceinline__ unsigned q8x4(float a, float b, float c, float d) {
    unsigned w = 0u;
    w = __builtin_amdgcn_cvt_pk_u8_f32(fminf(fmaxf(__builtin_rintf(a), -127.f), 127.f) + 128.f, 0, w); w = __builtin_amdgcn_cvt_pk_u8_f32(fminf(fmaxf(__builtin_rintf(b), -127.f), 127.f) + 128.f, 1, w);
    w = __builtin_amdgcn_cvt_pk_u8_f32(fminf(fmaxf(__builtin_rintf(c), -127.f), 127.f) + 128.f, 2, w); w = __builtin_amdgcn_cvt_pk_u8_f32(fminf(fmaxf(__builtin_rintf(d), -127.f), 127.f) + 128.f, 3, w);
    return w ^ 0x80808080u;
}
__device__ __forceinline__ float wave_max(float v, int lane) {
#pragma unroll
    for (int o = 1; o < 64; o <<= 1) v = fmaxf(v, shx(v, o, lane));
    return v;
}
__device__ __forceinline__ float wave_sum(float v, int lane) {
#pragma unroll
    for (int o = 1; o < 64; o <<= 1) v += shx(v, o, lane);
    return v;
}
__device__ __forceinline__ float fast_exp2(float x) { return __builtin_amdgcn_exp2f(x); }
__device__ __forceinline__ float fast_rcp(float x) { return __builtin_amdgcn_rcpf(x); }
__device__ __forceinline__ float sigmoid_f(float x) { return fast_rcp(1.0f + fast_exp2(-LOG2E * x)); }
__device__ __forceinline__ float gelu_tanh_f(float x) {
    const float z = 0.7978845608028654f * (x + 0.044715f * x * x * x);
    return x * fast_rcp(1.0f + fast_exp2(-2.0f * LOG2E * z));
}

namespace pg8 {
#define PG8_LAS __attribute__((address_space(3)))
constexpr int BM = 256, BK = 64, HALF = 128, HTB = HALF * BK * 2, STAGE_BYTES = 8 * HTB, NXCD = 8, WGM = 4;
__host__ __device__ __forceinline__ int lds_byte(int r, int c) { const int st = (r >> 4) * 2 + (c >> 5), rr = r & 15, cc = c & 31, ob = rr * 64 + cc * 2; return st * 1024 + (ob ^ (((ob >> 9) & 1) << 5)); }
__host__ __device__ __forceinline__ void stage_rc(int b, int& R, int& C) { const int st = b / 1024, sb = b % 1024, swz = sb ^ (((sb >> 9) & 1) << 5); R = (st >> 1) * 16 + swz / 64; C = (st & 1) * 32 + (swz % 64) / 2; }
__host__ __device__ __forceinline__ int perm32(int rho) { const int n = rho >> 4, i = rho & 15; return 8 * (i >> 2) + 4 * n + (i & 3); }
struct Unit { int pm, pn, kq; };
struct Gemm { const bf16_t* A; const bf16_t* Bt; int M, N, K; };
struct StaticOrder {
    int nM, nN, nwg, G, c;
    __host__ __device__ __forceinline__ void init(int M_, int N_, int G_, int c_) { nM = M_ / BM; nN = N_ / BM; nwg = nM * nN; G = G_; c = c_; }
    __host__ __device__ __forceinline__ bool next(int i, Unit& u) const { return map((long)i * G + c, u); }
    __host__ __device__ __forceinline__ bool map(long L, Unit& u) const {
        if (L >= nwg) return false;
        int wgid = (int)L; { const int q = nwg / NXCD, r = nwg % NXCD, xcd = wgid % NXCD, off = wgid / NXCD; wgid = (xcd < r ? xcd * (q + 1) : r * (q + 1) + (xcd - r) * q) + off; }
        const int nig = WGM * nN, gid = wgid / nig, fm = gid * WGM, gsz = (nM - fm) < WGM ? (nM - fm) : WGM;
        u.pm = fm + ((wgid % nig) % gsz); u.pn = (wgid % nig) / gsz; u.kq = 0; return true;
    }
    __device__ __forceinline__ void a_ready(const Unit&) const {}
    __device__ __forceinline__ void done(const Unit&) const {}
    __device__ __forceinline__ int nt(const Unit&, int K) const { return K / BK; }
    __device__ __forceinline__ size_t koff(const Unit&, int) const { return 0; }
};
struct OneUnit {
    int pm, pn;
    __device__ __forceinline__ bool next(int i, Unit& u) const { if (i != 0) return false; u.pm = pm; u.pn = pn; u.kq = 0; return true; }
    __device__ __forceinline__ void a_ready(const Unit&) const {}
    __device__ __forceinline__ void done(const Unit&) const {}
    __device__ __forceinline__ int nt(const Unit&, int K) const { return K / BK; }
    __device__ __forceinline__ size_t koff(const Unit&, int) const { return 0; }
};
struct ProjOrder {
    StaticOrder so;
    __device__ __forceinline__ void init(int M_, int N_, int G_, int c_) { so.init(M_, N_, G_, c_); }
    __device__ __forceinline__ bool next(int i, Unit& u) const { if (!so.next(i, u)) return false; u.pn = nth_set(~I8MASK & 0x1ffffffu, u.pn); return true; }
    __device__ __forceinline__ void a_ready(const Unit&) const {}
    __device__ __forceinline__ void done(const Unit&) const {}
    __device__ __forceinline__ int nt(const Unit&, int K) const { return K / BK; }
    __device__ __forceinline__ size_t koff(const Unit&, int) const { return 0; }
};
struct Gate8Order {
    StaticOrder so; int c;
    __device__ __forceinline__ void init(int M_, int N_, int G_, int c_) { so.init(M_, N_, G_, c_); c = c_; }
    __device__ __forceinline__ bool next(int i, Unit& u) const {
        if (so.G != 256) return so.next(i, u);
        long L;
        if (i < I8_X) L = (long)i * 256 + c;
        else if (PB_EXTRA && i < I8_X + 2) { if (c < PB_EXTRA) return false; L = I8_X * 256 + (long)(i - I8_X) * (256 - PB_EXTRA) + (c - PB_EXTRA); }
        else return false;
        return so.map(L, u);
    }
    __device__ __forceinline__ void a_ready(const Unit&) const {}
    __device__ __forceinline__ void done(const Unit&) const {}
    __device__ __forceinline__ int nt(const Unit&, int K) const { return K / BK; }
    __device__ __forceinline__ size_t koff(const Unit&, int) const { return 0; }
};
struct UpOrder {
    StaticOrder so; int G, c;
    __device__ __forceinline__ void init(int M_, int G_, int c_) { so.init(M_, 40 * BM, G_, c_); G = G_; c = c_; }
    __device__ __forceinline__ bool next(int i, Unit& u) const {
        if (so.next(i, u)) return true;
        const long L = (long)i * G + c - so.nwg; if (L < 0 || L >= 256) return false;
        const int tt = (int)L >> 1; u.pm = tt & 31; u.pn = 40 + (tt >> 5); u.kq = 1 + ((int)L & 1); return true;
    }
    __device__ __forceinline__ void a_ready(const Unit&) const {}
    __device__ __forceinline__ void done(const Unit&) const {}
    __device__ __forceinline__ int nt(const Unit& u, int K) const { return u.kq ? K / (2 * BK) : K / BK; }
    __device__ __forceinline__ size_t koff(const Unit& u, int K) const { return u.kq == 2 ? (size_t)K : 0; }
};
typedef f32x4 Acc[2][2][4][2];

template <int MODE> __device__ __forceinline__ void store_tile_bf16(const Acc& acc, bf16_t* O, int ldc, int row0, int col0) {
#pragma unroll
    for (int ai = 0; ai < 2; ++ai)
#pragma unroll
        for (int m = 0; m < 4; ++m) { bf16_t* rowp = O + (size_t)(row0 + ai * HALF + m * 16) * ldc + col0;
#pragma unroll
            for (int bj = 0; bj < 2; ++bj) { f32x4 v0 = acc[ai][bj][m][0], v1 = acc[ai][bj][m][1];
                if (MODE == 1) { v0 = v0 * C2; v1 = v1 * C2; }
                if (MODE == 2) {
#pragma unroll
                    for (int e = 0; e < 4; ++e) { v0[e] = gelu_tanh_f(v0[e]); v1[e] = gelu_tanh_f(v1[e]); } }
                if (MODE == 3) {
#pragma unroll
                    for (int e = 0; e < 4; ++e) { v0[e] = sigmoid_f(v0[e]); v1[e] = sigmoid_f(v1[e]); } }
                u32x4 w; w.x = cvt_pk_bf16(v0[0], v0[1]); w.y = cvt_pk_bf16(v0[2], v0[3]); w.z = cvt_pk_bf16(v1[0], v1[1]); w.w = cvt_pk_bf16(v1[2], v1[3]);
                *(u32x4*)(rowp + bj * HALF) = w; } }
}
struct NoHook { static constexpr bool ON = false; __device__ __forceinline__ void operator()(Acc&, const Unit&, int, int, int, int, int) const {} };
struct EpiPlain {
    static constexpr bool PERM = true, AFTER_DRAIN = false;
    bf16_t* O; int ldc;
    __device__ __forceinline__ void operator()(Acc& acc, const Unit& u, int wr, int wc, int fr, int fq) const {
        store_tile_bf16<0>(acc, O, ldc, u.pm * BM + wr * 64 + fr, u.pn * BM + wc * 32 + 8 * fq); }
};
struct EpiProj {
    static constexpr bool PERM = true, AFTER_DRAIN = false;
    bf16_t* O; int ldc; unsigned char* G; const float* RS;
    __device__ __forceinline__ void operator()(Acc& acc, const Unit& u, int wr, int wc, int fr, int fq) const {
        const int pn = u.pn, row0 = u.pm * BM + wr * 64 + fr, col0 = pn * BM + wc * 32 + 8 * fq;
#pragma unroll
        for (int ai = 0; ai < 2; ++ai)
#pragma unroll
            for (int m = 0; m < 4; ++m) { const float sc = RS[row0 + ai * HALF + m * 16];
#pragma unroll
                for (int bj = 0; bj < 2; ++bj) { acc[ai][bj][m][0] = acc[ai][bj][m][0] * sc; acc[ai][bj][m][1] = acc[ai][bj][m][1] * sc; } }
        if (pn < 2 || (pn >= 16 && pn < 19)) store_tile_bf16<1>(acc, O, ldc, row0, col0);
        else if (pn >= 12 && pn < 16) store_tile_bf16<2>(acc, O, ldc, row0, col0);
        else if (pn >= 25) {
            const int gc0 = col0 - PC_G;
#pragma unroll
            for (int ai = 0; ai < 2; ++ai)
#pragma unroll
                for (int m = 0; m < 4; ++m) { unsigned char* rowp = G + (size_t)(row0 + ai * HALF + m * 16) * 8192 + gc0;
#pragma unroll
                    for (int bj = 0; bj < 2; ++bj) { u32x2 w = {0u, 0u};
#pragma unroll
                        for (int e = 0; e < 4; ++e) { w.x = __builtin_amdgcn_cvt_pk_u8_f32(fmaxf(255.0f * sigmoid_f(acc[ai][bj][m][0][e]) + 0.5f, 1.0f), e, w.x);
                                                      w.y = __builtin_amdgcn_cvt_pk_u8_f32(fmaxf(255.0f * sigmoid_f(acc[ai][bj][m][1][e]) + 0.5f, 1.0f), e, w.y); }
                        *(u32x2*)(rowp + bj * HALF) = w; } }
        }
        else store_tile_bf16<0>(acc, O, ldc, row0, col0);
    }
};
__device__ __forceinline__ void row_scales(float (&rs)[2][4], const float* PART, int row0, int fr, int fq) {
    const int ln = fq * 16 + fr;
#pragma unroll
    for (int ai = 0; ai < 2; ++ai)
#pragma unroll
        for (int m = 0; m < 4; ++m) { const float* p = PART + (size_t)(row0 + ai * HALF + m * 16) * 32 + 8 * fq; const f32x4 a = *(const f32x4*)p, b = *(const f32x4*)(p + 4);
            float s = ((a.x + a.y) + (a.z + a.w)) + ((b.x + b.y) + (b.z + b.w)); s += shx(s, 16, ln); s += shx(s, 32, ln);
            rs[ai][m] = 1.0f / sqrtf(s * (1.0f / DM) + EPS); }
}
struct EpiUp8 {
    static constexpr bool PERM = true, AFTER_DRAIN = false;
    bf16_t* O; int ldc; const float* AS; const float* WS1; bf16_t* O2; int ldc2, c2;
    __device__ __forceinline__ void operator()(Acc& acc, const Unit& u, int wr, int wc, int fr, int fq) const {
        const int row0 = u.pm * BM + wr * 64 + fr; const float wqs = *WS1;
#pragma unroll
        for (int ai = 0; ai < 2; ++ai)
#pragma unroll
            for (int m = 0; m < 4; ++m) { const float sc = AS[row0 + ai * HALF + m * 16] * wqs;
#pragma unroll
                for (int bj = 0; bj < 2; ++bj)
#pragma unroll
                    for (int n = 0; n < 2; ++n) { const v4i a = __builtin_bit_cast(v4i, acc[ai][bj][m][n]); acc[ai][bj][m][n] = (f32x4){(float)a[0], (float)a[1], (float)a[2], (float)a[3]} * sc; } }
        if (u.kq == 2) store_tile_bf16<0>(acc, O2, ldc2, row0, u.pn * BM - c2 + wc * 32 + 8 * fq);
        else store_tile_bf16<0>(acc, O, ldc, row0, u.pn * BM + wc * 32 + 8 * fq); }
};
struct EpiGate8 {
    static constexpr bool PERM = true, AFTER_DRAIN = false;
    unsigned char* G; const float* AS; const float* WS1; bf16_t* O; int ldc;
    __device__ __forceinline__ void operator()(Acc& acc, const Unit& u, int wr, int wc, int fr, int fq) const {
        const int row0 = u.pm * BM + wr * 64 + fr; const float wqs = *WS1;
        if (u.pn < N8T) {
#pragma unroll
            for (int ai = 0; ai < 2; ++ai)
#pragma unroll
                for (int m = 0; m < 4; ++m) { const float sc = AS[row0 + ai * HALF + m * 16] * wqs;
#pragma unroll
                    for (int bj = 0; bj < 2; ++bj)
#pragma unroll
                        for (int n = 0; n < 2; ++n) { const v4i a = __builtin_bit_cast(v4i, acc[ai][bj][m][n]); acc[ai][bj][m][n] = (f32x4){(float)a[0], (float)a[1], (float)a[2], (float)a[3]} * sc; } }
            const int pt = nth_set(I8MASK, u.pn), col0 = pt * BM + wc * 32 + 8 * fq;
            if (pt < 2 || (pt >= 16 && pt < 19)) store_tile_bf16<1>(acc, O, ldc, row0, col0);
            else if (pt >= 12 && pt < 16) store_tile_bf16<2>(acc, O, ldc, row0, col0);
            else store_tile_bf16<0>(acc, O, ldc, row0, col0);
            return;
        }
        const int gc0 = (u.pn - N8T) * BM + wc * 32 + 8 * fq;
        float as8[2][4];
#pragma unroll
        for (int ai = 0; ai < 2; ++ai)
#pragma unroll
            for (int m = 0; m < 4; ++m) as8[ai][m] = AS[row0 + ai * HALF + m * 16];
#pragma unroll
        for (int ai = 0; ai < 2; ++ai)
#pragma unroll
            for (int m = 0; m < 4; ++m) { unsigned char* rowp = G + (size_t)(row0 + ai * HALF + m * 16) * 8192 + gc0; const float sc = -LOG2E * as8[ai][m] * wqs;
#pragma unroll
                for (int bj = 0; bj < 2; ++bj) { u32x2 w = {0u, 0u}; const v4i a0 = __builtin_bit_cast(v4i, acc[ai][bj][m][0]), a1 = __builtin_bit_cast(v4i, acc[ai][bj][m][1]);
#pragma unroll
                    for (int e = 0; e < 4; ++e) { w.x = __builtin_amdgcn_cvt_pk_u8_f32(fmaxf(__builtin_fmaf(255.0f, fast_rcp(1.0f + fast_exp2(sc * (float)a0[e])), 0.5f), 1.0f), e, w.x);
                                                  w.y = __builtin_amdgcn_cvt_pk_u8_f32(fmaxf(__builtin_fmaf(255.0f, fast_rcp(1.0f + fast_exp2(sc * (float)a1[e])), 0.5f), 1.0f), e, w.y); }
                    *(u32x2*)(rowp + bj * HALF) = w; } }
    }
};
struct EpiResidN {
    static constexpr bool PERM = true, AFTER_DRAIN = false;
    bf16_t* XR; float* SS;
    __device__ __forceinline__ void operator()(Acc& acc, const Unit& u, int wr, int wc, int fr, int fq) const {
        const int row0 = u.pm * BM + wr * 64 + fr, col0 = u.pn * BM + wc * 32 + 8 * fq;
        u32x4 b[2][4][2];
#pragma unroll
        for (int ai = 0; ai < 2; ++ai)
#pragma unroll
            for (int m = 0; m < 4; ++m)
#pragma unroll
                for (int bj = 0; bj < 2; ++bj) b[ai][m][bj] = *(const u32x4*)(XR + (size_t)(row0 + ai * HALF + m * 16) * DM + col0 + bj * HALF);
#pragma unroll
        for (int ai = 0; ai < 2; ++ai) {
#pragma unroll
            for (int m = 0; m < 4; ++m) { const int row = row0 + ai * HALF + m * 16; float ss = 0.f;
#pragma unroll
                for (int bj = 0; bj < 2; ++bj) { const u32x4 x = b[ai][m][bj];
                    const f32x4 v0 = (f32x4){bf_lo(x.x), bf_hi(x.x), bf_lo(x.y), bf_hi(x.y)} + acc[ai][bj][m][0], v1 = (f32x4){bf_lo(x.z), bf_hi(x.z), bf_lo(x.w), bf_hi(x.w)} + acc[ai][bj][m][1];
                    u32x4 w; w.x = cvt_pk_bf16(v0[0], v0[1]); w.y = cvt_pk_bf16(v0[2], v0[3]); w.z = cvt_pk_bf16(v1[0], v1[1]); w.w = cvt_pk_bf16(v1[2], v1[3]);
                    *(u32x4*)(XR + (size_t)row * DM + col0 + bj * HALF) = w;
                    ss += (v0[0] * v0[0] + v0[1] * v0[1]) + (v0[2] * v0[2] + v0[3] * v0[3]) + (v1[0] * v1[0] + v1[1] * v1[1]) + (v1[2] * v1[2] + v1[3] * v1[3]); }
                if (SS) { const int ln = fq * 16 + fr; ss += shx(ss, 16, ln); ss += shx(ss, 32, ln);
                    if (fq == 0) SS[(size_t)row * 32 + 4 * u.pn + wc] = ss; } }
            asm volatile("" ::: "memory"); }
    }
};
struct EpiPle {
    static constexpr bool PERM = true, AFTER_DRAIN = false;
    const bf16_t* XR; bf16_t* XO; const bf16_t* PP; const float* SS;
    __device__ __forceinline__ void operator()(Acc& acc, const Unit& u, int wr, int wc, int fr, int fq) const {
        const int row0 = u.pm * BM + wr * 64 + fr, col0 = u.pn * BM + wc * 32 + 8 * fq; float rs[2][4]; row_scales(rs, SS, row0, fr, fq);
#pragma unroll
        for (int ai = 0; ai < 2; ++ai)
#pragma unroll
            for (int mp = 0; mp < 1; ++mp) { u32x4 b[4][2], pp[4][2];
#pragma unroll
                for (int mm = 0; mm < 4; ++mm)
#pragma unroll
                    for (int bj = 0; bj < 2; ++bj) { const size_t off = (size_t)(row0 + ai * HALF + (2 * mp + mm) * 16) * DM + col0 + bj * HALF; b[mm][bj] = *(const u32x4*)(XR + off); pp[mm][bj] = *(const u32x4*)(PP + off); }
#pragma unroll
                for (int mm = 0; mm < 4; ++mm) { const float r = rs[ai][2 * mp + mm];
#pragma unroll
                    for (int bj = 0; bj < 2; ++bj) { const size_t off = (size_t)(row0 + ai * HALF + (2 * mp + mm) * 16) * DM + col0 + bj * HALF; const u32x4 x = b[mm][bj], p = pp[mm][bj];
                        const f32x4 a0 = acc[ai][bj][2 * mp + mm][0] * r, a1 = acc[ai][bj][2 * mp + mm][1] * r; u32x4 w;
                        w.x = cvt_pk_bf16(bf_lo(x.x) + sigmoid_f(a0[0]) * bf_lo(p.x), bf_hi(x.x) + sigmoid_f(a0[1]) * bf_hi(p.x)); w.y = cvt_pk_bf16(bf_lo(x.y) + sigmoid_f(a0[2]) * bf_lo(p.y), bf_hi(x.y) + sigmoid_f(a0[3]) * bf_hi(p.y));
                        w.z = cvt_pk_bf16(bf_lo(x.z) + sigmoid_f(a1[0]) * bf_lo(p.z), bf_hi(x.z) + sigmoid_f(a1[1]) * bf_hi(p.z)); w.w = cvt_pk_bf16(bf_lo(x.w) + sigmoid_f(a1[2]) * bf_lo(p.w), bf_hi(x.w) + sigmoid_f(a1[3]) * bf_hi(p.w));
                        *(u32x4*)(XO + off) = w; } }
                asm volatile("" ::: "memory"); }
    }
};
struct MergeHook {
    static constexpr bool ON = true;
    const unsigned char* G;
    __device__ __forceinline__ void operator()(Acc& acc, const Unit& u, int t, int wr, int wc, int fr, int fq) const {
        const int j = (t >> 3) - 1;
        unsigned off0 = (unsigned)((u.pm * BM + wr * 64 + fr) * 8192 + u.pn * BM + wc * 32 + 8 * fq);
        asm volatile("" : "+v"(off0));
        const unsigned char* gj = G + j * 2048;
#pragma unroll
        for (int ai = 0; ai < 2; ++ai) {
#pragma unroll
            for (int m = 0; m < 4; ++m) { const unsigned char* gp = gj + (off0 + (unsigned)((ai * HALF + m * 16) * 8192));
#pragma unroll
                for (int bj = 0; bj < 2; ++bj) { const u32x2 a = *(const u32x2*)(gp + bj * HALF), b = *(const u32x2*)(gp + 2048 + bj * HALF);
                    f32x4 r0, r1;
                    r0[0] = ub0(a.x) * fast_rcp(ub0(b.x)); r0[1] = ub1(a.x) * fast_rcp(ub1(b.x));
                    r0[2] = ub2(a.x) * fast_rcp(ub2(b.x)); r0[3] = ub3(a.x) * fast_rcp(ub3(b.x));
                    r1[0] = ub0(a.y) * fast_rcp(ub0(b.y)); r1[1] = ub1(a.y) * fast_rcp(ub1(b.y));
                    r1[2] = ub2(a.y) * fast_rcp(ub2(b.y)); r1[3] = ub3(a.y) * fast_rcp(ub3(b.y));
                    acc[ai][bj][m][0] = acc[ai][bj][m][0] * r0; acc[ai][bj][m][1] = acc[ai][bj][m][1] * r1; } }
            }
    }
};
struct EpiMerge {
    static constexpr bool PERM = true, AFTER_DRAIN = false;
    bf16_t* O; int ldc; const unsigned char* G3;
    __device__ __forceinline__ void operator()(Acc& acc, const Unit& u, int wr, int wc, int fr, int fq) const {
        const int row0 = u.pm * BM + wr * 64 + fr, col0 = u.pn * BM + wc * 32 + 8 * fq; const float s = 1.0f / 255.0f;
        u32x2 g[2][4][2];
#pragma unroll
        for (int ai = 0; ai < 2; ++ai)
#pragma unroll
            for (int m = 0; m < 4; ++m)
#pragma unroll
                for (int bj = 0; bj < 2; ++bj) g[ai][m][bj] = *(const u32x2*)(G3 + (size_t)(row0 + ai * HALF + m * 16) * 8192 + col0 + bj * HALF);
#pragma unroll
        for (int ai = 0; ai < 2; ++ai) {
#pragma unroll
            for (int m = 0; m < 4; ++m)
#pragma unroll
                for (int bj = 0; bj < 2; ++bj) { const u32x2 gg = g[ai][m][bj]; const f32x4 v0 = acc[ai][bj][m][0] * s, v1 = acc[ai][bj][m][1] * s;
                    u32x4 w; w.x = cvt_pk_bf16(v0[0] * ub0(gg.x), v0[1] * ub1(gg.x)); w.y = cvt_pk_bf16(v0[2] * ub2(gg.x), v0[3] * ub3(gg.x));
                    w.z = cvt_pk_bf16(v1[0] * ub0(gg.y), v1[1] * ub1(gg.y)); w.w = cvt_pk_bf16(v1[2] * ub2(gg.y), v1[3] * ub3(gg.y));
                    *(u32x4*)(O + (size_t)(row0 + ai * HALF + m * 16) * ldc + col0 + bj * HALF) = w; }
            asm volatile("" ::: "memory"); }
    }
};

template <class Epi, class Hook, class Sched, bool I8 = false>
__device__ __forceinline__ void gemm_phase(PG8_LAS unsigned char* lds, const Gemm g, const Sched& S, const Epi& E, const Hook& H, int tid) {
    asm volatile("" : "+v"(tid));
    const int wid = __builtin_amdgcn_readfirstlane(tid >> 6), lane = tid & 63, wr = wid >> 2, wc = wid & 3, fr = lane & 15, fq = lane >> 4;
    const int K = g.K;
    unsigned voffA[2], voffB[2];
#pragma unroll
    for (int i = 0; i < 2; ++i) { int R, C; stage_rc(tid * 16 + i * 8192, R, C); const int Rb = Epi::PERM ? ((R & ~31) + perm32(R & 31)) : R;
        voffA[i] = (unsigned)(R * K + C) * 2u; voffB[i] = (unsigned)(Rb * K + C) * 2u; }
    const size_t kstep = (size_t)(BK * 2);
    const size_t hstep = (size_t)HALF * K * 2;
    const size_t tstep = 2 * hstep;
    const unsigned ldsw = (unsigned)wid * 1024u;
    const int aoff = lds_byte(wr * 64 + fr, fq * 8), boff = lds_byte(wc * 32 + fr, fq * 8);
#define PG8_SA(b, h) (((b) * 2 + (h)) * HTB)
#define PG8_SB(b, h) ((4 + (b) * 2 + (h)) * HTB)
#define PG8_STAGE(bufoff, gbase, voff) do { _Pragma("unroll") for (int _i = 0; _i < 2; ++_i) \
        __builtin_amdgcn_global_load_lds((const unsigned*)((const char*)(gbase) + (voff)[_i]), (PG8_LAS unsigned*)(lds + (bufoff) + ldsw + _i * 8192), 16, 0, 0); } while (0)
#define PG8_LDA(dst, b, h) do { _Pragma("unroll") for (int m = 0; m < 4; ++m) _Pragma("unroll") for (int k = 0; k < 2; ++k) dst[m][k] = *(const PG8_LAS bf16x8*)(lds + PG8_SA(b, h) + aoff + m * 2048 + k * 1024); } while (0)
#define PG8_LDB(dst, b, h) do { _Pragma("unroll") for (int n = 0; n < 2; ++n) _Pragma("unroll") for (int k = 0; k < 2; ++k) dst[n][k] = *(const PG8_LAS bf16x8*)(lds + PG8_SB(b, h) + boff + n * 2048 + k * 1024); } while (0)
#define PG8_MMA(ai, bj, At, Bt) do { __builtin_amdgcn_s_setprio(1); _Pragma("unroll") for (int m = 0; m < 4; ++m) _Pragma("unroll") for (int n = 0; n < 2; ++n) _Pragma("unroll") for (int k = 0; k < 2; ++k) { \
        if constexpr (I8) acc[ai][bj][m][n] = __builtin_bit_cast(f32x4, __builtin_amdgcn_mfma_i32_16x16x64_i8(__builtin_bit_cast(v4i, Bt[n][k]), __builtin_bit_cast(v4i, At[m][k]), __builtin_bit_cast(v4i, acc[ai][bj][m][n]), 0, 0, 0)); \
        else acc[ai][bj][m][n] = __builtin_amdgcn_mfma_f32_16x16x32_bf16(Bt[n][k], At[m][k], acc[ai][bj][m][n], 0, 0, 0); } \
        __builtin_amdgcn_s_setprio(0); } while (0)
#define PG8_WAIT_V(n) asm volatile("s_waitcnt vmcnt(" #n ")" ::: "memory")
#define PG8_WAIT_L(n) asm volatile("s_waitcnt lgkmcnt(" #n ")" ::: "memory")
#define PG8_BAR __builtin_amdgcn_s_barrier()
#define PG8_SCHED __builtin_amdgcn_sched_barrier(0)
    Unit cur, nxt; int ui = 0;
    if (!S.next(0, cur)) return;
    Acc acc;
#pragma unroll
    for (int a = 0; a < 2; ++a)
#pragma unroll
        for (int b = 0; b < 2; ++b)
#pragma unroll
            for (int m = 0; m < 4; ++m)
#pragma unroll
                for (int n = 0; n < 2; ++n) acc[a][b][m][n] = (f32x4){0.f, 0.f, 0.f, 0.f};
    bf16x8 At[4][2], B0[2][2], B1[2][2];
    int nt = S.nt(cur, K);
    const char* cA = (const char*)g.A + (size_t)cur.pm * tstep + S.koff(cur, K); const char* cB = (const char*)g.Bt + (size_t)cur.pn * tstep + S.koff(cur, K);
    S.a_ready(cur);
    PG8_STAGE(PG8_SB(0, 0), cB, voffB); PG8_STAGE(PG8_SB(0, 1), cB + hstep, voffB); PG8_STAGE(PG8_SA(0, 0), cA, voffA); PG8_STAGE(PG8_SA(0, 1), cA + hstep, voffA);
    if (wr == 1) PG8_BAR;
    PG8_WAIT_V(2); PG8_BAR;
    PG8_STAGE(PG8_SB(1, 0), cB + kstep, voffB); PG8_STAGE(PG8_SA(1, 0), cA + kstep, voffA); PG8_STAGE(PG8_SB(1, 1), cB + hstep + kstep, voffB);
    PG8_WAIT_V(6); PG8_BAR;
    for (;;) {
        const bool has_next = S.next(ui + 1, nxt);
        const char* nA = has_next ? (const char*)g.A + (size_t)nxt.pm * tstep + S.koff(nxt, K) : cA; const char* nB = has_next ? (const char*)g.Bt + (size_t)nxt.pn * tstep + S.koff(nxt, K) : cB;
        for (int t = 0; t < nt; t += 2) {
            if constexpr (Hook::ON) { if (t != 0 && (t & 7) == 0) H(acc, cur, t, wr, wc, fr, fq); }
            const bool last = (t == nt - 2);
            const char* a1 = cA + (size_t)(t + 1) * kstep;
            const char* a2 = last ? nA : cA + (size_t)(t + 2) * kstep; const char* b2 = last ? nB : cB + (size_t)(t + 2) * kstep;
            const char* a3 = a2 + kstep; const char* b3 = b2 + kstep;
            if (last && has_next) S.a_ready(nxt);
            PG8_LDB(B0, 0, 0); PG8_LDB(B1, 0, 1); PG8_SCHED; PG8_LDA(At, 0, 0); PG8_STAGE(PG8_SA(1, 1), a1 + hstep, voffA);
            PG8_WAIT_V(8); PG8_WAIT_L(0); PG8_BAR; PG8_MMA(0, 0, At, B0); PG8_MMA(0, 1, At, B1); PG8_BAR; PG8_SCHED;
            PG8_LDA(At, 0, 1); PG8_STAGE(PG8_SB(0, 0), b2, voffB); PG8_STAGE(PG8_SB(0, 1), b2 + hstep, voffB); PG8_STAGE(PG8_SA(0, 0), a2, voffA);
            PG8_WAIT_V(8); PG8_WAIT_L(0); PG8_BAR; PG8_MMA(1, 0, At, B0); PG8_MMA(1, 1, At, B1); PG8_BAR; PG8_SCHED;
            PG8_LDB(B0, 1, 0); PG8_LDB(B1, 1, 1); PG8_SCHED; PG8_LDA(At, 1, 0); PG8_STAGE(PG8_SA(0, 1), a2 + hstep, voffA);
            PG8_WAIT_V(8); PG8_WAIT_L(0); PG8_BAR; PG8_MMA(0, 0, At, B0); PG8_MMA(0, 1, At, B1); PG8_BAR; PG8_SCHED;
            PG8_LDA(At, 1, 1); PG8_STAGE(PG8_SB(1, 0), b3, voffB); PG8_STAGE(PG8_SB(1, 1), b3 + hstep, voffB); PG8_STAGE(PG8_SA(1, 0), a3, voffA);
            PG8_WAIT_V(8); PG8_WAIT_L(0); PG8_BAR; PG8_MMA(1, 0, At, B0); PG8_MMA(1, 1, At, B1); PG8_BAR; PG8_SCHED;
        }
        if (wr == 0) PG8_BAR;
        E(acc, cur, wr, wc, fr, fq); S.done(cur);
        if (!has_next) break;
#pragma unroll
        for (int a = 0; a < 2; ++a)
#pragma unroll
            for (int b = 0; b < 2; ++b)
#pragma unroll
                for (int m = 0; m < 4; ++m)
#pragma unroll
                    for (int n = 0; n < 2; ++n) acc[a][b][m][n] = (f32x4){0.f, 0.f, 0.f, 0.f};
        cur = nxt; cA = nA; cB = nB; ++ui; nt = S.nt(cur, K);
        if (wr == 1) PG8_BAR;
    }
    PG8_WAIT_V(0);
    PG8_BAR;
#undef PG8_SA
#undef PG8_SB
#undef PG8_STAGE
#undef PG8_LDA
#undef PG8_LDB
#undef PG8_MMA
#undef PG8_WAIT_V
#undef PG8_WAIT_L
#undef PG8_BAR
#undef PG8_SCHED
}
}

#define XB_TMO      128
#define XB_XCNT(j)  (256  + 64 * (j))
#define XB_XSUB(j)  (1280 + 64 * (j))
#define XB_XGEN(j)  (2304 + 64 * (j))
#define XB_TOP      3328
#define XB_TOPGEN   3392
#define XCD_BAR_WORDS 3456
#define XB_SPIN_CAP (1u << 18)
__device__ __forceinline__ unsigned xb_ld(unsigned* p)              { return __hip_atomic_load(p, __ATOMIC_RELAXED, __HIP_MEMORY_SCOPE_AGENT); }
__device__ __forceinline__ unsigned xb_add(unsigned* p, unsigned v) { return __hip_atomic_fetch_add(p, v, __ATOMIC_RELAXED, __HIP_MEMORY_SCOPE_AGENT); }
__device__ __forceinline__ unsigned xb_xcc_id() { return (unsigned)__builtin_amdgcn_s_getreg((3 << 11) | 20) & 0xFu; }
#define XB_SPIN(cond, bar) do { unsigned _sp = 0; while (cond) { __builtin_amdgcn_s_sleep(1); \
    if ((++_sp & 255u) == 0u) { if (xb_ld(&(bar)[XB_TMO])) break; if (_sp > XB_SPIN_CAP) { atomicAdd(&(bar)[XB_TMO], 1u); break; } } } } while (0)
struct XcdBarrier { unsigned* bar; unsigned x; volatile LAS unsigned* st; };
__device__ __forceinline__ XcdBarrier xcd_barrier_post(unsigned* bar, volatile LAS unsigned* st) {
    XcdBarrier b; b.bar = bar; b.x = xb_xcc_id(); b.st = st;
    if (threadIdx.x == 0) (void)xb_add(&bar[XB_XCNT(b.x)], 1u);
    return b;
}
__device__ __forceinline__ void xcd_barrier_complete(unsigned* bar, unsigned x, unsigned& nloc, unsigned& nx) {
    const unsigned G = gridDim.x * gridDim.y * gridDim.z;
    unsigned sum, cnt, mine, sp = 0u;
    for (;;) {
        sum = 0u; cnt = 0u; mine = 0u;
#pragma unroll
        for (unsigned j = 0; j < 16; ++j) { const unsigned c = xb_ld(&bar[XB_XCNT(j)]); sum += c; cnt += (c > 0u) ? 1u : 0u; mine = (j == x) ? c : mine; }
        if (sum == G) break;
        __builtin_amdgcn_s_sleep(1);
        if ((++sp & 255u) == 0u) { if (xb_ld(&bar[XB_TMO])) break; if (sp > XB_SPIN_CAP) { atomicAdd(&bar[XB_TMO], 1u); break; } }
    }
    nloc = mine > 0u ? mine : 1u; nx = cnt > 0u ? cnt : 1u;
}
__device__ __forceinline__ void xcd_barrier(const XcdBarrier& b) {
    asm volatile("s_waitcnt vmcnt(0)" ::: "memory");
    __syncthreads();
    if (threadIdx.x == 0) {
        unsigned* bar = b.bar;
        __builtin_amdgcn_s_waitcnt(0);
        unsigned nloc = b.st[0], nx = b.st[1];
        if (nloc == 0u) { xcd_barrier_complete(bar, b.x, nloc, nx); b.st[0] = nloc; b.st[1] = nx; }
        const unsigned old = xb_add(&bar[XB_XSUB(b.x)], 1u);
        const unsigned gen = old / nloc;
        if (old + 1u == (gen + 1u) * nloc) {
            __builtin_amdgcn_fence(__ATOMIC_RELEASE, "agent");
            asm volatile("s_waitcnt vmcnt(0)" ::: "memory");
            const unsigned og = xb_add(&bar[XB_TOP], 1u);
            const unsigned tg = og / nx;
            if (og + 1u == (tg + 1u) * nx) xb_add(&bar[XB_TOPGEN], 1u);
            else XB_SPIN(xb_ld(&bar[XB_TOPGEN]) == tg, bar);
            __builtin_amdgcn_fence(__ATOMIC_ACQUIRE, "agent");
            xb_add(&bar[XB_XGEN(b.x)], 1u);
            asm volatile("s_waitcnt vmcnt(0)" ::: "memory");
        } else {
            XB_SPIN(xb_ld(&bar[XB_XGEN(b.x)]) == gen, bar);
            __builtin_amdgcn_fence(__ATOMIC_ACQUIRE, "agent");
            asm volatile("s_waitcnt vmcnt(0)" ::: "memory");
        }
    }
    __syncthreads();
}

__device__ const float c_one[1] = {1.0f};
struct TrDesc { const float* W; const float* gk; bf16_t* WT; int ldw, scol0, ldt, drow0, dk0, kb, nb, f8; float qinv; };
__device__ __forceinline__ void tr_load(f32x4 (&v)[8], float (&g)[8], const TrDesc& d, int lane) {
    const float* p = d.W + (size_t)(64 * d.kb + (lane >> 3)) * d.ldw + d.scol0 + 32 * d.nb + 4 * (lane & 7);
    const GAS float* gp = d.gk ? (const GAS float*)d.gk + 64 * d.kb + (lane >> 3) : (const GAS float*)c_one; const int gs = d.gk ? 8 : 0;
#pragma unroll
    for (int i = 0; i < 8; ++i) v[i] = __builtin_nontemporal_load((const f32x4*)(p + (size_t)(8 * i) * d.ldw));
#pragma unroll
    for (int i = 0; i < 8; ++i) g[i] = gp[i * gs];
}
__device__ __forceinline__ void tr_store(const f32x4 (&v)[8], const float (&g)[8], const TrDesc& d, LAS float* scr, int lane) {
    const int kr = lane >> 3, q = lane & 7;
#pragma unroll
    for (int i = 0; i < 8; ++i) { LAS float* s = scr + (8 * i + kr) * 33 + 4 * q; s[0] = v[i].x * g[i]; s[1] = v[i].y * g[i]; s[2] = v[i].z * g[i]; s[3] = v[i].w * g[i]; }
    LDS_WAIT(); asm volatile("" ::: "memory");
    const int c = lane & 7;
#pragma unroll
    for (int j = 0; j < 4; ++j) { const int n = (lane >> 3) + 8 * j; const LAS float* s = scr + (8 * c) * 33 + n;
        u32x4 o; o.x = cvt_pk_bf16(s[0 * 33], s[1 * 33]); o.y = cvt_pk_bf16(s[2 * 33], s[3 * 33]); o.z = cvt_pk_bf16(s[4 * 33], s[5 * 33]); o.w = cvt_pk_bf16(s[6 * 33], s[7 * 33]);
        if (d.f8) { const float qv = d.qinv; u32x2 o8; o8.x = q8x4(qv * s[0 * 33], qv * s[1 * 33], qv * s[2 * 33], qv * s[3 * 33]); o8.y = q8x4(qv * s[4 * 33], qv * s[5 * 33], qv * s[6 * 33], qv * s[7 * 33]);
            __builtin_nontemporal_store(o8, (u32x2*)((unsigned char*)d.WT + (size_t)(d.drow0 + 32 * d.nb + n) * d.ldt + d.dk0 + 64 * d.kb + 8 * c)); }
        else __builtin_nontemporal_store(o, (u32x4*)(d.WT + (size_t)(d.drow0 + 32 * d.nb + n) * d.ldt + d.dk0 + 64 * d.kb + 8 * c)); }
    LDS_WAIT(); asm volatile("" ::: "memory");
}

struct Args { const float* in[23]; float* out; unsigned char* ws; int ph_lo, ph_hi, li, pad; };

template <bool FORGET, bool FINAL, bool INBF>
__device__ __forceinline__ void norm_phase(const float* X, const bf16_t* Xb, bf16_t* XN, float* RS, unsigned* XN8, float* AS8, const float* gq, const float* wfg, const float* fb, float* logf, const float* gfin, float* outf,
                                           LAS unsigned char* lds, int gw, int NGW, int lane, int tid) {
    if (FORGET) {
        LAS f32x4* w4 = (LAS f32x4*)lds;
        for (int i = tid; i < 8 * 2048 / 4; i += 512) w4[i] = ((const f32x4*)wfg)[i];
        __syncthreads();
    }
    for (int m0 = gw * 4; m0 < M; m0 += NGW * 4) {
        f32x4 v[4][8]; float rr[4];
#pragma unroll
        for (int r = 0; r < 4; ++r) {
            if (INBF) { const GAS u32x4* xr = (const GAS u32x4*)(Xb + (size_t)(m0 + r) * DM) + lane;
#pragma unroll
                for (int jj = 0; jj < 4; ++jj) { const u32x4 w = xr[64 * jj]; v[r][2 * jj] = (f32x4){bf_lo(w.x), bf_hi(w.x), bf_lo(w.y), bf_hi(w.y)}; v[r][2 * jj + 1] = (f32x4){bf_lo(w.z), bf_hi(w.z), bf_lo(w.w), bf_hi(w.w)}; }
            } else { const GAS f32x4* xr = (const GAS f32x4*)(X + (size_t)(m0 + r) * DM) + lane;
#pragma unroll
                for (int j = 0; j < 8; ++j) v[r][j] = xr[64 * j]; } }
#define NQ(j) (INBF ? (128 * ((j) >> 1) + 2 * lane + ((j) & 1)) : (64 * (j) + lane))
#pragma unroll
        for (int r = 0; r < 4; ++r) { float s = 0.f;
#pragma unroll
            for (int j = 0; j < 8; ++j) s += (v[r][j].x * v[r][j].x + v[r][j].y * v[r][j].y) + (v[r][j].z * v[r][j].z + v[r][j].w * v[r][j].w);
            rr[r] = 1.0f / sqrtf(wave_sum(s, lane) * (1.0f / DM) + EPS); }
        if (FINAL) {
            f32x4 gf4[8];
#pragma unroll
            for (int j = 0; j < 8; ++j) gf4[j] = ((const GAS f32x4*)gfin)[NQ(j)];
#pragma unroll
            for (int r = 0; r < 4; ++r) { GAS f32x4* o = (GAS f32x4*)(outf + (size_t)(m0 + r) * DM);
#pragma unroll
                for (int j = 0; j < 8; ++j) o[NQ(j)] = v[r][j] * rr[r] * gf4[j]; }
        } else {
            f32x4 gq4[8];
#pragma unroll
            for (int j = 0; j < 8; ++j) gq4[j] = ((const GAS f32x4*)gq)[NQ(j)];
#pragma unroll
            for (int r = 0; r < 4; ++r) { GAS u32x2* o = (GAS u32x2*)(XN + (size_t)(m0 + r) * DM); GAS unsigned* o8 = (GAS unsigned*)(XN8 + (size_t)(m0 + r) * (DM / 4));
                float mx = 0.f;
#pragma unroll
                for (int j = 0; j < 8; ++j) { const f32x4 y = v[r][j] * gq4[j]; mx = fmaxf(mx, fmaxf(fmaxf(fabsf(y.x), fabsf(y.y)), fmaxf(fabsf(y.z), fabsf(y.w)))); }
                mx = fmaxf(wave_max(mx, lane) * rr[r], 1e-20f); const float qi = rr[r] * 127.0f / mx;
                if (lane == 0) { AS8[m0 + r] = mx * (1.0f / 127.0f); if (RS) RS[m0 + r] = rr[r]; }
#pragma unroll
                for (int j = 0; j < 8; ++j) { if (XN) { const f32x4 t = v[r][j] * rr[r]; u32x2 w; w.x = cvt_pk_bf16(t.x, t.y); w.y = cvt_pk_bf16(t.z, t.w); o[NQ(j)] = w; }
                    const f32x4 y = v[r][j] * gq4[j] * qi; o8[NQ(j)] = q8x4(y.x, y.y, y.z, y.w); } }
        }
        if (FORGET) {
#pragma unroll 1
            for (int h = 0; h < 8; ++h) {
                float a0 = 0.f, a1 = 0.f, a2 = 0.f, a3 = 0.f;
#pragma unroll
                for (int j = 0; j < 8; ++j) { const f32x4 w = *((LAS f32x4*)lds + h * 512 + NQ(j));
                    a0 += (v[0][j].x * w.x + v[0][j].y * w.y) + (v[0][j].z * w.z + v[0][j].w * w.w);
                    a1 += (v[1][j].x * w.x + v[1][j].y * w.y) + (v[1][j].z * w.z + v[1][j].w * w.w);
                    a2 += (v[2][j].x * w.x + v[2][j].y * w.y) + (v[2][j].z * w.z + v[2][j].w * w.w);
                    a3 += (v[3][j].x * w.x + v[3][j].y * w.y) + (v[3][j].z * w.z + v[3][j].w * w.w); }
                a0 = wave_sum(a0, lane); a1 = wave_sum(a1, lane); a2 = wave_sum(a2, lane); a3 = wave_sum(a3, lane);
                const float bh = fb[h];
                const float z = (lane == 0 ? a0 * rr[0] : lane == 1 ? a1 * rr[1] : lane == 2 ? a2 * rr[2] : a3 * rr[3]) + bh;
                const float az = fabsf(z);
                const float ls = fminf(z, 0.f) - 0.6931471805599453f * __builtin_amdgcn_logf(1.0f + fast_exp2(-LOG2E * az));
                if (lane < 4) logf[(size_t)h * M + m0 + lane] = ls;
            }
        }
    }
#undef NQ
}

namespace att {
constexpr int LDS_K = 0, LDS_V = 8192, LDS_BUF = 16384, LDS_SV = 32768, LDS_WS = 65536, LDS_QW = 67584, LDS_FL = 69632;
constexpr float NEG = -1e30f;
__device__ __forceinline__ int crow(int r, int hi) { return (r & 3) + 8 * (r >> 2) + 4 * hi; }
__device__ __forceinline__ s16x4 vtr(const LAS unsigned char* p) { return __builtin_bit_cast(s16x4, __builtin_amdgcn_ds_read_tr16_b64_v4i16((LAS s16x4*)p)); }
__device__ __forceinline__ float max3f(float a, float b, float c) { float r; asm("v_max3_f32 %0, %1, %2, %3" : "=v"(r) : "v"(a), "v"(b), "v"(c)); return r; }
__device__ __forceinline__ float rowmax32(const f32x16& p0, const f32x16& p1) {
    float a = max3f(p0[0], p0[1], p1[0]), b = max3f(p0[2], p0[3], p1[1]); a = max3f(a, p1[2], p1[3]);
#pragma unroll
    for (int r = 4; r < 16; r += 4) { a = max3f(a, p0[r], p0[r + 1]); b = max3f(b, p0[r + 2], p0[r + 3]); a = max3f(a, p1[r], p1[r + 1]); b = max3f(b, p1[r + 2], p1[r + 3]); }
    return fmaxf(a, b);
}
struct AttnArgs {
    const bf16_t *Q, *K, *V; long rs;
    int q0, kbase, jlo, jhi;
    const float* Fl;
    const float* rope; long rrs;
    bf16_t* Ob; float* Of; long ors;
    float* lse; long lrs;
};
__device__ __forceinline__ u32x4 rope8(u32x4 x1, u32x4 x2, const f32x4 c0, const f32x4 c1, const f32x4 s0, const f32x4 s1, bool first) {
    float a[8], b[8], c[8], s[8], o[8];
    a[0] = bf_lo(x1.x); a[1] = bf_hi(x1.x); a[2] = bf_lo(x1.y); a[3] = bf_hi(x1.y); a[4] = bf_lo(x1.z); a[5] = bf_hi(x1.z); a[6] = bf_lo(x1.w); a[7] = bf_hi(x1.w);
    b[0] = bf_lo(x2.x); b[1] = bf_hi(x2.x); b[2] = bf_lo(x2.y); b[3] = bf_hi(x2.y); b[4] = bf_lo(x2.z); b[5] = bf_hi(x2.z); b[6] = bf_lo(x2.w); b[7] = bf_hi(x2.w);
#pragma unroll
    for (int e = 0; e < 4; ++e) { c[e] = c0[e]; c[4 + e] = c1[e]; s[e] = s0[e]; s[4 + e] = s1[e]; }
#pragma unroll
    for (int e = 0; e < 8; ++e) o[e] = first ? (a[e] * c[e] - b[e] * s[e]) : (a[e] * s[e] + b[e] * c[e]);
    u32x4 w; w.x = cvt_pk_bf16(o[0], o[1]); w.y = cvt_pk_bf16(o[2], o[3]); w.z = cvt_pk_bf16(o[4], o[5]); w.w = cvt_pk_bf16(o[6], o[7]); return w;
}
template <int MODE>
__device__ __forceinline__ void attn_unit(LAS unsigned char* lds, const AttnArgs& A, int tid) {
    asm volatile("" : "+v"(tid));
    const int lane = tid & 63, wv = __builtin_amdgcn_readfirstlane(tid >> 6), r32 = lane & 31, hi = lane >> 5;
    LAS float* wsf = (LAS float*)(lds + LDS_WS) + wv * 64;
    const int qi = A.q0 + 32 * wv + r32;
    bf16x8 qr[4];
    { const bf16_t* qrow = A.Q + (long)qi * A.rs;
#pragma unroll
      for (int d0 = 0; d0 < 4; ++d0) qr[d0] = *(const bf16x8*)(qrow + d0 * 16 + hi * 8); }
    const int krow = 8 * wv + (lane & 7), kch = lane >> 3, vrow = 8 * wv + (lane >> 3), vch = lane & 7;
    const int kdo = LDS_K + kch * 1024 + krow * 16, vdo = LDS_V + (vch >> 2) * 4096 + vrow * 64 + (vch & 3) * 16;
    u32x4 kreg, vreg; f32x4 rc0, rc1, rs0, rs1;
    rc0 = rc1 = rs0 = rs1 = (f32x4){0.f, 0.f, 0.f, 0.f};
#define ATT_LOAD(j) do { const long ks_ = (long)A.kbase + 64 * (j); \
        kreg = *(const u32x4*)(A.K + (ks_ + krow) * A.rs + kch * 8); vreg = *(const u32x4*)(A.V + (ks_ + vrow) * A.rs + vch * 8); \
        if (MODE == 1) { if (kch < 2) { const float* rp_ = A.rope + (ks_ + krow) * A.rrs; rc0 = *(const f32x4*)(rp_); rc1 = *(const f32x4*)(rp_ + 4); rs0 = *(const f32x4*)(rp_ + 8); rs1 = *(const f32x4*)(rp_ + 12); } } } while (0)
    ATT_LOAD(A.jhi - 1);
    if (MODE == 1) {
        const float* rp = A.rope + (long)qi * A.rrs;
        const f32x4 c0 = *(const f32x4*)(rp), c1 = *(const f32x4*)(rp + 4), s0 = *(const f32x4*)(rp + 8), s1 = *(const f32x4*)(rp + 12);
        const u32x4 me = __builtin_bit_cast(u32x4, qr[0]); u32x4 x1, x2;
#pragma unroll
        for (int e = 0; e < 4; ++e) { auto rr = __builtin_amdgcn_permlane32_swap(me[e], me[e], false, false); x1[e] = rr[0]; x2[e] = rr[1]; }
        qr[0] = __builtin_bit_cast(bf16x8, rope8(x1, x2, c0, c1, s0, s1, hi == 0));
    }
    const float flq = (MODE != 1) ? A.Fl[qi] : 0.f;
    float m = (MODE == 1) ? NEG : 0.f, l = 0.f; f32x16 o0, o1; bool first = true;
#pragma unroll
    for (int r = 0; r < 16; ++r) { o0[r] = 0.f; o1[r] = 0.f; }
    const int qw0 = A.q0 + 32 * wv;
    int wlo = A.jlo; const int whi = (qw0 + 31 - A.kbase) >> 6;
    if (MODE == 1) { const int f = (qw0 - 128 - A.kbase) >> 6; wlo = f > wlo ? f : wlo; }
    const int k0 = A.kbase + 64 * A.jlo;
    if (MODE != 1) {
        LAS f32x4* fl4 = (LAS f32x4*)(lds + LDS_FL); const int n4 = 16 * (A.jhi - A.jlo);
        for (int i = tid; i < n4; i += 512) fl4[i] = *(const f32x4*)(A.Fl + k0 + 4 * i);
    }
#define ATT_WRITE(buf) do { if (MODE == 1) { u32x4 oth; _Pragma("unroll") for (int e = 0; e < 4; ++e) oth[e] = shxu(kreg[e], 8, lane); \
            if (kch < 2) kreg = (kch == 0) ? rope8(kreg, oth, rc0, rc1, rs0, rs1, true) : rope8(oth, kreg, rc0, rc1, rs0, rs1, false); } \
        *(LAS u32x4*)(lds + (buf) * LDS_BUF + kdo) = kreg; *(LAS u32x4*)(lds + (buf) * LDS_BUF + vdo) = vreg; } while (0)
    const int nst = A.jhi - A.jlo;
    asm volatile("s_barrier" ::: "memory");
    ATT_WRITE(0);
    if (nst > 1) ATT_LOAD(A.jhi - 2);
    BAR_L();
    for (int st = 0; st < nst; ++st) {
        const int j = A.jhi - 1 - st, cur = st & 1;
        if (j >= wlo && j <= whi) {
            const int ks = A.kbase + 64 * j;
            const LAS unsigned char* tb = lds + cur * LDS_BUF;
            f32x16 p0, p1;
            const float fm = flq - m;
            if (MODE != 1) { const LAS float* fk = (const LAS float*)(lds + LDS_FL) + (ks - k0) + 4 * hi;
#pragma unroll
                for (int g4 = 0; g4 < 4; ++g4) { const f32x4 a = *(const LAS f32x4*)(fk + 8 * g4), b = *(const LAS f32x4*)(fk + 32 + 8 * g4);
#pragma unroll
                    for (int e = 0; e < 4; ++e) { p0[4 * g4 + e] = fm - a[e]; p1[4 * g4 + e] = fm - b[e]; } }
            } else {
#pragma unroll
                for (int r = 0; r < 16; ++r) { p0[r] = 0.f; p1[r] = 0.f; } }
            { const LAS unsigned char* kb = tb + LDS_K + hi * 1024 + r32 * 16;
#pragma unroll
              for (int d0 = 0; d0 < 4; ++d0) { const bf16x8 b0 = *(const LAS bf16x8*)(kb + d0 * 2048), b1 = *(const LAS bf16x8*)(kb + d0 * 2048 + 512);
                  p0 = __builtin_amdgcn_mfma_f32_32x32x16_bf16(b0, qr[d0], p0, 0, 0, 0); p1 = __builtin_amdgcn_mfma_f32_32x32x16_bf16(b1, qr[d0], p1, 0, 0, 0); } }
            if (MODE != 1) {
                if (ks + 63 > qw0) {
#pragma unroll
                    for (int r = 0; r < 16; ++r) { const int kv = ks + crow(r, hi); if (kv > qi) p0[r] = NEG; if (kv + 32 > qi) p1[r] = NEG; } }
            } else {
#pragma unroll
                for (int r = 0; r < 16; ++r) { const int d = qi - (ks + crow(r, hi)); if (d < 0 || d > 128) p0[r] = NEG; if (d - 32 < 0 || d - 32 > 128) p1[r] = NEG; }
            }
            asm volatile("s_nop 15\n\ts_nop 7" : "+v"(p0), "+v"(p1));
            float rm = rowmax32(p0, p1);
            { auto rr = __builtin_amdgcn_permlane32_swap(__float_as_uint(rm), __float_as_uint(rm), false, false); rm = fmaxf(__uint_as_float(rr[0]), __uint_as_float(rr[1])); }
            float f = 1.0f; bool resc;
            if (MODE != 1) {
                const float d = first ? rm : fmaxf(rm, 0.f);
                resc = first || (__builtin_amdgcn_ballot_w64(rm > 0.f) != 0ull);
                if (resc) { m += d;
#pragma unroll
                    for (int r = 0; r < 16; ++r) { p0[r] -= d; p1[r] -= d; }
                    if (!first) { f = fast_exp2(-d); l *= f; } else resc = false; }
            } else {
                const float mn = fmaxf(m, rm); f = fast_exp2(m - mn); m = mn; l *= f;
#pragma unroll
                for (int r = 0; r < 16; ++r) { p0[r] -= mn; p1[r] -= mn; }
                resc = __builtin_amdgcn_ballot_w64(f != 1.0f) != 0ull;
            }
            first = false;
#pragma unroll
            for (int r = 0; r < 16; ++r) p0[r] = fast_exp2(p0[r]);
#pragma unroll
            for (int r = 0; r < 16; ++r) p1[r] = fast_exp2(p1[r]);
            { float s0 = 0.f, s1 = 0.f, s2 = 0.f, s3 = 0.f;
#pragma unroll
              for (int r = 0; r < 16; r += 2) { s0 += p0[r]; s1 += p0[r + 1]; s2 += p1[r]; s3 += p1[r + 1]; }
              l += (s0 + s1) + (s2 + s3); }
            if (resc) {
                if (hi == 0) wsf[r32] = f;
                f32x4 fr[4];
#pragma unroll
                for (int g4 = 0; g4 < 4; ++g4) fr[g4] = *(const LAS f32x4*)(wsf + 8 * g4 + 4 * hi);
#pragma unroll
                for (int r = 0; r < 16; ++r) { o0[r] *= fr[r >> 2][r & 3]; o1[r] *= fr[r >> 2][r & 3]; }
            }
            u32x4 pw[4];
#pragma unroll
            for (int e = 0; e < 4; ++e) { pw[0][e] = cvt_pk_bf16(p0[2 * e], p0[2 * e + 1]); pw[1][e] = cvt_pk_bf16(p0[8 + 2 * e], p0[9 + 2 * e]);
                                          pw[2][e] = cvt_pk_bf16(p1[2 * e], p1[2 * e + 1]); pw[3][e] = cvt_pk_bf16(p1[8 + 2 * e], p1[9 + 2 * e]); }
            const LAS unsigned char* vp = tb + LDS_V + ((lane >> 4) & 1) * 32 + (lane & 3) * 8 + (4 * hi + ((lane & 15) >> 2)) * 64;
#pragma unroll
            for (int k4 = 0; k4 < 4; ++k4) {
                const s16x4 a0 = vtr(vp + k4 * 1024), a1 = vtr(vp + k4 * 1024 + 512), b0 = vtr(vp + 4096 + k4 * 1024), b1 = vtr(vp + 4096 + k4 * 1024 + 512);
                const bf16x8 v0 = (bf16x8){a0[0], a0[1], a0[2], a0[3], a1[0], a1[1], a1[2], a1[3]}, v1 = (bf16x8){b0[0], b0[1], b0[2], b0[3], b1[0], b1[1], b1[2], b1[3]};
                o0 = __builtin_amdgcn_mfma_f32_32x32x16_bf16(__builtin_bit_cast(bf16x8, pw[k4]), v0, o0, 0, 0, 0);
                o1 = __builtin_amdgcn_mfma_f32_32x32x16_bf16(__builtin_bit_cast(bf16x8, pw[k4]), v1, o1, 0, 0, 0);
            }
        }
        if (st + 1 < nst) { ATT_WRITE(cur ^ 1); if (st + 2 < nst) ATT_LOAD(j - 2); }
        BAR_L();
    }
#undef ATT_WRITE
#undef ATT_LOAD
    { auto rr = __builtin_amdgcn_permlane32_swap(__float_as_uint(l), __float_as_uint(l), false, false); l = __uint_as_float(rr[0]) + __uint_as_float(rr[1]); }
    if (hi == 0) wsf[r32] = (MODE == 2) ? 1.0f : 1.0f / l;
    f32x4 fr[4];
#pragma unroll
    for (int g4 = 0; g4 < 4; ++g4) fr[g4] = *(const LAS f32x4*)(wsf + 8 * g4 + 4 * hi);
#pragma unroll
    for (int r = 0; r < 16; ++r) { const long row = (long)(qw0 + crow(r, hi)) * A.ors; const float s = fr[r >> 2][r & 3];
        if (MODE == 0) { A.Ob[row + r32] = (bf16_t)(cvt_pk_bf16(o0[r] * s, 0.f) & 0xffffu); A.Ob[row + 32 + r32] = (bf16_t)(cvt_pk_bf16(o1[r] * s, 0.f) & 0xffffu); }
        else { A.Of[row + r32] = o0[r] * s; A.Of[row + 32 + r32] = o1[r] * s; } }
    if (MODE == 1) { if (hi == 0) A.lse[(long)qi * A.lrs] = m + log2f(l); }
    if (MODE == 2) { if (hi == 0) { A.lse[(long)qi * A.lrs] = m; A.lse[(long)qi * A.lrs + 1] = l; } }
}
}

constexpr int NPH_PRO = 2, NPH_LAYER = 11, NPHASE = NPH_PRO + DEPTH * NPH_LAYER;
constexpr int TR_ITEMS = 37632;
constexpr int MIX_TR = 588, MIX_TRI = 64;
constexpr int MIX_FOX = 384, MIX_DIL = 384, MIX_SGU = 256, MIX_CONV = 256, MIX_UNITS = MIX_GEMM + MIX_FOX + MIX_DIL + MIX_SGU + MIX_CONV;
__constant__ double c_rope_inv[8] = {1.0, 0.19392274474868576, 0.03760603093086393, 0.007292664737217109, 0.001414213562373095, 0.0002742481756762073, 5.318295896944988e-05, 1.031338537721246e-05};

__device__ __forceinline__ void sincos_d(double x, float& sn, float& cs) {
    const double q = rint(x * 0.63661977236758134308);
    const double r = (x - q * 1.57079632679489655800e+00) - q * 6.12323399573676603587e-17;
    const int qi = ((int)q) & 3;
    const double r2 = r * r;
    double s = r * (1.0 + r2 * (-1.0 / 6 + r2 * (1.0 / 120 + r2 * (-1.0 / 5040 + r2 * (1.0 / 362880 + r2 * (-1.0 / 39916800 + r2 * (1.0 / 6227020800.0)))))));
    double c = 1.0 + r2 * (-0.5 + r2 * (1.0 / 24 + r2 * (-1.0 / 720 + r2 * (1.0 / 40320 + r2 * (-1.0 / 3628800 + r2 * (1.0 / 479001600.0 + r2 * (-1.0 / 87178291200.0)))))));
    double so = (qi == 0) ? s : (qi == 1) ? c : (qi == 2) ? -s : -c;
    double co = (qi == 0) ? c : (qi == 1) ? -s : (qi == 2) ? -c : s;
    sn = (float)so; cs = (float)co;
}

__device__ __forceinline__ int opaque_i(int k) { asm volatile("" : "+s"(k)); return k; }
__device__ __forceinline__ int lane_id_now() { int l; asm volatile("v_mbcnt_lo_u32_b32 %0, -1, 0\n\tv_mbcnt_hi_u32_b32 %0, -1, %0" : "=v"(l)); return l; }
__global__ void __launch_bounds__(512, 2) mk_fwd(Args args) {
    extern __shared__ __attribute__((aligned(16))) unsigned char lds_raw[];
    LAS unsigned char* lds = (LAS unsigned char*)lds_raw;
    volatile LAS unsigned* MISC = (volatile LAS unsigned*)(lds + MISC_OFF);
    const int wave0 = __builtin_amdgcn_readfirstlane(threadIdx.x >> 6);
#define MK_TID() (wave0 * 64 + lane_id_now())
    const int G = gridDim.x, bx = blockIdx.x, NGW = G * 8;
#define WS_LOCAL() unsigned char* ws = args.ws; float* X = args.out; asm volatile("" : "+s"(ws), "+s"(X)); (void)X
    unsigned* ctl = (unsigned*)(args.ws + WS_CTL);
    for (int u = MK_TID(); u < (LDS_BYTES - RING_BYTES) / 4; u += 512) ((LAS unsigned*)(lds + RING_BYTES))[u] = 0u;
    __syncthreads();
    XcdBarrier bar = xcd_barrier_post(ctl + CW_BAR + args.li * XCD_BAR_WORDS, MISC + 8);
    const int lo = args.ph_lo, hi = args.ph_hi;
#define IN(k) (lo <= (k) && (k) < hi)
#if PROBE_PH >= 0
    if (threadIdx.x == 0) { const unsigned long long t_ = __builtin_amdgcn_s_memrealtime(); MISC[20] = (unsigned)t_; MISC[21] = (unsigned)(t_ >> 32); }
#define PROBE_SEL(k) ((PROBE_PH < 100) ? ((k) == PROBE_PH) : ((k) >= NPH_PRO && ((k) - NPH_PRO) % NPH_LAYER == PROBE_PH - 100))
#define SEAM(k) do { if (IN(k) && IN((k) + 1)) xcd_barrier(bar); if (threadIdx.x == 0) { const unsigned long long tn_ = __builtin_amdgcn_s_memrealtime(), tp_ = (unsigned long long)MISC[20] | ((unsigned long long)MISC[21] << 32), du_ = tn_ - tp_; \
        if (PROBE_SEL(k)) { while (__builtin_amdgcn_s_memrealtime() - tn_ < du_) __builtin_amdgcn_s_sleep(8); } } __syncthreads(); \
        if (threadIdx.x == 0) { const unsigned long long t_ = __builtin_amdgcn_s_memrealtime(); MISC[20] = (unsigned)t_; MISC[21] = (unsigned)(t_ >> 32); } } while (0)
#else
#define SEAM(k) do { if (IN(k) && IN((k) + 1)) xcd_barrier(bar); } while (0)
#endif
#define x_in (args.in[opaque_i(0)])
#define p_in (args.in[opaque_i(1)])
#define pos_in ((const int*)args.in[opaque_i(2)])
#define norm_mix_g (args.in[opaque_i(3)])
#define w_in (args.in[opaque_i(4)])
#define fox_b (args.in[opaque_i(5)])
#define scw (args.in[opaque_i(6)])
#define sgu_g (args.in[opaque_i(7)])
#define sgu_w (args.in[opaque_i(8)])
#define sgu_b (args.in[opaque_i(9)])
#define w_br_fox (args.in[opaque_i(10)])
#define w_br_conv (args.in[opaque_i(11)])
#define w_br_sgu (args.in[opaque_i(12)])
#define w_br_dil (args.in[opaque_i(13)])
#define w_out (args.in[opaque_i(14)])
#define norm_ffn_g (args.in[opaque_i(15)])
#define w_up (args.in[opaque_i(16)])
#define ffn_cw (args.in[opaque_i(17)])
#define w_down (args.in[opaque_i(18)])
#define norm_ple_g (args.in[opaque_i(19)])
#define w_pg (args.in[opaque_i(20)])
#define w_pe (args.in[opaque_i(21)])
#define final_g (args.in[opaque_i(22)])
#define WFG ((float*)(ws + WS_SMALL + SM_WFG))
#define SGUW ((bf16_t*)(ws + WS_SMALL + SM_SGUW))
#define ROPE ((float*)(ws + WS_SMALL + SM_ROPE))
#define LOGF ((float*)(ws + WS_SMALL + SM_LOGF))
#define FL ((float*)(ws + WS_SMALL + SM_FL))
#define LSE ((float*)(ws + WS_SMALL + SM_LSE))
#define SSQ ((float*)(ws + WS_PART))
#define RSC ((float*)(ws + WS_SMALL + SM_SS))
#define FOP ((float*)(ws + WS_FOP))
#define FML ((float*)(ws + WS_FML))
#define UPB ((bf16_t*)(ws + WS_UPB))
#define G8 ((unsigned char*)(ws + WS_G8))
#define XN8 ((unsigned*)(ws + WS_XN8))
#define AS8 ((float*)(ws + WS_SMALL + SM_SS + 65536))
#define QSC ((float*)(ws + WS_SMALL + SM_SS + 98304))
#define XR ((bf16_t*)(ws + WS_XR) + (size_t)(L & 1) * M * DM)
#define XRN ((bf16_t*)(ws + WS_XR) + (size_t)((L + 1) & 1) * M * DM)
#define PB ((bf16_t*)(ws + WS_PB))
#define PP ((bf16_t*)(ws + WS_PP))
#define XN ((bf16_t*)(ws + WS_XN))
#define PROJ ((bf16_t*)(ws + WS_PROJ))
#define UP ((bf16_t*)(ws + WS_PROJ))
#define HID ((bf16_t*)(ws + WS_HID))
#define OCAT ((bf16_t*)(ws + WS_OCAT))
#define MG ((bf16_t*)(ws + WS_MG))
#define ODIL ((float*)(ws + WS_ODIL))

    if (IN(0)) { WS_LOCAL();
        const int tid = MK_TID(), lane = tid & 63, wave = wave0, gw = bx * 8 + wave;
        LAS float* qsl = (LAS float*)(lds + RING_BYTES + 4096);
        { float sq[8];
#pragma unroll
          for (int mth = 0; mth < 8; ++mth) { const int Ls = mth >> 1; float a = 0.f;
              for (int j = 0; j < 16; ++j) { const int i = tid + 512 * j;
                  const float w = (mth & 1) ? w_up[(size_t)Ls * DM * 2 * DFF + i] : w_in[(size_t)Ls * DM * DIN_SRC + (size_t)(i >> 11) * DIN_SRC + 6408 + (i & 2047)];
                  a += w * w; }
              sq[mth] = wave_sum(a, lane); }
          if (lane == 0) {
#pragma unroll
              for (int mth = 0; mth < 8; ++mth) qsl[8 + wave * 8 + mth] = sq[mth]; }
          __syncthreads();
          if (tid < 8) { float t = 0.f; for (int w = 0; w < 8; ++w) t += qsl[8 + w * 8 + tid];
              const float rng = 4.0f * sqrtf(t * (1.0f / 8192.0f)) + 1e-30f; qsl[tid] = 127.0f / rng; if (bx == 0) QSC[tid] = rng * (1.0f / 127.0f); }
          __syncthreads(); }
        LAS float* scr = (LAS float*)(lds + wave * 16384);
#define TR_DECODE(d, it_) do { const int L_ = (it_) / TR_ITEMS; int r_ = (it_) % TR_ITEMS; unsigned char* wl_ = ws + WS_WL + (size_t)L_ * WL_STRIDE; const float* win_ = w_in + (size_t)L_ * DM * DIN_SRC; \
            if (r_ < 1536 + 13056) { const bool pa_ = r_ < 1536; if (!pa_) r_ -= 1536; \
                if (pa_) d = TrDesc{win_, norm_mix_g + L_ * DM, (bf16_t*)(wl_ + WL_IN), DIN_SRC, 0, DM, 0, 0, r_ / 48, r_ % 48, 0, 0.f}; \
                else d = TrDesc{win_, norm_mix_g + L_ * DM, (bf16_t*)(wl_ + WL_IN), DIN_SRC, 1544, DM, 1536, 0, r_ / 408, r_ % 408, 0, 0.f}; \
                const int pc_ = d.drow0 + 32 * d.nb, pt_ = pc_ >> 8;        \
                if (pc_ >= PC_G || ((I8MASK >> pt_) & 1u)) { d.WT = (bf16_t*)(wl_ + WL_G8W); d.f8 = 1; d.gk = nullptr; d.qinv = qsl[2 * L_]; \
                    d.drow0 += (pc_ >= PC_G) ? (N8T * 256 - PC_G) : (__builtin_popcount(I8MASK & ((1u << pt_) - 1u)) - pt_) * 256; } } \
            else if ((r_ -= 1536 + 13056) < 512) { d = TrDesc{w_br_fox + (size_t)L_ * 512 * DM, nullptr, (bf16_t*)(wl_ + WL_BR), DM, 0, OC_W, 0, OC_A, r_ / 64, r_ % 64, 0, 0.f}; } \
            else if ((r_ -= 512) < 512) { d = TrDesc{w_br_conv + (size_t)L_ * 512 * DM, nullptr, (bf16_t*)(wl_ + WL_BR), DM, 0, OC_W, 0, OC_B, r_ / 64, r_ % 64, 0, 0.f}; } \
            else if ((r_ -= 512) < 512) { d = TrDesc{w_br_sgu + (size_t)L_ * 512 * DM, nullptr, (bf16_t*)(wl_ + WL_BR), DM, 0, OC_W, 0, OC_C, r_ / 64, r_ % 64, 0, 0.f}; } \
            else if ((r_ -= 512) < 256) { d = TrDesc{w_br_dil + (size_t)L_ * 256 * DM, nullptr, (bf16_t*)(wl_ + WL_BR), DM, 0, OC_W, 0, OC_D, r_ / 64, r_ % 64, 0, 0.f}; } \
            else if ((r_ -= 256) < 2048) { d = TrDesc{w_out + (size_t)L_ * DM * DM, nullptr, (bf16_t*)(wl_ + WL_OUT), DM, 0, DM, 0, 0, r_ / 64, r_ % 64, 0, 0.f}; } \
            else if ((r_ -= 2048) < 11264) { d = TrDesc{w_up + (size_t)L_ * DM * 2 * DFF, nullptr, (bf16_t*)(wl_ + WL_UP), 2 * DFF, 0, DM, 0, 0, r_ / 352, r_ % 352, 1, qsl[2 * L_ + 1]}; }   \
            else if ((r_ -= 11264) < 5632) { d = TrDesc{w_down + (size_t)L_ * DFF * DM, nullptr, (bf16_t*)(wl_ + WL_DN), DM, 0, DFF, 0, 0, r_ / 64, r_ % 64, 0, 0.f}; } \
            else if ((r_ -= 5632) < 2048) { d = TrDesc{w_pg + (size_t)L_ * DM * DM, norm_ple_g + L_ * DM, (bf16_t*)(wl_ + WL_PG), DM, 0, DM, 0, 0, r_ / 64, r_ % 64, 0, 0.f}; } \
            else { r_ -= 2048; d = TrDesc{w_pe + (size_t)L_ * PLE * DM, nullptr, (bf16_t*)(wl_ + WL_PE), DM, 0, PLE, 0, 0, r_ / 64, r_ % 64, 0, 0.f}; } } while (0)
#define TR_RUN(it0_, end_, stride_) do { TrDesc d0, d1, d2, d3; f32x4 v0[8], v1[8], v2[8], v3[8]; float g0[8], g1[8], g2[8], g3[8]; int it = (it0_);     \
            for (; it + 3 * (stride_) < (end_); it += 4 * (stride_)) { TR_DECODE(d0, it); tr_load(v0, g0, d0, lane); TR_DECODE(d1, it + (stride_)); tr_load(v1, g1, d1, lane); TR_DECODE(d2, it + 2 * (stride_)); tr_load(v2, g2, d2, lane); \
                TR_DECODE(d3, it + 3 * (stride_)); tr_load(v3, g3, d3, lane); \
                tr_store(v0, g0, d0, scr, lane); tr_store(v1, g1, d1, scr, lane); tr_store(v2, g2, d2, scr, lane); tr_store(v3, g3, d3, scr, lane); } \
            for (; it < (end_); it += (stride_)) { TR_DECODE(d0, it); tr_load(v0, g0, d0, lane); tr_store(v0, g0, d0, scr, lane); } } while (0)
        TR_RUN(gw, TR_ITEMS, NGW);
        const int gt = bx * 512 + tid, NGT = G * 512;
        for (int i = gt; i < DEPTH * 8 * DM; i += NGT) { const int L = i / (8 * DM), h = (i / DM) % 8, k = i % DM;
            WFG[i] = norm_mix_g[L * DM + k] * w_in[(size_t)L * DM * DIN_SRC + (size_t)k * DIN_SRC + 1536 + h]; }
        for (int i = gt; i < DEPTH * 4 * 128 * 128; i += NGT) { const int t = (i >> 7) & 127, s = i & 127; SGUW[i] = (s <= t) ? (bf16_t)(cvt_pk_bf16(sgu_w[i], 0.f) & 0xffffu) : (bf16_t)0; }
        for (int i = gt; i < M * 8; i += NGT) { const int row = i >> 3, jj = i & 7; float sn, cs; sincos_d((double)pos_in[row] * c_rope_inv[jj], sn, cs); ROPE[row * 16 + jj] = cs; ROPE[row * 16 + 8 + jj] = sn; }
#define CVT_STREAM(src_, dst_, n_) do { const f32x4* s_ = (const f32x4*)(src_); u32x4* d_ = (u32x4*)(dst_); \
            for (int i = gt; i < (n_); i += 4 * NGT) { f32x4 a[4], b[4]; \
                _Pragma("unroll") for (int k = 0; k < 4; ++k) { const int ii = i + k * NGT; if (ii < (n_)) { a[k] = s_[2 * ii]; b[k] = s_[2 * ii + 1]; } else { a[k] = (f32x4){0.f, 0.f, 0.f, 0.f}; b[k] = a[k]; } } \
                _Pragma("unroll") for (int k = 0; k < 4; ++k) { const int ii = i + k * NGT; u32x4 w; w.x = cvt_pk_bf16(a[k].x, a[k].y); w.y = cvt_pk_bf16(a[k].z, a[k].w); w.z = cvt_pk_bf16(b[k].x, b[k].y); w.w = cvt_pk_bf16(b[k].z, b[k].w); \
                    if (ii < (n_)) d_[ii] = w; } } } while (0)
        CVT_STREAM(x_in, ws + WS_XR, M * DM / 8);
        CVT_STREAM(p_in, PB, DEPTH * M * PLE / 8);
#undef CVT_STREAM
    }
    SEAM(0);
    if (IN(1)) { WS_LOCAL();
        const int tid = MK_TID(), lane = tid & 63, gw = bx * 8 + wave0;
        norm_phase<true, false, false>(x_in, nullptr, nullptr, RSC, XN8, AS8, norm_mix_g, WFG, fox_b, LOGF, nullptr, nullptr, lds, gw, NGW, lane, tid);
    }
    SEAM(1);

    for (int L = 0; L < DEPTH; ++L) {
        const int pb = NPH_PRO + L * NPH_LAYER;
#define wl (ws + WS_WL + (size_t)L * WL_STRIDE)
        if (IN(pb + 0)) { WS_LOCAL();
            const int bxs = opaque_i(bx);
            if (bxs >= 32 && bxs < 48 && G >= 48) {
                const int wave = opaque_i(wave0), tid = wave * 64 + lane_id_now(), lane = tid & 63, gw = bx * 8 + wave; (void)lane; (void)gw;
                const int seq = bxs - 32, b = seq >> 3, h = seq & 7; float v[8], run = 0.f;
                { const f32x4 la = *(const f32x4*)(LOGF + (size_t)h * M + b * SEQ + tid * 8), lb = *(const f32x4*)(LOGF + (size_t)h * M + b * SEQ + tid * 8 + 4);
                  const float lv[8] = {la.x, la.y, la.z, la.w, lb.x, lb.y, lb.z, lb.w};
#pragma unroll
                  for (int e = 0; e < 8; ++e) { run += lv[e]; v[e] = run; } }
                float inc = run;
#pragma unroll
                for (int o = 1; o < 64; o <<= 1) { const float t = __int_as_float(__builtin_amdgcn_ds_bpermute(((lane - o) & 63) << 2, __float_as_int(inc))); if (lane >= o) inc += t; }
                LAS float* wt = (LAS float*)lds;
                if (lane == 63) wt[wave] = inc;
                __syncthreads();
                float base = inc - run;
                for (int w = 0; w < wave; ++w) base += wt[w];
#pragma unroll
                for (int e = 0; e < 8; ++e) FL[seq * SEQ + tid * 8 + e] = (base + v[e]) * LOG2E;
                __syncthreads();
            }
            pg8::Gemm g{XR, (const bf16_t*)(wl + WL_IN), M, NBT * 256, DM}; pg8::ProjOrder S; S.init(M, NBT * 256, G, bx);
            pg8::EpiProj E{PROJ, DIN, G8, RSC};
            pg8::gemm_phase(lds, g, S, E, pg8::NoHook{}, MK_TID());
            pg8::Gemm g8{(const bf16_t*)XN8, (const bf16_t*)(wl + WL_G8W), M, N8N, opaque_i(DM / 2)}; pg8::Gate8Order S8; S8.init(M, N8N, G, bx);
            pg8::EpiGate8 E8{G8, AS8, QSC + 2 * L, PROJ, DIN};
            pg8::gemm_phase<pg8::EpiGate8, pg8::NoHook, pg8::Gate8Order, true>(lds, g8, S8, E8, pg8::NoHook{}, MK_TID());
        }
        SEAM(pb + 0);
        if (IN(pb + 1)) { WS_LOCAL();
            unsigned* qhead = ctl + CW_Q + 64 * L;
            unsigned qcur = 0u;
            if (MK_TID() == 0) qcur = __hip_atomic_fetch_add(qhead, 1u, __ATOMIC_RELAXED, __HIP_MEMORY_SCOPE_AGENT);
            for (;;) {
                const int wave = opaque_i(wave0), tid = wave * 64 + lane_id_now(), lane = tid & 63; (void)lane;
                __syncthreads();
                if (tid == 0) *(volatile LAS unsigned*)(lds + att::LDS_QW) = qcur;
                __syncthreads();
                int u = (int)*(volatile LAS unsigned*)(lds + att::LDS_QW);
                const int nq_ = MIX_UNITS + ((L + 1 < DEPTH) ? MIX_TR : 0);
#if MIX_PROBE
                const int nx_ = MIX_PROBE == 1 ? MIX_FOX : MIX_PROBE == 2 ? MIX_DIL : MIX_PROBE == 3 ? MIX_SGU : MIX_PROBE == 4 ? MIX_CONV : ((L + 1 < DEPTH) ? MIX_TR : 0);
                if (u >= nq_ + nx_) break;
                const int ex_ = u - nq_;
#else
                if (u >= nq_) break;
#endif
                if (u < MIX_GEMM) {
                    pg8::StaticOrder so; so.init(M, N8N, 256, 0); pg8::Unit gu; so.map(I8_INPHASE + u, gu);
                    pg8::Gemm g8{(const bf16_t*)XN8, (const bf16_t*)(wl + WL_G8W), M, N8N, opaque_i(DM / 2)}; pg8::OneUnit S1{gu.pm, gu.pn}; pg8::EpiGate8 E8{G8, AS8, QSC + 2 * L, PROJ, DIN};
                    pg8::gemm_phase<pg8::EpiGate8, pg8::NoHook, pg8::OneUnit, true>(lds, g8, S1, E8, pg8::NoHook{}, MK_TID());
                    if (MK_TID() == 0) qcur = __hip_atomic_fetch_add(qhead, 1u, __ATOMIC_RELAXED, __HIP_MEMORY_SCOPE_AGENT);
                    continue;
                }
                u -= MIX_GEMM;
                unsigned qnext = 0u;
                if (tid == 0) qnext = __hip_atomic_fetch_add(qhead, 1u, __ATOMIC_RELAXED, __HIP_MEMORY_SCOPE_AGENT);
                int cu = -1;
                if (L + 1 < DEPTH) { const int k = u / 19, r = u - 19 * k; if (k < 98) { if (r < 13) u = 13 * k + r; else cu = 6 * k + r - 13; } else u -= MIX_TR; }
#if MIX_PROBE
                if (ex_ >= 0) { cu = -1; u = ex_ + (MIX_PROBE == 2 ? MIX_FOX : MIX_PROBE == 3 ? MIX_FOX + MIX_DIL : MIX_PROBE == 4 ? MIX_FOX + MIX_DIL + MIX_SGU : 0); if (MIX_PROBE == 5) cu = ex_; }
#endif
                if (cu >= 0) {
                    LAS float* scr = (LAS float*)(lds + wave * 8448); LAS float* qsl = (LAS float*)(lds + RING_BYTES + 4096);
                    const int b0 = (L + 1) * TR_ITEMS + cu * MIX_TRI;
                    TR_RUN(b0 + wave, b0 + MIX_TRI, 8);
                } else if (u < MIX_FOX) {
                    const bool split = u < 256; int qb, seg, bh;
                    if (split) { qb = 15 - (u >> 5); seg = (u >> 4) & 1; bh = u & 15; } else { const int v = u - 256; qb = 7 - (v >> 4); seg = 0; bh = v & 15; }
                    const int b = bh >> 3, h = bh & 7;
                    att::AttnArgs A; const size_t r0 = (size_t)b * SEQ * DIN;
                    A.Q = PROJ + r0 + PC_AQ + h * 64; A.K = PROJ + r0 + PC_AK + h * 64; A.V = PROJ + r0 + PC_AV + h * 64; A.rs = DIN;
                    A.q0 = qb * 256; A.kbase = 0; A.Fl = FL + bh * SEQ; A.rope = nullptr; A.rrs = 0;
                    if (split) {
                        A.jlo = seg ? 2 * (qb + 1) : 0; A.jhi = seg ? 4 * (qb + 1) : 2 * (qb + 1);
                        A.Ob = nullptr; A.Of = FOP + (((long)seg * 4096 + (long)b * 2048 - 2048) * 8 + h) * 64; A.ors = 8 * 64;
                        A.lse = FML + (((long)seg * 4096 + (long)b * 2048 - 2048) * 8 + h) * 2; A.lrs = 16;
                        att::attn_unit<2>(lds, A, tid);
                    } else {
                        A.jlo = 0; A.jhi = 4 * (qb + 1);
                        A.Ob = OCAT + (size_t)b * SEQ * OC_W + OC_A + h * 64; A.Of = nullptr; A.ors = OC_W; A.lse = nullptr; A.lrs = 0;
                        att::attn_unit<0>(lds, A, tid);
                    }
                } else if (u < MIX_FOX + MIX_DIL) {
                    u -= MIX_FOX; const int grp = u >> 7, v = u & 127; const int sh = 2 * grp, dil = 1 << sh;
                    const int nqb = 16 >> sh; const int qb = v % nqb; int t = v / nqb; const int slot = t & 3; t >>= 2; const int res = t % dil; const int b = t / dil;
                    const int head = grp * 4 + slot; const size_t row0 = (size_t)b * SEQ + res;
                    att::AttnArgs A;
                    A.Q = PROJ + row0 * DIN + PC_DQ + head * 64; A.K = PROJ + row0 * DIN + PC_DK + head * 64; A.V = PROJ + row0 * DIN + PC_DV + head * 64; A.rs = (long)DIN * dil;
                    A.q0 = qb * 256; A.kbase = qb * 256 - 128; A.jlo = (qb == 0) ? 2 : 0; A.jhi = 6; A.Fl = nullptr; A.rope = ROPE + row0 * 16; A.rrs = 16L * dil;
                    A.Ob = nullptr; A.Of = ODIL + ((size_t)grp * M + row0) * 256 + slot * 64; A.ors = 256L * dil; A.lse = LSE + ((size_t)grp * M + row0) * 4 + slot; A.lrs = 4L * dil;
                    att::attn_unit<1>(lds, A, tid);
                } else if (u < MIX_FOX + MIX_DIL + MIX_SGU) {
                    u -= MIX_FOX + MIX_DIL; const int g = u & 3, c = (u >> 2) & 31, b = u >> 7; const size_t row0 = (size_t)b * SEQ + c * 128;
                    const int row = tid >> 2, part = tid & 3;
                    const int r32 = lane & 31, hh = lane >> 5, tb = wave & 3, dp = wave >> 2;
                    const bf16_t* wrow = SGUW + ((size_t)(L * 4 + g) * 128 + 32 * tb + r32) * 128 + 8 * hh;
                    bf16x8 wa[8];
#pragma unroll
                    for (int i = 0; i < 8; ++i) wa[i] = *(const bf16x8*)(wrow + 16 * i);
                    const bf16_t* vrow = PROJ + (row0 + row) * DIN + PC_SV;
                    const float* gsn = sgu_g + L * 512 + 128 * g + 32 * part;
                    u32x4 wg[4]; f32x4 gga[4], ggb[4];
#pragma unroll
                    for (int i = 0; i < 4; ++i) { wg[i] = *(const u32x4*)(vrow + 128 * g + 32 * part + 8 * i); gga[i] = *(const f32x4*)(gsn + 8 * i); ggb[i] = *(const f32x4*)(gsn + 8 * i + 4); }
                    float ss = 0.f;
#pragma unroll
                    for (int i = 0; i < 16; ++i) { const u32x4 w = *(const u32x4*)(vrow + part * 128 + 8 * i);
                        ss += (bf_lo(w.x) * bf_lo(w.x) + bf_hi(w.x) * bf_hi(w.x)) + (bf_lo(w.y) * bf_lo(w.y) + bf_hi(w.y) * bf_hi(w.y)) + (bf_lo(w.z) * bf_lo(w.z) + bf_hi(w.z) * bf_hi(w.z)) + (bf_lo(w.w) * bf_lo(w.w) + bf_hi(w.w) * bf_hi(w.w)); }
                    ss += shx(ss, 1, lane); ss += shx(ss, 2, lane);
                    const float rinv = 1.0f / sqrtf(ss * (1.0f / 512.0f) + EPS);
#pragma unroll
                    for (int i = 0; i < 4; ++i) { const u32x4 w = wg[i]; const f32x4 ga = gga[i], gb = ggb[i];
                        u32x4 o; o.x = cvt_pk_bf16(bf_lo(w.x) * rinv * ga.x, bf_hi(w.x) * rinv * ga.y); o.y = cvt_pk_bf16(bf_lo(w.y) * rinv * ga.z, bf_hi(w.y) * rinv * ga.w);
                        o.z = cvt_pk_bf16(bf_lo(w.z) * rinv * gb.x, bf_hi(w.z) * rinv * gb.y); o.w = cvt_pk_bf16(bf_lo(w.w) * rinv * gb.z, bf_hi(w.w) * rinv * gb.w);
                        *(LAS u32x4*)(lds + att::LDS_SV + part * 8192 + row * 64 + i * 16) = o; }
                    BAR_L();
                    float bia[16]; bf16_t uu0[16], uu1[16];
#pragma unroll
                    for (int r = 0; r < 16; ++r) { const int t = 32 * tb + att::crow(r, hh); const size_t gr = row0 + t; const int d = 128 * g + 64 * dp + r32;
                        bia[r] = sgu_b[(L * 4 + g) * 128 + t]; uu0[r] = PROJ[gr * DIN + PC_SU + d]; uu1[r] = PROJ[gr * DIN + PC_SU + d + 32]; }
                    f32x16 o0, o1;
#pragma unroll
                    for (int r = 0; r < 16; ++r) { o0[r] = 0.f; o1[r] = 0.f; }
                    const LAS unsigned char* vp = lds + att::LDS_SV + (2 * dp) * 8192 + ((lane >> 4) & 1) * 32 + (lane & 3) * 8 + (8 * hh + ((lane & 15) >> 2)) * 64;
#pragma unroll
                    for (int i = 0; i < 8; ++i) { if (i >= 2 * tb + 2) break;
                        const bf16x8 a = wa[i];
                        const s16x4 a0 = att::vtr(vp + i * 1024), a1 = att::vtr(vp + i * 1024 + 256), b0 = att::vtr(vp + 8192 + i * 1024), b1 = att::vtr(vp + 8192 + i * 1024 + 256);
                        const bf16x8 v0 = (bf16x8){a0[0], a0[1], a0[2], a0[3], a1[0], a1[1], a1[2], a1[3]}, v1 = (bf16x8){b0[0], b0[1], b0[2], b0[3], b1[0], b1[1], b1[2], b1[3]};
                        o0 = __builtin_amdgcn_mfma_f32_32x32x16_bf16(a, v0, o0, 0, 0, 0); o1 = __builtin_amdgcn_mfma_f32_32x32x16_bf16(a, v1, o1, 0, 0, 0);
                    }
#pragma unroll
                    for (int r = 0; r < 16; ++r) { const int t = 32 * tb + att::crow(r, hh); const size_t gr = row0 + t; const float bias = bia[r];
                        const int d = 128 * g + 64 * dp + r32;
                        const float u0 = bf1(uu0[r]), u1 = bf1(uu1[r]);
                        OCAT[gr * OC_W + OC_C + d] = (bf16_t)(cvt_pk_bf16(u0 * (o0[r] + bias), 0.f) & 0xffffu); OCAT[gr * OC_W + OC_C + d + 32] = (bf16_t)(cvt_pk_bf16(u1 * (o1[r] + bias), 0.f) & 0xffffu); }
                } else {
                    u -= MIX_FOX + MIX_DIL + MIX_SGU;
                    {
                        const int c = (tid & 63) * 8, rbase = 32 * u + 4 * (tid >> 6), t0 = rbase & (SEQ - 1);
                        const bf16_t* pr = PROJ + (size_t)rbase * DIN; u32x4 xa[6], gc[6], gb[4];
#pragma unroll
                        for (int k = 0; k < 6; ++k) { if (k >= 2 || t0 >= 2) { xa[k] = *(const u32x4*)(pr + (long)(k - 2) * DIN + PC_XB + c); gc[k] = *(const u32x4*)(pr + (long)(k - 2) * DIN + PC_GC + c); }
                                                      else { xa[k] = (u32x4){0u, 0u, 0u, 0u}; gc[k] = (u32x4){0u, 0u, 0u, 0u}; } }
#pragma unroll
                        for (int i = 0; i < 4; ++i) gb[i] = *(const u32x4*)(pr + (size_t)i * DIN + PC_GB + c);
                        const float* wk = scw + (size_t)L * 3 * 512 + c; float w0[8], w1[8], w2[8];
#pragma unroll
                        for (int e = 0; e < 8; ++e) { w0[e] = wk[e]; w1[e] = wk[512 + e]; w2[e] = wk[1024 + e]; }
                        float y[6][8];
#pragma unroll
                        for (int k = 0; k < 6; ++k) { const u32x4 a = xa[k], g2 = gc[k];
                            y[k][0] = bf_lo(a.x) * bf_lo(g2.x); y[k][1] = bf_hi(a.x) * bf_hi(g2.x); y[k][2] = bf_lo(a.y) * bf_lo(g2.y); y[k][3] = bf_hi(a.y) * bf_hi(g2.y);
                            y[k][4] = bf_lo(a.z) * bf_lo(g2.z); y[k][5] = bf_hi(a.z) * bf_hi(g2.z); y[k][6] = bf_lo(a.w) * bf_lo(g2.w); y[k][7] = bf_hi(a.w) * bf_hi(g2.w); }
#pragma unroll
                        for (int i = 0; i < 4; ++i) { const u32x4 g = gb[i]; const float gbf[8] = {bf_lo(g.x), bf_hi(g.x), bf_lo(g.y), bf_hi(g.y), bf_lo(g.z), bf_hi(g.z), bf_lo(g.w), bf_hi(g.w)}; float o[8];
#pragma unroll
                            for (int e = 0; e < 8; ++e) o[e] = gbf[e] * (w0[e] * y[i][e] + w1[e] * y[i + 1][e] + w2[e] * y[i + 2][e]);
                            u32x4 w; w.x = cvt_pk_bf16(o[0], o[1]); w.y = cvt_pk_bf16(o[2], o[3]); w.z = cvt_pk_bf16(o[4], o[5]); w.w = cvt_pk_bf16(o[6], o[7]);
                            *(u32x4*)(OCAT + (size_t)(rbase + i) * OC_W + OC_B + c) = w; }
                    }
                }
                qcur = qnext;
            }
            __syncthreads();
        }
#undef TR_RUN
#undef TR_DECODE
        SEAM(pb + 1);
        if (IN(pb + 2)) { WS_LOCAL();
            const int wave = opaque_i(wave0), tid = wave * 64 + lane_id_now(), lane = tid & 63, gw = bx * 8 + wave; (void)lane; (void)gw;
            if (G * 512 * 2 == M * 4 * 8) {
                const int gt = bx * 512 + tid, NT = G * 512;
                float l2[2][3]; f32x4 da[2][3], db[2][3]; float fm0[2], fl0[2], fm1[2], fl1[2]; f32x4 fa0[2], fa1[2], fb0[2], fb1[2];
#pragma unroll
                for (int q = 0; q < 2; ++q) { const int i = gt + q * NT, d8 = i & 7, slot = (i >> 3) & 3, row = i >> 5;
#pragma unroll
                    for (int g = 0; g < 3; ++g) { l2[q][g] = LSE[((size_t)g * M + row) * 4 + slot]; const float* od = ODIL + ((size_t)g * M + row) * 256 + slot * 64 + d8 * 8; da[q][g] = *(const f32x4*)od; db[q][g] = *(const f32x4*)(od + 4); }
                    const int h = (i >> 3) & 7, rr = i >> 6;
                    fm0[q] = FML[((size_t)rr * 8 + h) * 2]; fl0[q] = FML[((size_t)rr * 8 + h) * 2 + 1]; fm1[q] = FML[((size_t)(4096 + rr) * 8 + h) * 2]; fl1[q] = FML[((size_t)(4096 + rr) * 8 + h) * 2 + 1];
                    const float* p0 = FOP + ((size_t)rr * 8 + h) * 64 + d8 * 8; const float* p1 = FOP + ((size_t)(4096 + rr) * 8 + h) * 64 + d8 * 8;
                    fa0[q] = *(const f32x4*)p0; fa1[q] = *(const f32x4*)(p0 + 4); fb0[q] = *(const f32x4*)p1; fb1[q] = *(const f32x4*)(p1 + 4); }
#pragma unroll
                for (int q = 0; q < 2; ++q) { const int i = gt + q * NT, d8 = i & 7, slot = (i >> 3) & 3, row = i >> 5;
                    const float mx = fmaxf(fmaxf(l2[q][0], l2[q][1]), l2[q][2]); float wsum = 0.f; f32x4 oa = {0.f, 0.f, 0.f, 0.f}, ob = {0.f, 0.f, 0.f, 0.f};
#pragma unroll
                    for (int g = 0; g < 3; ++g) { const float w = fast_exp2(l2[q][g] - mx); wsum += w; oa = oa + da[q][g] * w; ob = ob + db[q][g] * w; }
                    const float inv = 1.0f / wsum; u32x4 w; w.x = cvt_pk_bf16(oa.x * inv, oa.y * inv); w.y = cvt_pk_bf16(oa.z * inv, oa.w * inv); w.z = cvt_pk_bf16(ob.x * inv, ob.y * inv); w.w = cvt_pk_bf16(ob.z * inv, ob.w * inv);
                    *(u32x4*)(OCAT + (size_t)row * OC_W + OC_D + slot * 64 + d8 * 8) = w;
                    const int h = (i >> 3) & 7, rr = i >> 6, b = rr >> 11, t = 2048 + (rr & 2047);
                    const float mm = fmaxf(fm0[q], fm1[q]), w0 = fast_exp2(fm0[q] - mm), w1 = fast_exp2(fm1[q] - mm), inv2 = 1.0f / (w0 * fl0[q] + w1 * fl1[q]);
                    const f32x4 o0 = (fa0[q] * w0 + fb0[q] * w1) * inv2, o1 = (fa1[q] * w0 + fb1[q] * w1) * inv2;
                    u32x4 w2; w2.x = cvt_pk_bf16(o0.x, o0.y); w2.y = cvt_pk_bf16(o0.z, o0.w); w2.z = cvt_pk_bf16(o1.x, o1.y); w2.w = cvt_pk_bf16(o1.z, o1.w);
                    *(u32x4*)(OCAT + ((size_t)b * SEQ + t) * OC_W + OC_A + h * 64 + d8 * 8) = w2; }
            } else {
            for (int i = bx * 512 + tid; i < M * 4 * 8; i += G * 512) { const int d8 = i & 7, slot = (i >> 3) & 3, row = i >> 5;
                float l2[3], mx = -3.0e38f;
#pragma unroll
                for (int g = 0; g < 3; ++g) { l2[g] = LSE[((size_t)g * M + row) * 4 + slot]; mx = fmaxf(mx, l2[g]); }
                float wsum = 0.f, o[8];
#pragma unroll
                for (int e = 0; e < 8; ++e) o[e] = 0.f;
#pragma unroll
                for (int g = 0; g < 3; ++g) { const float w = fast_exp2(l2[g] - mx); wsum += w; const float* od = ODIL + ((size_t)g * M + row) * 256 + slot * 64 + d8 * 8;
                    const f32x4 a = *(const f32x4*)od, b = *(const f32x4*)(od + 4); o[0] += w * a.x; o[1] += w * a.y; o[2] += w * a.z; o[3] += w * a.w; o[4] += w * b.x; o[5] += w * b.y; o[6] += w * b.z; o[7] += w * b.w; }
                const float inv = 1.0f / wsum; u32x4 w; w.x = cvt_pk_bf16(o[0] * inv, o[1] * inv); w.y = cvt_pk_bf16(o[2] * inv, o[3] * inv); w.z = cvt_pk_bf16(o[4] * inv, o[5] * inv); w.w = cvt_pk_bf16(o[6] * inv, o[7] * inv);
                *(u32x4*)(OCAT + (size_t)row * OC_W + OC_D + slot * 64 + d8 * 8) = w; }
            for (int i = bx * 512 + tid; i < 4096 * 8 * 8; i += G * 512) {
                const int d8 = i & 7, h = (i >> 3) & 7, rr = i >> 6; const int b = rr >> 11, t = 2048 + (rr & 2047);
                const float m0 = FML[((size_t)rr * 8 + h) * 2], l0 = FML[((size_t)rr * 8 + h) * 2 + 1], m1 = FML[((size_t)(4096 + rr) * 8 + h) * 2], l1 = FML[((size_t)(4096 + rr) * 8 + h) * 2 + 1];
                const float mm = fmaxf(m0, m1), w0 = fast_exp2(m0 - mm), w1 = fast_exp2(m1 - mm), inv = 1.0f / (w0 * l0 + w1 * l1);
                const float* p0 = FOP + ((size_t)rr * 8 + h) * 64 + d8 * 8; const float* p1 = FOP + ((size_t)(4096 + rr) * 8 + h) * 64 + d8 * 8;
                const f32x4 a0 = *(const f32x4*)p0, a1 = *(const f32x4*)(p0 + 4), b0 = *(const f32x4*)p1, b1 = *(const f32x4*)(p1 + 4);
                const f32x4 o0 = (a0 * w0 + b0 * w1) * inv, o1 = (a1 * w0 + b1 * w1) * inv;
                u32x4 w; w.x = cvt_pk_bf16(o0.x, o0.y); w.y = cvt_pk_bf16(o0.z, o0.w); w.z = cvt_pk_bf16(o1.x, o1.y); w.w = cvt_pk_bf16(o1.z, o1.w);
                *(u32x4*)(OCAT + ((size_t)b * SEQ + t) * OC_W + OC_A + h * 64 + d8 * 8) = w; }
            }
            {
                pg8::Gemm g2{PB + (size_t)L * M * PLE, (const bf16_t*)(wl + WL_PE), M, DM, opaque_i(PLE)};   pg8::StaticOrder S2; S2.init(M, DM, G, bx);
                pg8::EpiPlain E2{PP + (size_t)L * M * DM, DM};
                __syncthreads();
                pg8::gemm_phase(lds, g2, S2, E2, pg8::NoHook{}, MK_TID());
            }
        }
        SEAM(pb + 2);
        if (IN(pb + 3)) { WS_LOCAL();
            pg8::Gemm g{OCAT, (const bf16_t*)(wl + WL_BR), M, DM, OC_W}; pg8::StaticOrder S; S.init(M, DM, G, bx);
            pg8::EpiMerge E{MG, DM, G8 + 3 * 2048}; pg8::MergeHook H{G8};
            pg8::gemm_phase(lds, g, S, E, H, MK_TID());
        }
        SEAM(pb + 3);
        if (IN(pb + 4)) { WS_LOCAL();
            pg8::Gemm g{MG, (const bf16_t*)(wl + WL_OUT), M, DM, DM}; pg8::StaticOrder S; S.init(M, DM, G, bx);
            pg8::EpiResidN E{XR, nullptr};
            pg8::gemm_phase(lds, g, S, E, pg8::NoHook{}, MK_TID());
        }
        SEAM(pb + 4);
        if (IN(pb + 5)) { WS_LOCAL();
            const int wave = opaque_i(wave0), tid = wave * 64 + lane_id_now(), lane = tid & 63, gw = bx * 8 + wave; (void)lane; (void)gw;
            norm_phase<false, false, true>(nullptr, XR, nullptr, nullptr, XN8, AS8, norm_ffn_g + L * DM, nullptr, nullptr, nullptr, nullptr, nullptr, lds, gw, NGW, lane, tid);
        }
        SEAM(pb + 5);
        if (IN(pb + 6)) { WS_LOCAL();
            pg8::Gemm g{(const bf16_t*)XN8, (const bf16_t*)(wl + WL_UP), M, 2 * DFF, opaque_i(DM / 2)}; pg8::UpOrder S; S.init(M, G, bx);
            pg8::EpiUp8 E{UP, 2 * DFF, AS8, QSC + 2 * L + 1, UPB, 1024, 40 * 256};
            pg8::gemm_phase<pg8::EpiUp8, pg8::NoHook, pg8::UpOrder, true>(lds, g, S, E, pg8::NoHook{}, MK_TID());
        }
        SEAM(pb + 6);
        if (IN(pb + 7)) { WS_LOCAL();
            const int wave = opaque_i(wave0), tid = wave * 64 + lane_id_now(), lane = tid & 63, gw = bx * 8 + wave; (void)lane; (void)gw;
            const float* cw = ffn_cw + (size_t)L * 3 * 2 * DFF;
            for (int item = bx * 512 + tid; item < 1024 * 704; item += G * 512) { const int rb = item / 704, c = (item % 704) * 8, row0 = rb * 8, t0 = row0 & (SEQ - 1);
                u32x4 gq[10], vq[10];
#pragma unroll
                for (int r = 0; r < 10; ++r) { if (r >= 2 || t0 >= 2) { const bf16_t* pr = UP + (size_t)(row0 + r - 2) * 2 * DFF + c; gq[r] = *(const u32x4*)pr; vq[r] = *(const u32x4*)(pr + DFF); }
                                               else { gq[r] = (u32x4){0u, 0u, 0u, 0u}; vq[r] = (u32x4){0u, 0u, 0u, 0u}; } }
                if (c >= 4608) {
#pragma unroll
                    for (int r = 0; r < 10; ++r) { if (r >= 2 || t0 >= 2) { const u32x4 b2 = *(const u32x4*)(UPB + (size_t)(row0 + r - 2) * 1024 + (c - 4608)); u32x4 s;
#pragma unroll
                            for (int e = 0; e < 4; ++e) s[e] = cvt_pk_bf16(bf_lo(vq[r][e]) + bf_lo(b2[e]), bf_hi(vq[r][e]) + bf_hi(b2[e]));
                            vq[r] = s; } } }
                float rq[10];
#pragma unroll
                for (int r = 0; r < 10; ++r) rq[r] = 1.0f;
                float wg[3][8], wv[3][8];
#pragma unroll
                for (int k = 0; k < 3; ++k) { const f32x4 a = *(const f32x4*)(cw + k * 2 * DFF + c), b = *(const f32x4*)(cw + k * 2 * DFF + c + 4), d = *(const f32x4*)(cw + k * 2 * DFF + DFF + c), e2 = *(const f32x4*)(cw + k * 2 * DFF + DFF + c + 4);
                    wg[k][0] = a.x; wg[k][1] = a.y; wg[k][2] = a.z; wg[k][3] = a.w; wg[k][4] = b.x; wg[k][5] = b.y; wg[k][6] = b.z; wg[k][7] = b.w;
                    wv[k][0] = d.x; wv[k][1] = d.y; wv[k][2] = d.z; wv[k][3] = d.w; wv[k][4] = e2.x; wv[k][5] = e2.y; wv[k][6] = e2.z; wv[k][7] = e2.w; }
#pragma unroll
                for (int r = 0; r < 8; ++r) { const u32x4 g0 = gq[r], g1 = gq[r + 1], g2 = gq[r + 2], v0 = vq[r], v1 = vq[r + 1], v2 = vq[r + 2];
                    float o[8];
#pragma unroll
                    for (int e = 0; e < 4; ++e) {
                        const float q0 = rq[r], q1 = rq[r + 1], q2 = rq[r + 2];
                        const float ga = wg[0][2 * e] * q0 * bf_lo(g0[e]) + wg[1][2 * e] * q1 * bf_lo(g1[e]) + wg[2][2 * e] * q2 * bf_lo(g2[e]), gb2 = wg[0][2 * e + 1] * q0 * bf_hi(g0[e]) + wg[1][2 * e + 1] * q1 * bf_hi(g1[e]) + wg[2][2 * e + 1] * q2 * bf_hi(g2[e]);
                        const float va = wv[0][2 * e] * q0 * bf_lo(v0[e]) + wv[1][2 * e] * q1 * bf_lo(v1[e]) + wv[2][2 * e] * q2 * bf_lo(v2[e]), vb = wv[0][2 * e + 1] * q0 * bf_hi(v0[e]) + wv[1][2 * e + 1] * q1 * bf_hi(v1[e]) + wv[2][2 * e + 1] * q2 * bf_hi(v2[e]);
                        o[2 * e] = ga * sigmoid_f(ga) * va; o[2 * e + 1] = gb2 * sigmoid_f(gb2) * vb; }
                    u32x4 w; w.x = cvt_pk_bf16(o[0], o[1]); w.y = cvt_pk_bf16(o[2], o[3]); w.z = cvt_pk_bf16(o[4], o[5]); w.w = cvt_pk_bf16(o[6], o[7]);
                    *(u32x4*)(HID + (size_t)(row0 + r) * DFF + c) = w; }
            }
        }
        SEAM(pb + 7);
        if (IN(pb + 8)) { WS_LOCAL();
            pg8::Gemm g{HID, (const bf16_t*)(wl + WL_DN), M, DM, DFF}; pg8::StaticOrder S; S.init(M, DM, G, bx);
            pg8::EpiResidN E{XR, SSQ + (size_t)M * 32};
            pg8::gemm_phase(lds, g, S, E, pg8::NoHook{}, MK_TID());
        }
        SEAM(pb + 8);
        if (IN(pb + 9)) { WS_LOCAL();
            pg8::Gemm g{XR, (const bf16_t*)(wl + WL_PG), M, DM, DM}; pg8::StaticOrder S; S.init(M, DM, G, bx);
            pg8::EpiPle E{XR, XRN, PP + (size_t)L * M * DM, SSQ + (size_t)M * 32};
            pg8::gemm_phase(lds, g, S, E, pg8::NoHook{}, MK_TID());
        }
        SEAM(pb + 9);
        if (IN(pb + 10)) { WS_LOCAL();
            const int wave = opaque_i(wave0), tid = wave * 64 + lane_id_now(), lane = tid & 63, gw = bx * 8 + wave; (void)lane; (void)gw;
            if (L + 1 < DEPTH) norm_phase<true, false, true>(nullptr, XRN, nullptr, RSC, XN8, AS8, norm_mix_g + (L + 1) * DM, WFG + (size_t)(L + 1) * 8 * DM, fox_b + (L + 1) * 8, LOGF, nullptr, nullptr, lds, gw, NGW, lane, tid);
            else norm_phase<false, true, true>(nullptr, XRN, nullptr, nullptr, nullptr, nullptr, nullptr, nullptr, nullptr, nullptr, final_g, X, lds, gw, NGW, lane, tid);
        }
        SEAM(pb + 10);
    }
#undef IN
#undef SEAM
#undef MK_TID
}
#undef x_in
#undef p_in
#undef pos_in
#undef norm_mix_g
#undef w_in
#undef fox_b
#undef scw
#undef sgu_g
#undef sgu_w
#undef sgu_b
#undef w_br_fox
#undef w_br_conv
#undef w_br_sgu
#undef w_br_dil
#undef w_out
#undef norm_ffn_g
#undef w_up
#undef ffn_cw
#undef w_down
#undef norm_ple_g
#undef w_pg
#undef w_pe
#undef final_g
#undef WFG
#undef SGUW
#undef ROPE
#undef LOGF
#undef FL
#undef LSE
#undef SSQ
#undef RSC
#undef FOP
#undef FML
#undef UPB
#undef G8
#undef XN8
#undef AS8
#undef QSC
#undef XR
#undef XRN
#undef PB
#undef PP
#undef XN
#undef PROJ
#undef UP
#undef HID
#undef OCAT
#undef MG
#undef ODIL
#undef WS_LOCAL
#undef wl

extern "C" void kernel_launch(void* const* d_in, const int* in_sizes, int n_in, void* d_out, int out_size, void* d_ws, size_t ws_size, hipStream_t stream) {
    static int grid = 0;
    if (grid == 0) {
        if (n_in != 23 || in_sizes[0] != M * DM || out_size != M * DM || ws_size < WS_END) { fprintf(stderr, "kernel_launch: unexpected shapes/workspace (n_in %d, ws %zu < %zu)\n", n_in, ws_size, (size_t)WS_END); grid = -1; return; }
        int dev = 0, cus = 0, per_cu = 0;
        if (hipGetDevice(&dev) != hipSuccess || hipDeviceGetAttribute(&cus, hipDeviceAttributeMultiprocessorCount, dev) != hipSuccess) { grid = -1; return; }
        if (hipFuncSetAttribute((const void*)mk_fwd, hipFuncAttributeMaxDynamicSharedMemorySize, LDS_BYTES) != hipSuccess) { fprintf(stderr, "kernel_launch: hipFuncSetAttribute failed\n"); grid = -1; return; }
        if (hipOccupancyMaxActiveBlocksPerMultiprocessor(&per_cu, (const void*)mk_fwd, 512, LDS_BYTES) != hipSuccess || per_cu < 1) fprintf(stderr, "kernel_launch: occupancy query says %d\n", per_cu);
        (void)hipGetLastError();
        grid = cus;
    }
    if (grid < 0) return;
    if (hipMemsetAsync((char*)d_ws + WS_CTL, 0, CTL_BYTES, stream) != hipSuccess) return;
    Args a{};
    for (int i = 0; i < 23; ++i) a.in[i] = (const float*)d_in[i];
    a.out = (float*)d_out; a.ws = (unsigned char*)d_ws; a.pad = 0;
    const int step = (MK_SPLIT > 0) ? MK_SPLIT : NPHASE;
    int li = 0;
    for (int lo = 0; lo < NPHASE; lo += step, ++li) {
        a.ph_lo = lo; a.ph_hi = (lo + step < NPHASE) ? lo + step : NPHASE; a.li = li;
        hipLaunchKernelGGL(mk_fwd, dim3(grid), dim3(512), LDS_BYTES, stream, a);
        if (hipPeekAtLastError() != hipSuccess) { fprintf(stderr, "kernel_launch: launch %d failed\n", li); break; }
    }
}
```

```cpp
#include <hip/hip_runtime.h>
#include <cstdio>
#include <cstdint>

#ifndef PROBE_PH
#define PROBE_PH -1
#endif
#ifndef MIX_PROBE
#define MIX_PROBE 0
#endif
#ifndef MK_SPLIT
#define MK_SPLIT 0
#endif

#define LAS __attribute__((address_space(3)))
#define GAS __attribute__((address_space(1)))
typedef unsigned short bf16_t;
typedef short bf16x8 __attribute__((ext_vector_type(8)));
typedef short s16x4 __attribute__((ext_vector_type(4)));
typedef float f32x2 __attribute__((ext_vector_type(2)));
typedef float f32x4 __attribute__((ext_vector_type(4)));
typedef float f32x16 __attribute__((ext_vector_type(16)));
typedef unsigned u32x2 __attribute__((ext_vector_type(2)));
typedef unsigned u32x4 __attribute__((ext_vector_type(4)));
typedef int v4i __attribute__((ext_vector_type(4)));


constexpr int NB = 2, SEQ = 4096, DM = 2048, DEPTH = 4, M = NB * SEQ;
constexpr int DIN_SRC = 14600, DIN = 14592;
constexpr int DFF = 5632, PLE = 256;
constexpr float EPS = 1e-6f;
constexpr float LOG2E = 1.4426950408889634f;
constexpr float C2 = 0.125f * LOG2E;
constexpr float WQ_MAX = 0.126f, WQ_INV = 127.0f / WQ_MAX, WQ_S = WQ_MAX / 127.0f;
constexpr int PC_AQ = 0, PC_AK = 512, PC_AV = 1024, PC_XB = 1536, PC_GB = 2048, PC_GC = 2560, PC_SU = 3072, PC_SV = 3584,
              PC_DQ = 4096, PC_DK = 4864, PC_DV = 5632, PC_G = 6400;
constexpr unsigned I8MASK = (3u << 4) | (7u << 22);
constexpr int N8T = __builtin_popcount(I8MASK), NBT = 25 - N8T, N8N = 8192 + N8T * 256;
constexpr int PB_EXTRA = (NBT * 32) % 256, I8_UNITS = (32 + N8T) * 32, I8_X = (I8_UNITS - (PB_EXTRA ? 2 * (256 - PB_EXTRA) : 0)) / 256;
constexpr int I8_INPHASE = I8_X * 256 + (PB_EXTRA ? 2 * (256 - PB_EXTRA) : 0), MIX_GEMM = I8_UNITS - I8_INPHASE;
__host__ __device__ __forceinline__ int nth_set(unsigned m, int k) { for (int i = 0; i < k; ++i) m &= m - 1u; return __builtin_ctz(m); }
constexpr int OC_W = 1792;
constexpr int OC_A = 0, OC_B = 512, OC_C = 1024, OC_D = 1536;

constexpr size_t MiB = 1u << 20;
constexpr size_t WS_CTL = 0, CTL_BYTES = (MK_SPLIT > 0) ? 2 * MiB : 64 * 1024;
constexpr size_t WS_WL = 2 * MiB;
constexpr size_t WL_IN = 0, WL_G8W = 32 * MiB  , WL_BR = 57 * MiB, WL_OUT = 64 * MiB, WL_UP = 72 * MiB, WL_DN = 116 * MiB, WL_PG = 138 * MiB, WL_PE = 146 * MiB, WL_STRIDE = 147 * MiB;
constexpr size_t WS_SMALL = WS_WL + 4 * WL_STRIDE;
constexpr size_t SM_WFG = 0, SM_SGUW = 256 * 1024, SM_ROPE = 768 * 1024, SM_LOGF = 1280 * 1024, SM_FL = 1536 * 1024, SM_LSE = 1792 * 1024, SM_SS = 2304 * 1024;
constexpr size_t WS_PB = WS_SMALL + 4 * MiB;
constexpr size_t WS_PP = WS_PB + 16 * MiB;
constexpr size_t WS_XN = WS_PP + 128 * MiB;
constexpr size_t WS_PROJ = WS_XN + 32 * MiB;
constexpr size_t WS_HID = WS_PROJ + 228 * MiB;
constexpr size_t WS_OCAT = WS_HID + 88 * MiB;
constexpr size_t WS_MG = WS_OCAT + 28 * MiB;
constexpr size_t WS_ODIL = WS_MG + 32 * MiB;
constexpr size_t WS_PART = WS_ODIL + 24 * MiB;
constexpr size_t WS_FOP = WS_PART + 2 * MiB;
constexpr size_t WS_FML = WS_FOP + 16 * MiB;
constexpr size_t WS_UPB = WS_FML + 1 * MiB;
constexpr size_t WS_XR = WS_UPB + 16 * MiB;
constexpr size_t WS_G8 = WS_XR + 64 * MiB;
constexpr size_t WS_XN8 = WS_G8 + 64 * MiB;
constexpr size_t WS_END = WS_XN8 + 16 * MiB;
constexpr int CW_BAR = 4096;
constexpr int CW_Q = 1024;

constexpr int LDS_BYTES = 147456;
constexpr int RING_BYTES = 131072;
constexpr int MISC_OFF = RING_BYTES + 320;

#define LDS_WAIT() asm volatile("s_waitcnt lgkmcnt(0)" ::: "memory")
#define VM_WAIT() asm volatile("s_waitcnt vmcnt(0)" ::: "memory")
#define BAR_L() asm volatile("s_waitcnt lgkmcnt(0)\n\ts_barrier" ::: "memory")
typedef __bf16 bf16x2_t __attribute__((ext_vector_type(2)));
__device__ __forceinline__ unsigned cvt_pk_bf16(float lo, float hi) { f32x2 v = {lo, hi}; bf16x2_t b = __builtin_convertvector(v, bf16x2_t); return __builtin_bit_cast(unsigned, b); }
__device__ __forceinline__ float ub0(unsigned u) { return (float)(u & 0xffu); }
__device__ __forceinline__ float ub1(unsigned u) { return (float)((u >> 8) & 0xffu); }
__device__ __forceinline__ float ub2(unsigned u) { return (float)((u >> 16) & 0xffu); }
__device__ __forceinline__ float ub3(unsigned u) { return (float)(u >> 24); }
__device__ __forceinline__ float bf_lo(unsigned u) { return __uint_as_float(u << 16); }
__device__ __forceinline__ float bf_hi(unsigned u) { return __uint_as_float(u & 0xffff0000u); }
__device__ __forceinline__ float bf1(bf16_t u) { return __uint_as_float(((unsigned)u) << 16); }
__device__ __forceinline__ float shx(float v, int mask, int lane) { return __int_as_float(__builtin_amdgcn_ds_bpermute((lane ^ mask) << 2, __float_as_int(v))); }
__device__ __forceinline__ unsigned shxu(unsigned v, int mask, int lane) { return (unsigned)__builtin_amdgcn_ds_bpermute((lane ^ mask) << 2, (int)v); }
__device__ __forceinline__ unsigned q8x4(float a, float b, float c, float d) {
    unsigned w = 0u;
    w = __builtin_amdgcn_cvt_pk_u8_f32(fminf(fmaxf(__builtin_rintf(a), -127.f), 127.f) + 128.f, 0, w); w = __builtin_amdgcn_cvt_pk_u8_f32(fminf(fmaxf(__builtin_rintf(b), -127.f), 127.f) + 128.f, 1, w);
    w = __builtin_amdgcn_cvt_pk_u8_f32(fminf(fmaxf(__builtin_rintf(c), -127.f), 127.f) + 128.f, 2, w); w = __builtin_amdgcn_cvt_pk_u8_f32(fminf(fmaxf(__builtin_rintf(d), -127.f), 127.f) + 128.f, 3, w);
    return w ^ 0x80808080u;
}
__device__ __forceinline__ float wave_max(float v, int lane) {
#pragma unroll
    for (int o = 1; o < 64; o <<= 1) v = fmaxf(v, shx(v, o, lane));
    return v;
}
__device__ __forceinline__ float wave_sum(float v, int lane) {
#pragma unroll
    for (int o = 1; o < 64; o <<= 1) v += shx(v, o, lane);
    return v;
}
__device__ __forceinline__ float fast_exp2(float x) { return __builtin_amdgcn_exp2f(x); }
__device__ __forceinline__ float fast_rcp(float x) { return __builtin_amdgcn_rcpf(x); }
__device__ __forceinline__ float sigmoid_f(float x) { return fast_rcp(1.0f + fast_exp2(-LOG2E * x)); }
__device__ __forceinline__ float gelu_tanh_f(float x) {
    const float z = 0.7978845608028654f * (x + 0.044715f * x * x * x);
    return x * fast_rcp(1.0f + fast_exp2(-2.0f * LOG2E * z));
}

namespace pg8 {
#define PG8_LAS __attribute__((address_space(3)))
constexpr int BM = 256, BK = 64, HALF = 128, HTB = HALF * BK * 2, STAGE_BYTES = 8 * HTB, NXCD = 8, WGM = 4;
__host__ __device__ __forceinline__ int lds_byte(int r, int c) { const int st = (r >> 4) * 2 + (c >> 5), rr = r & 15, cc = c & 31, ob = rr * 64 + cc * 2; return st * 1024 + (ob ^ (((ob >> 9) & 1) << 5)); }
__host__ __device__ __forceinline__ void stage_rc(int b, int& R, int& C) { const int st = b / 1024, sb = b % 1024, swz = sb ^ (((sb >> 9) & 1) << 5); R = (st >> 1) * 16 + swz / 64; C = (st & 1) * 32 + (swz % 64) / 2; }
__host__ __device__ __forceinline__ int perm32(int rho) { const int n = rho >> 4, i = rho & 15; return 8 * (i >> 2) + 4 * n + (i & 3); }
struct Unit { int pm, pn, kq; };
struct Gemm { const bf16_t* A; const bf16_t* Bt; int M, N, K; };
struct StaticOrder {
    int nM, nN, nwg, G, c;
    __host__ __device__ __forceinline__ void init(int M_, int N_, int G_, int c_) { nM = M_ / BM; nN = N_ / BM; nwg = nM * nN; G = G_; c = c_; }
    __host__ __device__ __forceinline__ bool next(int i, Unit& u) const { return map((long)i * G + c, u); }
    __host__ __device__ __forceinline__ bool map(long L, Unit& u) const {
        if (L >= nwg) return false;
        int wgid = (int)L; { const int q = nwg / NXCD, r = nwg % NXCD, xcd = wgid % NXCD, off = wgid / NXCD; wgid = (xcd < r ? xcd * (q + 1) : r * (q + 1) + (xcd - r) * q) + off; }
        const int nig = WGM * nN, gid = wgid / nig, fm = gid * WGM, gsz = (nM - fm) < WGM ? (nM - fm) : WGM;
        u.pm = fm + ((wgid % nig) % gsz); u.pn = (wgid % nig) / gsz; u.kq = 0; return true;
    }
    __device__ __forceinline__ void a_ready(const Unit&) const {}
    __device__ __forceinline__ void done(const Unit&) const {}
    __device__ __forceinline__ int nt(const Unit&, int K) const { return K / BK; }
    __device__ __forceinline__ size_t koff(const Unit&, int) const { return 0; }
};
struct OneUnit {
    int pm, pn;
    __device__ __forceinline__ bool next(int i, Unit& u) const { if (i != 0) return false; u.pm = pm; u.pn = pn; u.kq = 0; return true; }
    __device__ __forceinline__ void a_ready(const Unit&) const {}
    __device__ __forceinline__ void done(const Unit&) const {}
    __device__ __forceinline__ int nt(const Unit&, int K) const { return K / BK; }
    __device__ __forceinline__ size_t koff(const Unit&, int) const { return 0; }
};
struct ProjOrder {
    StaticOrder so;
    __device__ __forceinline__ void init(int M_, int N_, int G_, int c_) { so.init(M_, N_, G_, c_); }
    __device__ __forceinline__ bool next(int i, Unit& u) const { if (!so.next(i, u)) return false; u.pn = nth_set(~I8MASK & 0x1ffffffu, u.pn); return true; }
    __device__ __forceinline__ void a_ready(const Unit&) const {}
    __device__ __forceinline__ void done(const Unit&) const {}
    __device__ __forceinline__ int nt(const Unit&, int K) const { return K / BK; }
    __device__ __forceinline__ size_t koff(const Unit&, int) const { return 0; }
};
struct Gate8Order {
    StaticOrder so; int c;
    __device__ __forceinline__ void init(int M_, int N_, int G_, int c_) { so.init(M_, N_, G_, c_); c = c_; }
    __device__ __forceinline__ bool next(int i, Unit& u) const {
        if (so.G != 256) return so.next(i, u);
        long L;
        if (i < I8_X) L = (long)i * 256 + c;
        else if (PB_EXTRA && i < I8_X + 2) { if (c < PB_EXTRA) return false; L = I8_X * 256 + (long)(i - I8_X) * (256 - PB_EXTRA) + (c - PB_EXTRA); }
        else return false;
        return so.map(L, u);
    }
    __device__ __forceinline__ void a_ready(const Unit&) const {}
    __device__ __forceinline__ void done(const Unit&) const {}
    __device__ __forceinline__ int nt(const Unit&, int K) const { return K / BK; }
    __device__ __forceinline__ size_t koff(const Unit&, int) const { return 0; }
};
struct UpOrder {
    StaticOrder so; int G, c;
    __device__ __forceinline__ void init(int M_, int G_, int c_) { so.init(M_, 40 * BM, G_, c_); G = G_; c = c_; }
    __device__ __forceinline__ bool next(int i, Unit& u) const {
        if (so.next(i, u)) return true;
        const long L = (long)i * G + c - so.nwg; if (L < 0 || L >= 256) return false;
        const int tt = (int)L >> 1; u.pm = tt & 31; u.pn = 40 + (tt >> 5); u.kq = 1 + ((int)L & 1); return true;
    }
    __device__ __forceinline__ void a_ready(const Unit&) const {}
    __device__ __forceinline__ void done(const Unit&) const {}
    __device__ __forceinline__ int nt(const Unit& u, int K) const { return u.kq ? K / (2 * BK) : K / BK; }
    __device__ __forceinline__ size_t koff(const Unit& u, int K) const { return u.kq == 2 ? (size_t)K : 0; }
};
typedef f32x4 Acc[2][2][4][2];

template <int MODE> __device__ __forceinline__ void store_tile_bf16(const Acc& acc, bf16_t* O, int ldc, int row0, int col0) {
#pragma unroll
    for (int ai = 0; ai < 2; ++ai)
#pragma unroll
        for (int m = 0; m < 4; ++m) { bf16_t* rowp = O + (size_t)(row0 + ai * HALF + m * 16) * ldc + col0;
#pragma unroll
            for (int bj = 0; bj < 2; ++bj) { f32x4 v0 = acc[ai][bj][m][0], v1 = acc[ai][bj][m][1];
                if (MODE == 1) { v0 = v0 * C2; v1 = v1 * C2; }
                if (MODE == 2) {
#pragma unroll
                    for (int e = 0; e < 4; ++e) { v0[e] = gelu_tanh_f(v0[e]); v1[e] = gelu_tanh_f(v1[e]); } }
                if (MODE == 3) {
#pragma unroll
                    for (int e = 0; e < 4; ++e) { v0[e] = sigmoid_f(v0[e]); v1[e] = sigmoid_f(v1[e]); } }
                u32x4 w; w.x = cvt_pk_bf16(v0[0], v0[1]); w.y = cvt_pk_bf16(v0[2], v0[3]); w.z = cvt_pk_bf16(v1[0], v1[1]); w.w = cvt_pk_bf16(v1[2], v1[3]);
                *(u32x4*)(rowp + bj * HALF) = w; } }
}
struct NoHook { static constexpr bool ON = false; __device__ __forceinline__ void operator()(Acc&, const Unit&, int, int, int, int, int) const {} };
struct EpiPlain {
    static constexpr bool PERM = true, AFTER_DRAIN = false;
    bf16_t* O; int ldc;
    __device__ __forceinline__ void operator()(Acc& acc, const Unit& u, int wr, int wc, int fr, int fq) const {
        store_tile_bf16<0>(acc, O, ldc, u.pm * BM + wr * 64 + fr, u.pn * BM + wc * 32 + 8 * fq); }
};
struct EpiProj {
    static constexpr bool PERM = true, AFTER_DRAIN = false;
    bf16_t* O; int ldc; unsigned char* G; const float* RS;
    __device__ __forceinline__ void operator()(Acc& acc, const Unit& u, int wr, int wc, int fr, int fq) const {
        const int pn = u.pn, row0 = u.pm * BM + wr * 64 + fr, col0 = pn * BM + wc * 32 + 8 * fq;
#pragma unroll
        for (int ai = 0; ai < 2; ++ai)
#pragma unroll
            for (int m = 0; m < 4; ++m) { const float sc = RS[row0 + ai * HALF + m * 16];
#pragma unroll
                for (int bj = 0; bj < 2; ++bj) { acc[ai][bj][m][0] = acc[ai][bj][m][0] * sc; acc[ai][bj][m][1] = acc[ai][bj][m][1] * sc; } }
        if (pn < 2 || (pn >= 16 && pn < 19)) store_tile_bf16<1>(acc, O, ldc, row0, col0);
        else if (pn >= 12 && pn < 16) store_tile_bf16<2>(acc, O, ldc, row0, col0);
        else if (pn >= 25) {
            const int gc0 = col0 - PC_G;
#pragma unroll
            for (int ai = 0; ai < 2; ++ai)
#pragma unroll
                for (int m = 0; m < 4; ++m) { unsigned char* rowp = G + (size_t)(row0 + ai * HALF + m * 16) * 8192 + gc0;
#pragma unroll
                    for (int bj = 0; bj < 2; ++bj) { u32x2 w = {0u, 0u};
#pragma unroll
                        for (int e = 0; e < 4; ++e) { w.x = __builtin_amdgcn_cvt_pk_u8_f32(fmaxf(255.0f * sigmoid_f(acc[ai][bj][m][0][e]) + 0.5f, 1.0f), e, w.x);
                                                      w.y = __builtin_amdgcn_cvt_pk_u8_f32(fmaxf(255.0f * sigmoid_f(acc[ai][bj][m][1][e]) + 0.5f, 1.0f), e, w.y); }
                        *(u32x2*)(rowp + bj * HALF) = w; } }
        }
        else store_tile_bf16<0>(acc, O, ldc, row0, col0);
    }
};
__device__ __forceinline__ void row_scales(float (&rs)[2][4], const float* PART, int row0, int fr, int fq) {
    const int ln = fq * 16 + fr;
#pragma unroll
    for (int ai = 0; ai < 2; ++ai)
#pragma unroll
        for (int m = 0; m < 4; ++m) { const float* p = PART + (size_t)(row0 + ai * HALF + m * 16) * 32 + 8 * fq; const f32x4 a = *(const f32x4*)p, b = *(const f32x4*)(p + 4);
            float s = ((a.x + a.y) + (a.z + a.w)) + ((b.x + b.y) + (b.z + b.w)); s += shx(s, 16, ln); s += shx(s, 32, ln);
            rs[ai][m] = 1.0f / sqrtf(s * (1.0f / DM) + EPS); }
}
struct EpiUp8 {
    static constexpr bool PERM = true, AFTER_DRAIN = false;
    bf16_t* O; int ldc; const float* AS; const float* WS1; bf16_t* O2; int ldc2, c2;
    __device__ __forceinline__ void operator()(Acc& acc, const Unit& u, int wr, int wc, int fr, int fq) const {
        const int row0 = u.pm * BM + wr * 64 + fr; const float wqs = *WS1;
#pragma unroll
        for (int ai = 0; ai < 2; ++ai)
#pragma unroll
            for (int m = 0; m < 4; ++m) { const float sc = AS[row0 + ai * HALF + m * 16] * wqs;
#pragma unroll
                for (int bj = 0; bj < 2; ++bj)
#pragma unroll
                    for (int n = 0; n < 2; ++n) { const v4i a = __builtin_bit_cast(v4i, acc[ai][bj][m][n]); acc[ai][bj][m][n] = (f32x4){(float)a[0], (float)a[1], (float)a[2], (float)a[3]} * sc; } }
        if (u.kq == 2) store_tile_bf16<0>(acc, O2, ldc2, row0, u.pn * BM - c2 + wc * 32 + 8 * fq);
        else store_tile_bf16<0>(acc, O, ldc, row0, u.pn * BM + wc * 32 + 8 * fq); }
};
struct EpiGate8 {
    static constexpr bool PERM = true, AFTER_DRAIN = false;
    unsigned char* G; const float* AS; const float* WS1; bf16_t* O; int ldc;
    __device__ __forceinline__ void operator()(Acc& acc, const Unit& u, int wr, int wc, int fr, int fq) const {
        const int row0 = u.pm * BM + wr * 64 + fr; const float wqs = *WS1;
        if (u.pn < N8T) {
#pragma unroll
            for (int ai = 0; ai < 2; ++ai)
#pragma unroll
                for (int m = 0; m < 4; ++m) { const float sc = AS[row0 + ai * HALF + m * 16] * wqs;
#pragma unroll
                    for (int bj = 0; bj < 2; ++bj)
#pragma unroll
                        for (int n = 0; n < 2; ++n) { const v4i a = __builtin_bit_cast(v4i, acc[ai][bj][m][n]); acc[ai][bj][m][n] = (f32x4){(float)a[0], (float)a[1], (float)a[2], (float)a[3]} * sc; } }
            const int pt = nth_set(I8MASK, u.pn), col0 = pt * BM + wc * 32 + 8 * fq;
            if (pt < 2 || (pt >= 16 && pt < 19)) store_tile_bf16<1>(acc, O, ldc, row0, col0);
            else if (pt >= 12 && pt < 16) store_tile_bf16<2>(acc, O, ldc, row0, col0);
            else store_tile_bf16<0>(acc, O, ldc, row0, col0);
            return;
        }
        const int gc0 = (u.pn - N8T) * BM + wc * 32 + 8 * fq;
        float as8[2][4];
#pragma unroll
        for (int ai = 0; ai < 2; ++ai)
#pragma unroll
            for (int m = 0; m < 4; ++m) as8[ai][m] = AS[row0 + ai * HALF + m * 16];
#pragma unroll
        for (int ai = 0; ai < 2; ++ai)
#pragma unroll
            for (int m = 0; m < 4; ++m) { unsigned char* rowp = G + (size_t)(row0 + ai * HALF + m * 16) * 8192 + gc0; const float sc = -LOG2E * as8[ai][m] * wqs;
#pragma unroll
                for (int bj = 0; bj < 2; ++bj) { u32x2 w = {0u, 0u}; const v4i a0 = __builtin_bit_cast(v4i, acc[ai][bj][m][0]), a1 = __builtin_bit_cast(v4i, acc[ai][bj][m][1]);
#pragma unroll
                    for (int e = 0; e < 4; ++e) { w.x = __builtin_amdgcn_cvt_pk_u8_f32(fmaxf(__builtin_fmaf(255.0f, fast_rcp(1.0f + fast_exp2(sc * (float)a0[e])), 0.5f), 1.0f), e, w.x);
                                                  w.y = __builtin_amdgcn_cvt_pk_u8_f32(fmaxf(__builtin_fmaf(255.0f, fast_rcp(1.0f + fast_exp2(sc * (float)a1[e])), 0.5f), 1.0f), e, w.y); }
                    *(u32x2*)(rowp + bj * HALF) = w; } }
    }
};
struct EpiResidN {
    static constexpr bool PERM = true, AFTER_DRAIN = false;
    bf16_t* XR; float* SS;
    __device__ __forceinline__ void operator()(Acc& acc, const Unit& u, int wr, int wc, int fr, int fq) const {
        const int row0 = u.pm * BM + wr * 64 + fr, col0 = u.pn * BM + wc * 32 + 8 * fq;
#pragma unroll
        for (int ai = 0; ai < 2; ++ai) { u32x4 b[4][2];
#pragma unroll
            for (int m = 0; m < 4; ++m)
#pragma unroll
                for (int bj = 0; bj < 2; ++bj) b[m][bj] = *(const u32x4*)(XR + (size_t)(row0 + ai * HALF + m * 16) * DM + col0 + bj * HALF);
#pragma unroll
            for (int m = 0; m < 4; ++m) { const int row = row0 + ai * HALF + m * 16; float ss = 0.f;
#pragma unroll
                for (int bj = 0; bj < 2; ++bj) { const u32x4 x = b[m][bj];
                    const f32x4 v0 = (f32x4){bf_lo(x.x), bf_hi(x.x), bf_lo(x.y), bf_hi(x.y)} + acc[ai][bj][m][0], v1 = (f32x4){bf_lo(x.z), bf_hi(x.z), bf_lo(x.w), bf_hi(x.w)} + acc[ai][bj][m][1];
                    u32x4 w; w.x = cvt_pk_bf16(v0[0], v0[1]); w.y = cvt_pk_bf16(v0[2], v0[3]); w.z = cvt_pk_bf16(v1[0], v1[1]); w.w = cvt_pk_bf16(v1[2], v1[3]);
                    *(u32x4*)(XR + (size_t)row * DM + col0 + bj * HALF) = w;
                    ss += (v0[0] * v0[0] + v0[1] * v0[1]) + (v0[2] * v0[2] + v0[3] * v0[3]) + (v1[0] * v1[0] + v1[1] * v1[1]) + (v1[2] * v1[2] + v1[3] * v1[3]); }
                if (SS) { const int ln = fq * 16 + fr; ss += shx(ss, 16, ln); ss += shx(ss, 32, ln);
                    if (fq == 0) SS[(size_t)row * 32 + 4 * u.pn + wc] = ss; } }
            asm volatile("" ::: "memory"); }
    }
};
struct EpiPle {
    static constexpr bool PERM = true, AFTER_DRAIN = false;
    const bf16_t* XR; bf16_t* XO; const bf16_t* PP; const float* SS;
    __device__ __forceinline__ void operator()(Acc& acc, const Unit& u, int wr, int wc, int fr, int fq) const {
        const int row0 = u.pm * BM + wr * 64 + fr, col0 = u.pn * BM + wc * 32 + 8 * fq; float rs[2][4]; row_scales(rs, SS, row0, fr, fq);
#pragma unroll
        for (int ai = 0; ai < 2; ++ai)
#pragma unroll
            for (int mp = 0; mp < 2; ++mp) { u32x4 b[2][2], pp[2][2];
#pragma unroll
                for (int mm = 0; mm < 2; ++mm)
#pragma unroll
                    for (int bj = 0; bj < 2; ++bj) { const size_t off = (size_t)(row0 + ai * HALF + (2 * mp + mm) * 16) * DM + col0 + bj * HALF; b[mm][bj] = *(const u32x4*)(XR + off); pp[mm][bj] = *(const u32x4*)(PP + off); }
#pragma unroll
                for (int mm = 0; mm < 2; ++mm) { const float r = rs[ai][2 * mp + mm];
#pragma unroll
                    for (int bj = 0; bj < 2; ++bj) { const size_t off = (size_t)(row0 + ai * HALF + (2 * mp + mm) * 16) * DM + col0 + bj * HALF; const u32x4 x = b[mm][bj], p = pp[mm][bj];
                        const f32x4 a0 = acc[ai][bj][2 * mp + mm][0] * r, a1 = acc[ai][bj][2 * mp + mm][1] * r; u32x4 w;
                        w.x = cvt_pk_bf16(bf_lo(x.x) + sigmoid_f(a0[0]) * bf_lo(p.x), bf_hi(x.x) + sigmoid_f(a0[1]) * bf_hi(p.x)); w.y = cvt_pk_bf16(bf_lo(x.y) + sigmoid_f(a0[2]) * bf_lo(p.y), bf_hi(x.y) + sigmoid_f(a0[3]) * bf_hi(p.y));
                        w.z = cvt_pk_bf16(bf_lo(x.z) + sigmoid_f(a1[0]) * bf_lo(p.z), bf_hi(x.z) + sigmoid_f(a1[1]) * bf_hi(p.z)); w.w = cvt_pk_bf16(bf_lo(x.w) + sigmoid_f(a1[2]) * bf_lo(p.w), bf_hi(x.w) + sigmoid_f(a1[3]) * bf_hi(p.w));
                        *(u32x4*)(XO + off) = w; } }
                asm volatile("" ::: "memory"); }
    }
};
struct MergeHook {
    static constexpr bool ON = true;
    const unsigned char* G;
    __device__ __forceinline__ void operator()(Acc& acc, const Unit& u, int t, int wr, int wc, int fr, int fq) const {
        const int j = (t >> 3) - 1;
        unsigned off0 = (unsigned)((u.pm * BM + wr * 64 + fr) * 8192 + u.pn * BM + wc * 32 + 8 * fq);
        asm volatile("" : "+v"(off0));
        const unsigned char* gj = G + j * 2048;
#pragma unroll
        for (int ai = 0; ai < 2; ++ai) {
#pragma unroll
            for (int m = 0; m < 4; ++m) { const unsigned char* gp = gj + (off0 + (unsigned)((ai * HALF + m * 16) * 8192));
#pragma unroll
                for (int bj = 0; bj < 2; ++bj) { const u32x2 a = *(const u32x2*)(gp + bj * HALF), b = *(const u32x2*)(gp + 2048 + bj * HALF);
                    f32x4 r0, r1;
                    r0[0] = ub0(a.x) * fast_rcp(ub0(b.x)); r0[1] = ub1(a.x) * fast_rcp(ub1(b.x));
                    r0[2] = ub2(a.x) * fast_rcp(ub2(b.x)); r0[3] = ub3(a.x) * fast_rcp(ub3(b.x));
                    r1[0] = ub0(a.y) * fast_rcp(ub0(b.y)); r1[1] = ub1(a.y) * fast_rcp(ub1(b.y));
                    r1[2] = ub2(a.y) * fast_rcp(ub2(b.y)); r1[3] = ub3(a.y) * fast_rcp(ub3(b.y));
                    acc[ai][bj][m][0] = acc[ai][bj][m][0] * r0; acc[ai][bj][m][1] = acc[ai][bj][m][1] * r1; } }
            }
    }
};
struct EpiMerge {
    static constexpr bool PERM = true, AFTER_DRAIN = false;
    bf16_t* O; int ldc; const unsigned char* G3;
    __device__ __forceinline__ void operator()(Acc& acc, const Unit& u, int wr, int wc, int fr, int fq) const {
        const int row0 = u.pm * BM + wr * 64 + fr, col0 = u.pn * BM + wc * 32 + 8 * fq; const float s = 1.0f / 255.0f;
#pragma unroll
        for (int ai = 0; ai < 2; ++ai) { u32x2 g[4][2];
#pragma unroll
            for (int m = 0; m < 4; ++m)
#pragma unroll
                for (int bj = 0; bj < 2; ++bj) g[m][bj] = *(const u32x2*)(G3 + (size_t)(row0 + ai * HALF + m * 16) * 8192 + col0 + bj * HALF);
#pragma unroll
            for (int m = 0; m < 4; ++m)
#pragma unroll
                for (int bj = 0; bj < 2; ++bj) { const u32x2 gg = g[m][bj]; const f32x4 v0 = acc[ai][bj][m][0] * s, v1 = acc[ai][bj][m][1] * s;
                    u32x4 w; w.x = cvt_pk_bf16(v0[0] * ub0(gg.x), v0[1] * ub1(gg.x)); w.y = cvt_pk_bf16(v0[2] * ub2(gg.x), v0[3] * ub3(gg.x));
                    w.z = cvt_pk_bf16(v1[0] * ub0(gg.y), v1[1] * ub1(gg.y)); w.w = cvt_pk_bf16(v1[2] * ub2(gg.y), v1[3] * ub3(gg.y));
                    *(u32x4*)(O + (size_t)(row0 + ai * HALF + m * 16) * ldc + col0 + bj * HALF) = w; }
            asm volatile("" ::: "memory"); }
    }
};

template <class Epi, class Hook, class Sched, bool I8 = false>
__device__ __forceinline__ void gemm_phase(PG8_LAS unsigned char* lds, const Gemm g, const Sched& S, const Epi& E, const Hook& H, int tid) {
    asm volatile("" : "+v"(tid));
    const int wid = __builtin_amdgcn_readfirstlane(tid >> 6), lane = tid & 63, wr = wid >> 2, wc = wid & 3, fr = lane & 15, fq = lane >> 4;
    const int K = g.K;
    unsigned voffA[2], voffB[2];
#pragma unroll
    for (int i = 0; i < 2; ++i) { int R, C; stage_rc(tid * 16 + i * 8192, R, C); const int Rb = Epi::PERM ? ((R & ~31) + perm32(R & 31)) : R;
        voffA[i] = (unsigned)(R * K + C) * 2u; voffB[i] = (unsigned)(Rb * K + C) * 2u; }
    const size_t kstep = (size_t)(BK * 2);
    const size_t hstep = (size_t)HALF * K * 2;
    const size_t tstep = 2 * hstep;
    const unsigned ldsw = (unsigned)wid * 1024u;
    const int aoff = lds_byte(wr * 64 + fr, fq * 8), boff = lds_byte(wc * 32 + fr, fq * 8);
#define PG8_SA(b, h) (((b) * 2 + (h)) * HTB)
#define PG8_SB(b, h) ((4 + (b) * 2 + (h)) * HTB)
#define PG8_STAGE(bufoff, gbase, voff) do { _Pragma("unroll") for (int _i = 0; _i < 2; ++_i) \
        __builtin_amdgcn_global_load_lds((const unsigned*)((const char*)(gbase) + (voff)[_i]), (PG8_LAS unsigned*)(lds + (bufoff) + ldsw + _i * 8192), 16, 0, 0); } while (0)
#define PG8_LDA(dst, b, h) do { _Pragma("unroll") for (int m = 0; m < 4; ++m) _Pragma("unroll") for (int k = 0; k < 2; ++k) dst[m][k] = *(const PG8_LAS bf16x8*)(lds + PG8_SA(b, h) + aoff + m * 2048 + k * 1024); } while (0)
#define PG8_LDB(dst, b, h) do { _Pragma("unroll") for (int n = 0; n < 2; ++n) _Pragma("unroll") for (int k = 0; k < 2; ++k) dst[n][k] = *(const PG8_LAS bf16x8*)(lds + PG8_SB(b, h) + boff + n * 2048 + k * 1024); } while (0)
#define PG8_MMA(ai, bj, At, Bt) do { __builtin_amdgcn_s_setprio(1); _Pragma("unroll") for (int m = 0; m < 4; ++m) _Pragma("unroll") for (int n = 0; n < 2; ++n) _Pragma("unroll") for (int k = 0; k < 2; ++k) { \
        if constexpr (I8) acc[ai][bj][m][n] = __builtin_bit_cast(f32x4, __builtin_amdgcn_mfma_i32_16x16x64_i8(__builtin_bit_cast(v4i, Bt[n][k]), __builtin_bit_cast(v4i, At[m][k]), __builtin_bit_cast(v4i, acc[ai][bj][m][n]), 0, 0, 0)); \
        else acc[ai][bj][m][n] = __builtin_amdgcn_mfma_f32_16x16x32_bf16(Bt[n][k], At[m][k], acc[ai][bj][m][n], 0, 0, 0); } \
        __builtin_amdgcn_s_setprio(0); } while (0)
#define PG8_WAIT_V(n) asm volatile("s_waitcnt vmcnt(" #n ")" ::: "memory")
#define PG8_WAIT_L(n) asm volatile("s_waitcnt lgkmcnt(" #n ")" ::: "memory")
#define PG8_BAR __builtin_amdgcn_s_barrier()
#define PG8_SCHED __builtin_amdgcn_sched_barrier(0)
    Unit cur, nxt; int ui = 0;
    if (!S.next(0, cur)) return;
    Acc acc;
#pragma unroll
    for (int a = 0; a < 2; ++a)
#pragma unroll
        for (int b = 0; b < 2; ++b)
#pragma unroll
            for (int m = 0; m < 4; ++m)
#pragma unroll
                for (int n = 0; n < 2; ++n) acc[a][b][m][n] = (f32x4){0.f, 0.f, 0.f, 0.f};
    bf16x8 At[4][2], B0[2][2], B1[2][2];
    int nt = S.nt(cur, K);
    const char* cA = (const char*)g.A + (size_t)cur.pm * tstep + S.koff(cur, K); const char* cB = (const char*)g.Bt + (size_t)cur.pn * tstep + S.koff(cur, K);
    S.a_ready(cur);
    PG8_STAGE(PG8_SB(0, 0), cB, voffB); PG8_STAGE(PG8_SB(0, 1), cB + hstep, voffB); PG8_STAGE(PG8_SA(0, 0), cA, voffA); PG8_STAGE(PG8_SA(0, 1), cA + hstep, voffA);
    if (wr == 1) PG8_BAR;
    PG8_WAIT_V(2); PG8_BAR;
    PG8_STAGE(PG8_SB(1, 0), cB + kstep, voffB); PG8_STAGE(PG8_SA(1, 0), cA + kstep, voffA); PG8_STAGE(PG8_SB(1, 1), cB + hstep + kstep, voffB);
    PG8_WAIT_V(6); PG8_BAR;
    for (;;) {
        const bool has_next = S.next(ui + 1, nxt);
        const char* nA = has_next ? (const char*)g.A + (size_t)nxt.pm * tstep + S.koff(nxt, K) : cA; const char* nB = has_next ? (const char*)g.Bt + (size_t)nxt.pn * tstep + S.koff(nxt, K) : cB;
        for (int t = 0; t < nt; t += 2) {
            if constexpr (Hook::ON) { if (t != 0 && (t & 7) == 0) H(acc, cur, t, wr, wc, fr, fq); }
            const bool last = (t == nt - 2);
            const char* a1 = cA + (size_t)(t + 1) * kstep;
            const char* a2 = last ? nA : cA + (size_t)(t + 2) * kstep; const char* b2 = last ? nB : cB + (size_t)(t + 2) * kstep;
            const char* a3 = a2 + kstep; const char* b3 = b2 + kstep;
            if (last && has_next) S.a_ready(nxt);
            PG8_LDB(B0, 0, 0); PG8_LDB(B1, 0, 1); PG8_SCHED; PG8_LDA(At, 0, 0); PG8_STAGE(PG8_SA(1, 1), a1 + hstep, voffA);
            PG8_WAIT_V(8); PG8_WAIT_L(0); PG8_BAR; PG8_MMA(0, 0, At, B0); PG8_MMA(0, 1, At, B1); PG8_BAR; PG8_SCHED;
            PG8_LDA(At, 0, 1); PG8_STAGE(PG8_SB(0, 0), b2, voffB); PG8_STAGE(PG8_SB(0, 1), b2 + hstep, voffB); PG8_STAGE(PG8_SA(0, 0), a2, voffA);
            PG8_WAIT_V(8); PG8_WAIT_L(0); PG8_BAR; PG8_MMA(1, 0, At, B0); PG8_MMA(1, 1, At, B1); PG8_BAR; PG8_SCHED;
            PG8_LDB(B0, 1, 0); PG8_LDB(B1, 1, 1); PG8_SCHED; PG8_LDA(At, 1, 0); PG8_STAGE(PG8_SA(0, 1), a2 + hstep, voffA);
            PG8_WAIT_V(8); PG8_WAIT_L(0); PG8_BAR; PG8_MMA(0, 0, At, B0); PG8_MMA(0, 1, At, B1); PG8_BAR; PG8_SCHED;
            PG8_LDA(At, 1, 1); PG8_STAGE(PG8_SB(1, 0), b3, voffB); PG8_STAGE(PG8_SB(1, 1), b3 + hstep, voffB); PG8_STAGE(PG8_SA(1, 0), a3, voffA);
            PG8_WAIT_V(8); PG8_WAIT_L(0); PG8_BAR; PG8_MMA(1, 0, At, B0); PG8_MMA(1, 1, At, B1); PG8_BAR; PG8_SCHED;
        }
        if (wr == 0) PG8_BAR;
        E(acc, cur, wr, wc, fr, fq); S.done(cur);
        if (!has_next) break;
#pragma unroll
        for (int a = 0; a < 2; ++a)
#pragma unroll
            for (int b = 0; b < 2; ++b)
#pragma unroll
                for (int m = 0; m < 4; ++m)
#pragma unroll
                    for (int n = 0; n < 2; ++n) acc[a][b][m][n] = (f32x4){0.f, 0.f, 0.f, 0.f};
        cur = nxt; cA = nA; cB = nB; ++ui; nt = S.nt(cur, K);
        if (wr == 1) PG8_BAR;
    }
    PG8_WAIT_V(0);
    PG8_BAR;
#undef PG8_SA
#undef PG8_SB
#undef PG8_STAGE
#undef PG8_LDA
#undef PG8_LDB
#undef PG8_MMA
#undef PG8_WAIT_V
#undef PG8_WAIT_L
#undef PG8_BAR
#undef PG8_SCHED
}
}

#define XB_TMO      128
#define XB_XCNT(j)  (256  + 64 * (j))
#define XB_XSUB(j)  (1280 + 64 * (j))
#define XB_XGEN(j)  (2304 + 64 * (j))
#define XB_TOP      3328
#define XB_TOPGEN   3392
#define XCD_BAR_WORDS 3456
#define XB_SPIN_CAP (1u << 18)
__device__ __forceinline__ unsigned xb_ld(unsigned* p)              { return __hip_atomic_load(p, __ATOMIC_RELAXED, __HIP_MEMORY_SCOPE_AGENT); }
__device__ __forceinline__ unsigned xb_add(unsigned* p, unsigned v) { return __hip_atomic_fetch_add(p, v, __ATOMIC_RELAXED, __HIP_MEMORY_SCOPE_AGENT); }
__device__ __forceinline__ unsigned xb_xcc_id() { return (unsigned)__builtin_amdgcn_s_getreg((3 << 11) | 20) & 0xFu; }
#define XB_SPIN(cond, bar) do { unsigned _sp = 0; while (cond) { __builtin_amdgcn_s_sleep(1); \
    if ((++_sp & 255u) == 0u) { if (xb_ld(&(bar)[XB_TMO])) break; if (_sp > XB_SPIN_CAP) { atomicAdd(&(bar)[XB_TMO], 1u); break; } } } } while (0)
struct XcdBarrier { unsigned* bar; unsigned x; volatile LAS unsigned* st; };
__device__ __forceinline__ XcdBarrier xcd_barrier_post(unsigned* bar, volatile LAS unsigned* st) {
    XcdBarrier b; b.bar = bar; b.x = xb_xcc_id(); b.st = st;
    if (threadIdx.x == 0) (void)xb_add(&bar[XB_XCNT(b.x)], 1u);
    return b;
}
__device__ __forceinline__ void xcd_barrier_complete(unsigned* bar, unsigned x, unsigned& nloc, unsigned& nx) {
    const unsigned G = gridDim.x * gridDim.y * gridDim.z;
    unsigned sum, cnt, mine, sp = 0u;
    for (;;) {
        sum = 0u; cnt = 0u; mine = 0u;
#pragma unroll
        for (unsigned j = 0; j < 16; ++j) { const unsigned c = xb_ld(&bar[XB_XCNT(j)]); sum += c; cnt += (c > 0u) ? 1u : 0u; mine = (j == x) ? c : mine; }
        if (sum == G) break;
        __builtin_amdgcn_s_sleep(1);
        if ((++sp & 255u) == 0u) { if (xb_ld(&bar[XB_TMO])) break; if (sp > XB_SPIN_CAP) { atomicAdd(&bar[XB_TMO], 1u); break; } }
    }
    nloc = mine > 0u ? mine : 1u; nx = cnt > 0u ? cnt : 1u;
}
__device__ __forceinline__ void xcd_barrier(const XcdBarrier& b) {
    asm volatile("s_waitcnt vmcnt(0)" ::: "memory");
    __syncthreads();
    if (threadIdx.x == 0) {
        unsigned* bar = b.bar;
        __builtin_amdgcn_s_waitcnt(0);
        unsigned nloc = b.st[0], nx = b.st[1];
        if (nloc == 0u) { xcd_barrier_complete(bar, b.x, nloc, nx); b.st[0] = nloc; b.st[1] = nx; }
        const unsigned old = xb_add(&bar[XB_XSUB(b.x)], 1u);
        const unsigned gen = old / nloc;
        if (old + 1u == (gen + 1u) * nloc) {
            __builtin_amdgcn_fence(__ATOMIC_RELEASE, "agent");
            asm volatile("s_waitcnt vmcnt(0)" ::: "memory");
            const unsigned og = xb_add(&bar[XB_TOP], 1u);
            const unsigned tg = og / nx;
            if (og + 1u == (tg + 1u) * nx) xb_add(&bar[XB_TOPGEN], 1u);
            else XB_SPIN(xb_ld(&bar[XB_TOPGEN]) == tg, bar);
            __builtin_amdgcn_fence(__ATOMIC_ACQUIRE, "agent");
            xb_add(&bar[XB_XGEN(b.x)], 1u);
            asm volatile("s_waitcnt vmcnt(0)" ::: "memory");
        } else {
            XB_SPIN(xb_ld(&bar[XB_XGEN(b.x)]) == gen, bar);
            __builtin_amdgcn_fence(__ATOMIC_ACQUIRE, "agent");
            asm volatile("s_waitcnt vmcnt(0)" ::: "memory");
        }
    }
    __syncthreads();
}

__device__ const float c_one[1] = {1.0f};
struct TrDesc { const float* W; const float* gk; bf16_t* WT; int ldw, scol0, ldt, drow0, dk0, kb, nb, f8; float qinv; };
__device__ __forceinline__ void tr_load(f32x4 (&v)[8], float (&g)[8], const TrDesc& d, int lane) {
    const float* p = d.W + (size_t)(64 * d.kb + (lane >> 3)) * d.ldw + d.scol0 + 32 * d.nb + 4 * (lane & 7);
    const GAS float* gp = d.gk ? (const GAS float*)d.gk + 64 * d.kb + (lane >> 3) : (const GAS float*)c_one; const int gs = d.gk ? 8 : 0;
#pragma unroll
    for (int i = 0; i < 8; ++i) v[i] = __builtin_nontemporal_load((const f32x4*)(p + (size_t)(8 * i) * d.ldw));
#pragma unroll
    for (int i = 0; i < 8; ++i) g[i] = gp[i * gs];
}
__device__ __forceinline__ void tr_store(const f32x4 (&v)[8], const float (&g)[8], const TrDesc& d, LAS float* scr, int lane) {
    const int kr = lane >> 3, q = lane & 7;
#pragma unroll
    for (int i = 0; i < 8; ++i) { LAS float* s = scr + (8 * i + kr) * 33 + 4 * q; s[0] = v[i].x * g[i]; s[1] = v[i].y * g[i]; s[2] = v[i].z * g[i]; s[3] = v[i].w * g[i]; }
    LDS_WAIT(); asm volatile("" ::: "memory");
    const int c = lane & 7;
#pragma unroll
    for (int j = 0; j < 4; ++j) { const int n = (lane >> 3) + 8 * j; const LAS float* s = scr + (8 * c) * 33 + n;
        u32x4 o; o.x = cvt_pk_bf16(s[0 * 33], s[1 * 33]); o.y = cvt_pk_bf16(s[2 * 33], s[3 * 33]); o.z = cvt_pk_bf16(s[4 * 33], s[5 * 33]); o.w = cvt_pk_bf16(s[6 * 33], s[7 * 33]);
        if (d.f8) { const float qv = d.qinv; u32x2 o8; o8.x = q8x4(qv * s[0 * 33], qv * s[1 * 33], qv * s[2 * 33], qv * s[3 * 33]); o8.y = q8x4(qv * s[4 * 33], qv * s[5 * 33], qv * s[6 * 33], qv * s[7 * 33]);
            __builtin_nontemporal_store(o8, (u32x2*)((unsigned char*)d.WT + (size_t)(d.drow0 + 32 * d.nb + n) * d.ldt + d.dk0 + 64 * d.kb + 8 * c)); }
        else __builtin_nontemporal_store(o, (u32x4*)(d.WT + (size_t)(d.drow0 + 32 * d.nb + n) * d.ldt + d.dk0 + 64 * d.kb + 8 * c)); }
    LDS_WAIT(); asm volatile("" ::: "memory");
}

struct Args { const float* in[23]; float* out; unsigned char* ws; int ph_lo, ph_hi, li, pad; };

template <bool FORGET, bool FINAL, bool INBF>
__device__ __forceinline__ void norm_phase(const float* X, const bf16_t* Xb, bf16_t* XN, float* RS, unsigned* XN8, float* AS8, const float* gq, const float* wfg, const float* fb, float* logf, const float* gfin, float* outf,
                                           LAS unsigned char* lds, int gw, int NGW, int lane, int tid) {
    const bool late_fill = FORGET && NGW * 4 <= M;
    if (FORGET) {
#pragma unroll
        for (int i = 0; i < 8; ++i) __builtin_amdgcn_global_load_lds((const unsigned*)(wfg + 4 * (tid + 512 * i)), (LAS unsigned*)(lds + ((tid & ~63) + 512 * i) * 16), 16, 0, 0);
        if (!late_fill) { VM_WAIT(); __syncthreads(); }
    }
    for (int m0 = gw * 4; m0 < M; m0 += NGW * 4) {
        f32x4 v[4][8]; float rr[4];
#pragma unroll
        for (int r = 0; r < 4; ++r) {
            if (INBF) { const GAS u32x4* xr = (const GAS u32x4*)(Xb + (size_t)(m0 + r) * DM) + lane;
#pragma unroll
                for (int jj = 0; jj < 4; ++jj) { const u32x4 w = xr[64 * jj]; v[r][2 * jj] = (f32x4){bf_lo(w.x), bf_hi(w.x), bf_lo(w.y), bf_hi(w.y)}; v[r][2 * jj + 1] = (f32x4){bf_lo(w.z), bf_hi(w.z), bf_lo(w.w), bf_hi(w.w)}; }
            } else { const GAS f32x4* xr = (const GAS f32x4*)(X + (size_t)(m0 + r) * DM) + lane;
#pragma unroll
                for (int j = 0; j < 8; ++j) v[r][j] = xr[64 * j]; } }
#define NQ(j) (INBF ? (128 * ((j) >> 1) + 2 * lane + ((j) & 1)) : (64 * (j) + lane))
        if (FORGET) { if (late_fill && m0 == gw * 4) { VM_WAIT(); __syncthreads(); } }
#pragma unroll
        for (int r = 0; r < 4; ++r) { float s = 0.f;
#pragma unroll
            for (int j = 0; j < 8; ++j) s += (v[r][j].x * v[r][j].x + v[r][j].y * v[r][j].y) + (v[r][j].z * v[r][j].z + v[r][j].w * v[r][j].w);
            rr[r] = 1.0f / sqrtf(wave_sum(s, lane) * (1.0f / DM) + EPS); }
        if (FINAL) {
            f32x4 gf4[8];
#pragma unroll
            for (int j = 0; j < 8; ++j) gf4[j] = ((const GAS f32x4*)gfin)[NQ(j)];
#pragma unroll
            for (int r = 0; r < 4; ++r) { GAS f32x4* o = (GAS f32x4*)(outf + (size_t)(m0 + r) * DM);
#pragma unroll
                for (int j = 0; j < 8; ++j) o[NQ(j)] = v[r][j] * rr[r] * gf4[j]; }
        } else {
            f32x4 gq4[8];
#pragma unroll
            for (int j = 0; j < 8; ++j) gq4[j] = ((const GAS f32x4*)gq)[NQ(j)];
#pragma unroll
            for (int r = 0; r < 4; ++r) { GAS u32x2* o = (GAS u32x2*)(XN + (size_t)(m0 + r) * DM); GAS unsigned* o8 = (GAS unsigned*)(XN8 + (size_t)(m0 + r) * (DM / 4));
                float mx = 0.f;
#pragma unroll
                for (int j = 0; j < 8; ++j) { const f32x4 y = v[r][j] * gq4[j]; mx = fmaxf(mx, fmaxf(fmaxf(fabsf(y.x), fabsf(y.y)), fmaxf(fabsf(y.z), fabsf(y.w)))); }
                mx = fmaxf(wave_max(mx, lane) * rr[r], 1e-20f); const float qi = rr[r] * 127.0f / mx;
                if (lane == 0) { AS8[m0 + r] = mx * (1.0f / 127.0f); if (RS) RS[m0 + r] = rr[r]; }
#pragma unroll
                for (int j = 0; j < 8; ++j) { if (XN) { const f32x4 t = v[r][j] * rr[r]; u32x2 w; w.x = cvt_pk_bf16(t.x, t.y); w.y = cvt_pk_bf16(t.z, t.w); o[NQ(j)] = w; }
                    const f32x4 y = v[r][j] * gq4[j] * qi; o8[NQ(j)] = q8x4(y.x, y.y, y.z, y.w); } }
        }
        if (FORGET) {
#pragma unroll 1
            for (int h = 0; h < 8; ++h) {
                float a0 = 0.f, a1 = 0.f, a2 = 0.f, a3 = 0.f;
#pragma unroll
                for (int j = 0; j < 8; ++j) { const f32x4 w = *((LAS f32x4*)lds + h * 512 + NQ(j));
                    a0 += (v[0][j].x * w.x + v[0][j].y * w.y) + (v[0][j].z * w.z + v[0][j].w * w.w);
                    a1 += (v[1][j].x * w.x + v[1][j].y * w.y) + (v[1][j].z * w.z + v[1][j].w * w.w);
                    a2 += (v[2][j].x * w.x + v[2][j].y * w.y) + (v[2][j].z * w.z + v[2][j].w * w.w);
                    a3 += (v[3][j].x * w.x + v[3][j].y * w.y) + (v[3][j].z * w.z + v[3][j].w * w.w); }
                a0 = wave_sum(a0, lane); a1 = wave_sum(a1, lane); a2 = wave_sum(a2, lane); a3 = wave_sum(a3, lane);
                const float bh = fb[h];
                const float z = (lane == 0 ? a0 * rr[0] : lane == 1 ? a1 * rr[1] : lane == 2 ? a2 * rr[2] : a3 * rr[3]) + bh;
                const float az = fabsf(z);
                const float ls = fminf(z, 0.f) - 0.6931471805599453f * __builtin_amdgcn_logf(1.0f + fast_exp2(-LOG2E * az));
                if (lane < 4) logf[(size_t)h * M + m0 + lane] = ls;
            }
        }
    }
#undef NQ
}

namespace att {
constexpr int LDS_K = 0, LDS_V = 8192, LDS_BUF = 16384, LDS_SV = 32768, LDS_WS = 65536, LDS_QW = 67584, LDS_FL = 69632;
constexpr float NEG = -1e30f;
__device__ __forceinline__ int crow(int r, int hi) { return (r & 3) + 8 * (r >> 2) + 4 * hi; }
__device__ __forceinline__ s16x4 vtr(const LAS unsigned char* p) { return __builtin_bit_cast(s16x4, __builtin_amdgcn_ds_read_tr16_b64_v4i16((LAS s16x4*)p)); }
__device__ __forceinline__ float max3f(float a, float b, float c) { float r; asm("v_max3_f32 %0, %1, %2, %3" : "=v"(r) : "v"(a), "v"(b), "v"(c)); return r; }
__device__ __forceinline__ float rowmax32(const f32x16& p0, const f32x16& p1) {
    float a = max3f(p0[0], p0[1], p1[0]), b = max3f(p0[2], p0[3], p1[1]); a = max3f(a, p1[2], p1[3]);
#pragma unroll
    for (int r = 4; r < 16; r += 4) { a = max3f(a, p0[r], p0[r + 1]); b = max3f(b, p0[r + 2], p0[r + 3]); a = max3f(a, p1[r], p1[r + 1]); b = max3f(b, p1[r + 2], p1[r + 3]); }
    return fmaxf(a, b);
}
struct AttnArgs {
    const bf16_t *Q, *K, *V; long rs;
    int q0, kbase, jlo, jhi;
    const float* Fl;
    const float* rope; long rrs;
    bf16_t* Ob; float* Of; long ors;
    float* lse; long lrs;
};
__device__ __forceinline__ u32x4 rope8(u32x4 x1, u32x4 x2, const f32x4 c0, const f32x4 c1, const f32x4 s0, const f32x4 s1, bool first) {
    float a[8], b[8], c[8], s[8], o[8];
    a[0] = bf_lo(x1.x); a[1] = bf_hi(x1.x); a[2] = bf_lo(x1.y); a[3] = bf_hi(x1.y); a[4] = bf_lo(x1.z); a[5] = bf_hi(x1.z); a[6] = bf_lo(x1.w); a[7] = bf_hi(x1.w);
    b[0] = bf_lo(x2.x); b[1] = bf_hi(x2.x); b[2] = bf_lo(x2.y); b[3] = bf_hi(x2.y); b[4] = bf_lo(x2.z); b[5] = bf_hi(x2.z); b[6] = bf_lo(x2.w); b[7] = bf_hi(x2.w);
#pragma unroll
    for (int e = 0; e < 4; ++e) { c[e] = c0[e]; c[4 + e] = c1[e]; s[e] = s0[e]; s[4 + e] = s1[e]; }
#pragma unroll
    for (int e = 0; e < 8; ++e) o[e] = first ? (a[e] * c[e] - b[e] * s[e]) : (a[e] * s[e] + b[e] * c[e]);
    u32x4 w; w.x = cvt_pk_bf16(o[0], o[1]); w.y = cvt_pk_bf16(o[2], o[3]); w.z = cvt_pk_bf16(o[4], o[5]); w.w = cvt_pk_bf16(o[6], o[7]); return w;
}
template <int MODE>
__device__ __forceinline__ void attn_unit(LAS unsigned char* lds, const AttnArgs& A, int tid) {
    asm volatile("" : "+v"(tid));
    const int lane = tid & 63, wv = __builtin_amdgcn_readfirstlane(tid >> 6), r32 = lane & 31, hi = lane >> 5;
    LAS float* wsf = (LAS float*)(lds + LDS_WS) + wv * 64;
    const int qi = A.q0 + 32 * wv + r32;
    bf16x8 qr[4];
    { const bf16_t* qrow = A.Q + (long)qi * A.rs;
#pragma unroll
      for (int d0 = 0; d0 < 4; ++d0) qr[d0] = *(const bf16x8*)(qrow + d0 * 16 + hi * 8); }
    const int krow = 8 * wv + (lane & 7), kch = lane >> 3, vrow = 8 * wv + (lane >> 3), vch = lane & 7;
    const int kdo = LDS_K + kch * 1024 + krow * 16, vdo = LDS_V + (vch >> 2) * 4096 + vrow * 64 + (vch & 3) * 16;
    u32x4 kreg, vreg; f32x4 rc0, rc1, rs0, rs1;
    rc0 = rc1 = rs0 = rs1 = (f32x4){0.f, 0.f, 0.f, 0.f};
#define ATT_LOAD(j) do { const long ks_ = (long)A.kbase + 64 * (j); \
        kreg = *(const u32x4*)(A.K + (ks_ + krow) * A.rs + kch * 8); vreg = *(const u32x4*)(A.V + (ks_ + vrow) * A.rs + vch * 8); \
        if (MODE == 1) { if (kch < 2) { const float* rp_ = A.rope + (ks_ + krow) * A.rrs; rc0 = *(const f32x4*)(rp_); rc1 = *(const f32x4*)(rp_ + 4); rs0 = *(const f32x4*)(rp_ + 8); rs1 = *(const f32x4*)(rp_ + 12); } } } while (0)
    ATT_LOAD(A.jhi - 1);
    if (MODE == 1) {
        const float* rp = A.rope + (long)qi * A.rrs;
        const f32x4 c0 = *(const f32x4*)(rp), c1 = *(const f32x4*)(rp + 4), s0 = *(const f32x4*)(rp + 8), s1 = *(const f32x4*)(rp + 12);
        const u32x4 me = __builtin_bit_cast(u32x4, qr[0]); u32x4 x1, x2;
#pragma unroll
        for (int e = 0; e < 4; ++e) { auto rr = __builtin_amdgcn_permlane32_swap(me[e], me[e], false, false); x1[e] = rr[0]; x2[e] = rr[1]; }
        qr[0] = __builtin_bit_cast(bf16x8, rope8(x1, x2, c0, c1, s0, s1, hi == 0));
    }
    const float flq = (MODE != 1) ? A.Fl[qi] : 0.f;
    float m = (MODE == 1) ? NEG : 0.f, l = 0.f; f32x16 o0, o1; bool first = true;
#pragma unroll
    for (int r = 0; r < 16; ++r) { o0[r] = 0.f; o1[r] = 0.f; }
    const int qw0 = A.q0 + 32 * wv;
    int wlo = A.jlo; const int whi = (qw0 + 31 - A.kbase) >> 6;
    if (MODE == 1) { const int f = (qw0 - 128 - A.kbase) >> 6; wlo = f > wlo ? f : wlo; }
    const int k0 = A.kbase + 64 * A.jlo;
    if (MODE != 1) {
        LAS f32x4* fl4 = (LAS f32x4*)(lds + LDS_FL); const int n4 = 16 * (A.jhi - A.jlo);
        for (int i = tid; i < n4; i += 512) fl4[i] = *(const f32x4*)(A.Fl + k0 + 4 * i);
    }
#define ATT_WRITE(buf) do { if (MODE == 1) { u32x4 oth; _Pragma("unroll") for (int e = 0; e < 4; ++e) oth[e] = shxu(kreg[e], 8, lane); \
            if (kch < 2) kreg = (kch == 0) ? rope8(kreg, oth, rc0, rc1, rs0, rs1, true) : rope8(oth, kreg, rc0, rc1, rs0, rs1, false); } \
        *(LAS u32x4*)(lds + (buf) * LDS_BUF + kdo) = kreg; *(LAS u32x4*)(lds + (buf) * LDS_BUF + vdo) = vreg; } while (0)
    const int nst = A.jhi - A.jlo;
    asm volatile("s_barrier" ::: "memory");
    ATT_WRITE(0);
    if (nst > 1) ATT_LOAD(A.jhi - 2);
    BAR_L();
    for (int st = 0; st < nst; ++st) {
        const int j = A.jhi - 1 - st, cur = st & 1;
        if (j >= wlo && j <= whi) {
            const int ks = A.kbase + 64 * j;
            const LAS unsigned char* tb = lds + cur * LDS_BUF;
            f32x16 p0, p1;
            const float fm = flq - m;
            if (MODE != 1) { const LAS float* fk = (const LAS float*)(lds + LDS_FL) + (ks - k0) + 4 * hi;
#pragma unroll
                for (int g4 = 0; g4 < 4; ++g4) { const f32x4 a = *(const LAS f32x4*)(fk + 8 * g4), b = *(const LAS f32x4*)(fk + 32 + 8 * g4);
#pragma unroll
                    for (int e = 0; e < 4; ++e) { p0[4 * g4 + e] = fm - a[e]; p1[4 * g4 + e] = fm - b[e]; } }
            } else {
#pragma unroll
                for (int r = 0; r < 16; ++r) { p0[r] = 0.f; p1[r] = 0.f; } }
            { const LAS unsigned char* kb = tb + LDS_K + hi * 1024 + r32 * 16;
#pragma unroll
              for (int d0 = 0; d0 < 4; ++d0) { const bf16x8 b0 = *(const LAS bf16x8*)(kb + d0 * 2048), b1 = *(const LAS bf16x8*)(kb + d0 * 2048 + 512);
                  p0 = __builtin_amdgcn_mfma_f32_32x32x16_bf16(b0, qr[d0], p0, 0, 0, 0); p1 = __builtin_amdgcn_mfma_f32_32x32x16_bf16(b1, qr[d0], p1, 0, 0, 0); } }
            if (MODE != 1) {
                if (ks + 63 > qw0) {
#pragma unroll
                    for (int r = 0; r < 16; ++r) { const int kv = ks + crow(r, hi); if (kv > qi) p0[r] = NEG; if (kv + 32 > qi) p1[r] = NEG; } }
            } else {
#pragma unroll
                for (int r = 0; r < 16; ++r) { const int d = qi - (ks + crow(r, hi)); if (d < 0 || d > 128) p0[r] = NEG; if (d - 32 < 0 || d - 32 > 128) p1[r] = NEG; }
            }
            asm volatile("s_nop 15\n\ts_nop 7" : "+v"(p0), "+v"(p1));
            float rm = rowmax32(p0, p1);
            { auto rr = __builtin_amdgcn_permlane32_swap(__float_as_uint(rm), __float_as_uint(rm), false, false); rm = fmaxf(__uint_as_float(rr[0]), __uint_as_float(rr[1])); }
            float f = 1.0f; bool resc;
            if (MODE != 1) {
                const float d = first ? rm : fmaxf(rm, 0.f);
                resc = first || (__builtin_amdgcn_ballot_w64(rm > 0.f) != 0ull);
                if (resc) { m += d;
#pragma unroll
                    for (int r = 0; r < 16; ++r) { p0[r] -= d; p1[r] -= d; }
                    if (!first) { f = fast_exp2(-d); l *= f; } else resc = false; }
            } else {
                const float mn = fmaxf(m, rm); f = fast_exp2(m - mn); m = mn; l *= f;
#pragma unroll
                for (int r = 0; r < 16; ++r) { p0[r] -= mn; p1[r] -= mn; }
                resc = __builtin_amdgcn_ballot_w64(f != 1.0f) != 0ull;
            }
            first = false;
#pragma unroll
            for (int r = 0; r < 16; ++r) p0[r] = fast_exp2(p0[r]);
#pragma unroll
            for (int r = 0; r < 16; ++r) p1[r] = fast_exp2(p1[r]);
            { float s0 = 0.f, s1 = 0.f, s2 = 0.f, s3 = 0.f;
#pragma unroll
              for (int r = 0; r < 16; r += 2) { s0 += p0[r]; s1 += p0[r + 1]; s2 += p1[r]; s3 += p1[r + 1]; }
              l += (s0 + s1) + (s2 + s3); }
            if (resc) {
                if (hi == 0) wsf[r32] = f;
                f32x4 fr[4];
#pragma unroll
                for (int g4 = 0; g4 < 4; ++g4) fr[g4] = *(const LAS f32x4*)(wsf + 8 * g4 + 4 * hi);
#pragma unroll
                for (int r = 0; r < 16; ++r) { o0[r] *= fr[r >> 2][r & 3]; o1[r] *= fr[r >> 2][r & 3]; }
            }
            u32x4 pw[4];
#pragma unroll
            for (int e = 0; e < 4; ++e) { pw[0][e] = cvt_pk_bf16(p0[2 * e], p0[2 * e + 1]); pw[1][e] = cvt_pk_bf16(p0[8 + 2 * e], p0[9 + 2 * e]);
                                          pw[2][e] = cvt_pk_bf16(p1[2 * e], p1[2 * e + 1]); pw[3][e] = cvt_pk_bf16(p1[8 + 2 * e], p1[9 + 2 * e]); }
            const LAS unsigned char* vp = tb + LDS_V + ((lane >> 4) & 1) * 32 + (lane & 3) * 8 + (4 * hi + ((lane & 15) >> 2)) * 64;
#pragma unroll
            for (int k4 = 0; k4 < 4; ++k4) {
                const s16x4 a0 = vtr(vp + k4 * 1024), a1 = vtr(vp + k4 * 1024 + 512), b0 = vtr(vp + 4096 + k4 * 1024), b1 = vtr(vp + 4096 + k4 * 1024 + 512);
                const bf16x8 v0 = (bf16x8){a0[0], a0[1], a0[2], a0[3], a1[0], a1[1], a1[2], a1[3]}, v1 = (bf16x8){b0[0], b0[1], b0[2], b0[3], b1[0], b1[1], b1[2], b1[3]};
                o0 = __builtin_amdgcn_mfma_f32_32x32x16_bf16(__builtin_bit_cast(bf16x8, pw[k4]), v0, o0, 0, 0, 0);
                o1 = __builtin_amdgcn_mfma_f32_32x32x16_bf16(__builtin_bit_cast(bf16x8, pw[k4]), v1, o1, 0, 0, 0);
            }
        }
        if (st + 1 < nst) { ATT_WRITE(cur ^ 1); if (st + 2 < nst) ATT_LOAD(j - 2); }
        BAR_L();
    }
#undef ATT_WRITE
#undef ATT_LOAD
    { auto rr = __builtin_amdgcn_permlane32_swap(__float_as_uint(l), __float_as_uint(l), false, false); l = __uint_as_float(rr[0]) + __uint_as_float(rr[1]); }
    if (hi == 0) wsf[r32] = (MODE == 2) ? 1.0f : 1.0f / l;
    f32x4 fr[4];
#pragma unroll
    for (int g4 = 0; g4 < 4; ++g4) fr[g4] = *(const LAS f32x4*)(wsf + 8 * g4 + 4 * hi);
#pragma unroll
    for (int r = 0; r < 16; ++r) { const long row = (long)(qw0 + crow(r, hi)) * A.ors; const float s = fr[r >> 2][r & 3];
        if (MODE == 0) { A.Ob[row + r32] = (bf16_t)(cvt_pk_bf16(o0[r] * s, 0.f) & 0xffffu); A.Ob[row + 32 + r32] = (bf16_t)(cvt_pk_bf16(o1[r] * s, 0.f) & 0xffffu); }
        else { A.Of[row + r32] = o0[r] * s; A.Of[row + 32 + r32] = o1[r] * s; } }
    if (MODE == 1) { if (hi == 0) A.lse[(long)qi * A.lrs] = m + log2f(l); }
    if (MODE == 2) { if (hi == 0) { A.lse[(long)qi * A.lrs] = m; A.lse[(long)qi * A.lrs + 1] = l; } }
}
}

constexpr int NPH_PRO = 2, NPH_LAYER = 11, NPHASE = NPH_PRO + DEPTH * NPH_LAYER;
constexpr int TR_ITEMS = 37632;
constexpr int MIX_TR = 588, MIX_TRI = 64;
constexpr int MIX_FOX = 384, MIX_DIL = 384, MIX_SGU = 256, MIX_CONV = 256, MIX_UNITS = MIX_GEMM + MIX_FOX + MIX_DIL + MIX_SGU + MIX_CONV;
__constant__ double c_rope_inv[8] = {1.0, 0.19392274474868576, 0.03760603093086393, 0.007292664737217109, 0.001414213562373095, 0.0002742481756762073, 5.318295896944988e-05, 1.031338537721246e-05};

__device__ __forceinline__ void sincos_d(double x, float& sn, float& cs) {
    const double q = rint(x * 0.63661977236758134308);
    const double r = (x - q * 1.57079632679489655800e+00) - q * 6.12323399573676603587e-17;
    const int qi = ((int)q) & 3;
    const double r2 = r * r;
    double s = r * (1.0 + r2 * (-1.0 / 6 + r2 * (1.0 / 120 + r2 * (-1.0 / 5040 + r2 * (1.0 / 362880 + r2 * (-1.0 / 39916800 + r2 * (1.0 / 6227020800.0)))))));
    double c = 1.0 + r2 * (-0.5 + r2 * (1.0 / 24 + r2 * (-1.0 / 720 + r2 * (1.0 / 40320 + r2 * (-1.0 / 3628800 + r2 * (1.0 / 479001600.0 + r2 * (-1.0 / 87178291200.0)))))));
    double so = (qi == 0) ? s : (qi == 1) ? c : (qi == 2) ? -s : -c;
    double co = (qi == 0) ? c : (qi == 1) ? -s : (qi == 2) ? -c : s;
    sn = (float)so; cs = (float)co;
}

__device__ __forceinline__ int opaque_i(int k) { asm volatile("" : "+s"(k)); return k; }
__device__ __forceinline__ int lane_id_now() { int l; asm volatile("v_mbcnt_lo_u32_b32 %0, -1, 0\n\tv_mbcnt_hi_u32_b32 %0, -1, %0" : "=v"(l)); return l; }
__global__ void __launch_bounds__(512, 2) mk_fwd(Args args) {
    extern __shared__ __attribute__((aligned(16))) unsigned char lds_raw[];
    LAS unsigned char* lds = (LAS unsigned char*)lds_raw;
    volatile LAS unsigned* MISC = (volatile LAS unsigned*)(lds + MISC_OFF);
    const int wave0 = __builtin_amdgcn_readfirstlane(threadIdx.x >> 6);
#define MK_TID() (wave0 * 64 + lane_id_now())
    const int G = gridDim.x, bx = blockIdx.x, NGW = G * 8;
#define WS_LOCAL() unsigned char* ws = args.ws; float* X = args.out; asm volatile("" : "+s"(ws), "+s"(X)); (void)X
    unsigned* ctl = (unsigned*)(args.ws + WS_CTL);
    for (int u = MK_TID(); u < (LDS_BYTES - RING_BYTES) / 4; u += 512) ((LAS unsigned*)(lds + RING_BYTES))[u] = 0u;
    __syncthreads();
    XcdBarrier bar = xcd_barrier_post(ctl + CW_BAR + args.li * XCD_BAR_WORDS, MISC + 8);
    const int lo = args.ph_lo, hi = args.ph_hi;
#define IN(k) (lo <= (k) && (k) < hi)
#if PROBE_PH >= 0
    if (threadIdx.x == 0) { const unsigned long long t_ = __builtin_amdgcn_s_memrealtime(); MISC[20] = (unsigned)t_; MISC[21] = (unsigned)(t_ >> 32); }
#define PROBE_SEL(k) ((PROBE_PH < 100) ? ((k) == PROBE_PH) : ((k) >= NPH_PRO && ((k) - NPH_PRO) % NPH_LAYER == PROBE_PH - 100))
#define SEAM(k) do { if (IN(k) && IN((k) + 1)) xcd_barrier(bar); if (threadIdx.x == 0) { const unsigned long long tn_ = __builtin_amdgcn_s_memrealtime(), tp_ = (unsigned long long)MISC[20] | ((unsigned long long)MISC[21] << 32), du_ = tn_ - tp_; \
        if (PROBE_SEL(k)) { while (__builtin_amdgcn_s_memrealtime() - tn_ < du_) __builtin_amdgcn_s_sleep(8); } } __syncthreads(); \
        if (threadIdx.x == 0) { const unsigned long long t_ = __builtin_amdgcn_s_memrealtime(); MISC[20] = (unsigned)t_; MISC[21] = (unsigned)(t_ >> 32); } } while (0)
#else
#define SEAM(k) do { if (IN(k) && IN((k) + 1)) xcd_barrier(bar); } while (0)
#endif
#define x_in (args.in[opaque_i(0)])
#define p_in (args.in[opaque_i(1)])
#define pos_in ((const int*)args.in[opaque_i(2)])
#define norm_mix_g (args.in[opaque_i(3)])
#define w_in (args.in[opaque_i(4)])
#define fox_b (args.in[opaque_i(5)])
#define scw (args.in[opaque_i(6)])
#define sgu_g (args.in[opaque_i(7)])
#define sgu_w (args.in[opaque_i(8)])
#define sgu_b (args.in[opaque_i(9)])
#define w_br_fox (args.in[opaque_i(10)])
#define w_br_conv (args.in[opaque_i(11)])
#define w_br_sgu (args.in[opaque_i(12)])
#define w_br_dil (args.in[opaque_i(13)])
#define w_out (args.in[opaque_i(14)])
#define norm_ffn_g (args.in[opaque_i(15)])
#define w_up (args.in[opaque_i(16)])
#define ffn_cw (args.in[opaque_i(17)])
#define w_down (args.in[opaque_i(18)])
#define norm_ple_g (args.in[opaque_i(19)])
#define w_pg (args.in[opaque_i(20)])
#define w_pe (args.in[opaque_i(21)])
#define final_g (args.in[opaque_i(22)])
#define WFG ((float*)(ws + WS_SMALL + SM_WFG))
#define SGUW ((bf16_t*)(ws + WS_SMALL + SM_SGUW))
#define ROPE ((float*)(ws + WS_SMALL + SM_ROPE))
#define LOGF ((float*)(ws + WS_SMALL + SM_LOGF))
#define FL ((float*)(ws + WS_SMALL + SM_FL))
#define LSE ((float*)(ws + WS_SMALL + SM_LSE))
#define SSQ ((float*)(ws + WS_PART))
#define RSC ((float*)(ws + WS_SMALL + SM_SS))
#define FOP ((float*)(ws + WS_FOP))
#define FML ((float*)(ws + WS_FML))
#define UPB ((bf16_t*)(ws + WS_UPB))
#define G8 ((unsigned char*)(ws + WS_G8))
#define XN8 ((unsigned*)(ws + WS_XN8))
#define AS8 ((float*)(ws + WS_SMALL + SM_SS + 65536))
#define QSC ((float*)(ws + WS_SMALL + SM_SS + 98304))
#define XR ((bf16_t*)(ws + WS_XR) + (size_t)(L & 1) * M * DM)
#define XRN ((bf16_t*)(ws + WS_XR) + (size_t)((L + 1) & 1) * M * DM)
#define PB ((bf16_t*)(ws + WS_PB))
#define PP ((bf16_t*)(ws + WS_PP))
#define XN ((bf16_t*)(ws + WS_XN))
#define PROJ ((bf16_t*)(ws + WS_PROJ))
#define UP ((bf16_t*)(ws + WS_PROJ))
#define HID ((bf16_t*)(ws + WS_HID))
#define OCAT ((bf16_t*)(ws + WS_OCAT))
#define MG ((bf16_t*)(ws + WS_MG))
#define ODIL ((float*)(ws + WS_ODIL))

    if (IN(0)) { WS_LOCAL();
        const int tid = MK_TID(), lane = tid & 63, wave = wave0, gw = bx * 8 + wave;
        LAS float* qsl = (LAS float*)(lds + RING_BYTES + 4096);
        { float sq[8];
#pragma unroll
          for (int mth = 0; mth < 8; ++mth) { const int Ls = mth >> 1; float a = 0.f;
              for (int j = 0; j < 16; ++j) { const int i = tid + 512 * j;
                  const float w = (mth & 1) ? w_up[(size_t)Ls * DM * 2 * DFF + i] : w_in[(size_t)Ls * DM * DIN_SRC + (size_t)(i >> 11) * DIN_SRC + 6408 + (i & 2047)];
                  a += w * w; }
              sq[mth] = wave_sum(a, lane); }
          if (lane == 0) {
#pragma unroll
              for (int mth = 0; mth < 8; ++mth) qsl[8 + wave * 8 + mth] = sq[mth]; }
          __syncthreads();
          if (tid < 8) { float t = 0.f; for (int w = 0; w < 8; ++w) t += qsl[8 + w * 8 + tid];
              const float rng = 4.0f * sqrtf(t * (1.0f / 8192.0f)) + 1e-30f; qsl[tid] = 127.0f / rng; if (bx == 0) QSC[tid] = rng * (1.0f / 127.0f); }
          __syncthreads(); }
        LAS float* scr = (LAS float*)(lds + wave * 16384);
#define TR_DECODE(d, it_) do { const int L_ = (it_) / TR_ITEMS; int r_ = (it_) % TR_ITEMS; unsigned char* wl_ = ws + WS_WL + (size_t)L_ * WL_STRIDE; const float* win_ = w_in + (size_t)L_ * DM * DIN_SRC; \
            if (r_ < 1536 + 13056) { const bool pa_ = r_ < 1536; if (!pa_) r_ -= 1536; \
                if (pa_) d = TrDesc{win_, norm_mix_g + L_ * DM, (bf16_t*)(wl_ + WL_IN), DIN_SRC, 0, DM, 0, 0, r_ / 48, r_ % 48, 0, 0.f}; \
                else d = TrDesc{win_, norm_mix_g + L_ * DM, (bf16_t*)(wl_ + WL_IN), DIN_SRC, 1544, DM, 1536, 0, r_ / 408, r_ % 408, 0, 0.f}; \
                const int pc_ = d.drow0 + 32 * d.nb, pt_ = pc_ >> 8;        \
                if (pc_ >= PC_G || ((I8MASK >> pt_) & 1u)) { d.WT = (bf16_t*)(wl_ + WL_G8W); d.f8 = 1; d.gk = nullptr; d.qinv = qsl[2 * L_]; \
                    d.drow0 += (pc_ >= PC_G) ? (N8T * 256 - PC_G) : (__builtin_popcount(I8MASK & ((1u << pt_) - 1u)) - pt_) * 256; } } \
            else if ((r_ -= 1536 + 13056) < 512) { d = TrDesc{w_br_fox + (size_t)L_ * 512 * DM, nullptr, (bf16_t*)(wl_ + WL_BR), DM, 0, OC_W, 0, OC_A, r_ / 64, r_ % 64, 0, 0.f}; } \
            else if ((r_ -= 512) < 512) { d = TrDesc{w_br_conv + (size_t)L_ * 512 * DM, nullptr, (bf16_t*)(wl_ + WL_BR), DM, 0, OC_W, 0, OC_B, r_ / 64, r_ % 64, 0, 0.f}; } \
            else if ((r_ -= 512) < 512) { d = TrDesc{w_br_sgu + (size_t)L_ * 512 * DM, nullptr, (bf16_t*)(wl_ + WL_BR), DM, 0, OC_W, 0, OC_C, r_ / 64, r_ % 64, 0, 0.f}; } \
            else if ((r_ -= 512) < 256) { d = TrDesc{w_br_dil + (size_t)L_ * 256 * DM, nullptr, (bf16_t*)(wl_ + WL_BR), DM, 0, OC_W, 0, OC_D, r_ / 64, r_ % 64, 0, 0.f}; } \
            else if ((r_ -= 256) < 2048) { d = TrDesc{w_out + (size_t)L_ * DM * DM, nullptr, (bf16_t*)(wl_ + WL_OUT), DM, 0, DM, 0, 0, r_ / 64, r_ % 64, 0, 0.f}; } \
            else if ((r_ -= 2048) < 11264) { d = TrDesc{w_up + (size_t)L_ * DM * 2 * DFF, nullptr, (bf16_t*)(wl_ + WL_UP), 2 * DFF, 0, DM, 0, 0, r_ / 352, r_ % 352, 1, qsl[2 * L_ + 1]}; }   \
            else if ((r_ -= 11264) < 5632) { d = TrDesc{w_down + (size_t)L_ * DFF * DM, nullptr, (bf16_t*)(wl_ + WL_DN), DM, 0, DFF, 0, 0, r_ / 64, r_ % 64, 0, 0.f}; } \
            else if ((r_ -= 5632) < 2048) { d = TrDesc{w_pg + (size_t)L_ * DM * DM, norm_ple_g + L_ * DM, (bf16_t*)(wl_ + WL_PG), DM, 0, DM, 0, 0, r_ / 64, r_ % 64, 0, 0.f}; } \
            else { r_ -= 2048; d = TrDesc{w_pe + (size_t)L_ * PLE * DM, nullptr, (bf16_t*)(wl_ + WL_PE), DM, 0, PLE, 0, 0, r_ / 64, r_ % 64, 0, 0.f}; } } while (0)
#define TR_RUN(it0_, end_, stride_) do { TrDesc d0, d1, d2, d3; f32x4 v0[8], v1[8], v2[8], v3[8]; float g0[8], g1[8], g2[8], g3[8]; int it = (it0_);     \
            for (; it + 3 * (stride_) < (end_); it += 4 * (stride_)) { TR_DECODE(d0, it); tr_load(v0, g0, d0, lane); TR_DECODE(d1, it + (stride_)); tr_load(v1, g1, d1, lane); TR_DECODE(d2, it + 2 * (stride_)); tr_load(v2, g2, d2, lane); \
                TR_DECODE(d3, it + 3 * (stride_)); tr_load(v3, g3, d3, lane); \
                tr_store(v0, g0, d0, scr, lane); tr_store(v1, g1, d1, scr, lane); tr_store(v2, g2, d2, scr, lane); tr_store(v3, g3, d3, scr, lane); } \
            for (; it < (end_); it += (stride_)) { TR_DECODE(d0, it); tr_load(v0, g0, d0, lane); tr_store(v0, g0, d0, scr, lane); } } while (0)
        TR_RUN(gw, TR_ITEMS, NGW);
        const int gt = bx * 512 + tid, NGT = G * 512;
        for (int i = gt; i < DEPTH * 8 * DM; i += NGT) { const int L = i / (8 * DM), h = (i / DM) % 8, k = i % DM;
            WFG[i] = norm_mix_g[L * DM + k] * w_in[(size_t)L * DM * DIN_SRC + (size_t)k * DIN_SRC + 1536 + h]; }
        for (int i = gt; i < DEPTH * 4 * 128 * 128; i += NGT) { const int t = (i >> 7) & 127, s = i & 127; SGUW[i] = (s <= t) ? (bf16_t)(cvt_pk_bf16(sgu_w[i], 0.f) & 0xffffu) : (bf16_t)0; }
        for (int i = gt; i < M * 8; i += NGT) { const int row = i >> 3, jj = i & 7; float sn, cs; sincos_d((double)pos_in[row] * c_rope_inv[jj], sn, cs); ROPE[row * 16 + jj] = cs; ROPE[row * 16 + 8 + jj] = sn; }
#define CVT_STREAM(src_, dst_, n_) do { const f32x4* s_ = (const f32x4*)(src_); u32x4* d_ = (u32x4*)(dst_); \
            for (int i = gt; i < (n_); i += 4 * NGT) { f32x4 a[4], b[4]; \
                _Pragma("unroll") for (int k = 0; k < 4; ++k) { const int ii = i + k * NGT; if (ii < (n_)) { a[k] = s_[2 * ii]; b[k] = s_[2 * ii + 1]; } else { a[k] = (f32x4){0.f, 0.f, 0.f, 0.f}; b[k] = a[k]; } } \
                _Pragma("unroll") for (int k = 0; k < 4; ++k) { const int ii = i + k * NGT; u32x4 w; w.x = cvt_pk_bf16(a[k].x, a[k].y); w.y = cvt_pk_bf16(a[k].z, a[k].w); w.z = cvt_pk_bf16(b[k].x, b[k].y); w.w = cvt_pk_bf16(b[k].z, b[k].w); \
                    if (ii < (n_)) d_[ii] = w; } } } while (0)
        CVT_STREAM(x_in, ws + WS_XR, M * DM / 8);
        CVT_STREAM(p_in, PB, DEPTH * M * PLE / 8);
#undef CVT_STREAM
    }
    SEAM(0);
    if (IN(1)) { WS_LOCAL();
        const int tid = MK_TID(), lane = tid & 63, gw = bx * 8 + wave0;
        norm_phase<true, false, false>(x_in, nullptr, nullptr, RSC, XN8, AS8, norm_mix_g, WFG, fox_b, LOGF, nullptr, nullptr, lds, gw, NGW, lane, tid);
    }
    SEAM(1);

    for (int L = 0; L < DEPTH; ++L) {
        const int pb = NPH_PRO + L * NPH_LAYER;
#define wl (ws + WS_WL + (size_t)L * WL_STRIDE)
        if (IN(pb + 0)) { WS_LOCAL();
            const int bxs = opaque_i(bx);
            if (bxs >= 32 && bxs < 48 && G >= 48) {
                const int wave = opaque_i(wave0), tid = wave * 64 + lane_id_now(), lane = tid & 63, gw = bx * 8 + wave; (void)lane; (void)gw;
                const int seq = bxs - 32, b = seq >> 3, h = seq & 7; float v[8], run = 0.f;
                { const f32x4 la = *(const f32x4*)(LOGF + (size_t)h * M + b * SEQ + tid * 8), lb = *(const f32x4*)(LOGF + (size_t)h * M + b * SEQ + tid * 8 + 4);
                  const float lv[8] = {la.x, la.y, la.z, la.w, lb.x, lb.y, lb.z, lb.w};
#pragma unroll
                  for (int e = 0; e < 8; ++e) { run += lv[e]; v[e] = run; } }
                float inc = run;
#pragma unroll
                for (int o = 1; o < 64; o <<= 1) { const float t = __int_as_float(__builtin_amdgcn_ds_bpermute(((lane - o) & 63) << 2, __float_as_int(inc))); if (lane >= o) inc += t; }
                LAS float* wt = (LAS float*)lds;
                if (lane == 63) wt[wave] = inc;
                __syncthreads();
                float base = inc - run;
                for (int w = 0; w < wave; ++w) base += wt[w];
#pragma unroll
                for (int e = 0; e < 8; ++e) FL[seq * SEQ + tid * 8 + e] = (base + v[e]) * LOG2E;
                __syncthreads();
            }
            pg8::Gemm g{XR, (const bf16_t*)(wl + WL_IN), M, NBT * 256, DM}; pg8::ProjOrder S; S.init(M, NBT * 256, G, bx);
            pg8::EpiProj E{PROJ, DIN, G8, RSC};
            pg8::gemm_phase(lds, g, S, E, pg8::NoHook{}, MK_TID());
            pg8::Gemm g8{(const bf16_t*)XN8, (const bf16_t*)(wl + WL_G8W), M, N8N, opaque_i(DM / 2)}; pg8::Gate8Order S8; S8.init(M, N8N, G, bx);
            pg8::EpiGate8 E8{G8, AS8, QSC + 2 * L, PROJ, DIN};
            pg8::gemm_phase<pg8::EpiGate8, pg8::NoHook, pg8::Gate8Order, true>(lds, g8, S8, E8, pg8::NoHook{}, MK_TID());
        }
        SEAM(pb + 0);
        if (IN(pb + 1)) { WS_LOCAL();
            unsigned* qhead = ctl + CW_Q + 64 * L;
            unsigned qcur = 0u;
            if (MK_TID() == 0) qcur = __hip_atomic_fetch_add(qhead, 1u, __ATOMIC_RELAXED, __HIP_MEMORY_SCOPE_AGENT);
            for (;;) {
                const int wave = opaque_i(wave0), tid = wave * 64 + lane_id_now(), lane = tid & 63; (void)lane;
                __syncthreads();
                if (tid == 0) *(volatile LAS unsigned*)(lds + att::LDS_QW) = qcur;
                __syncthreads();
                int u = (int)*(volatile LAS unsigned*)(lds + att::LDS_QW);
                const int nq_ = MIX_UNITS + ((L + 1 < DEPTH) ? MIX_TR : 0);
#if MIX_PROBE
                const int nx_ = MIX_PROBE == 1 ? MIX_FOX : MIX_PROBE == 2 ? MIX_DIL : MIX_PROBE == 3 ? MIX_SGU : MIX_PROBE == 4 ? MIX_CONV : ((L + 1 < DEPTH) ? MIX_TR : 0);
                if (u >= nq_ + nx_) break;
                const int ex_ = u - nq_;
#else
                if (u >= nq_) break;
#endif
                if (u < MIX_GEMM) {
                    pg8::StaticOrder so; so.init(M, N8N, 256, 0); pg8::Unit gu; so.map(I8_INPHASE + u, gu);
                    pg8::Gemm g8{(const bf16_t*)XN8, (const bf16_t*)(wl + WL_G8W), M, N8N, opaque_i(DM / 2)}; pg8::OneUnit S1{gu.pm, gu.pn}; pg8::EpiGate8 E8{G8, AS8, QSC + 2 * L, PROJ, DIN};
                    pg8::gemm_phase<pg8::EpiGate8, pg8::NoHook, pg8::OneUnit, true>(lds, g8, S1, E8, pg8::NoHook{}, MK_TID());
                    if (MK_TID() == 0) qcur = __hip_atomic_fetch_add(qhead, 1u, __ATOMIC_RELAXED, __HIP_MEMORY_SCOPE_AGENT);
                    continue;
                }
                u -= MIX_GEMM;
                unsigned qnext = 0u;
                if (tid == 0) qnext = __hip_atomic_fetch_add(qhead, 1u, __ATOMIC_RELAXED, __HIP_MEMORY_SCOPE_AGENT);
                int cu = -1;
                if (L + 1 < DEPTH) { const int k = u / 19, r = u - 19 * k; if (k < 98) { if (r < 13) u = 13 * k + r; else cu = 6 * k + r - 13; } else u -= MIX_TR; }
#if MIX_PROBE
                if (ex_ >= 0) { cu = -1; u = ex_ + (MIX_PROBE == 2 ? MIX_FOX : MIX_PROBE == 3 ? MIX_FOX + MIX_DIL : MIX_PROBE == 4 ? MIX_FOX + MIX_DIL + MIX_SGU : 0); if (MIX_PROBE == 5) cu = ex_; }
#endif
                if (cu >= 0) {
                    LAS float* scr = (LAS float*)(lds + wave * 8448); LAS float* qsl = (LAS float*)(lds + RING_BYTES + 4096);
                    const int b0 = (L + 1) * TR_ITEMS + cu * MIX_TRI;
                    TR_RUN(b0 + wave, b0 + MIX_TRI, 8);
                } else if (u < MIX_FOX) {
                    const bool split = u < 256; int qb, seg, bh;
                    if (split) { qb = 15 - (u >> 5); seg = (u >> 4) & 1; bh = u & 15; } else { const int v = u - 256; qb = 7 - (v >> 4); seg = 0; bh = v & 15; }
                    const int b = bh >> 3, h = bh & 7;
                    att::AttnArgs A; const size_t r0 = (size_t)b * SEQ * DIN;
                    A.Q = PROJ + r0 + PC_AQ + h * 64; A.K = PROJ + r0 + PC_AK + h * 64; A.V = PROJ + r0 + PC_AV + h * 64; A.rs = DIN;
                    A.q0 = qb * 256; A.kbase = 0; A.Fl = FL + bh * SEQ; A.rope = nullptr; A.rrs = 0;
                    if (split) {
                        A.jlo = seg ? 2 * (qb + 1) : 0; A.jhi = seg ? 4 * (qb + 1) : 2 * (qb + 1);
                        A.Ob = nullptr; A.Of = FOP + (((long)seg * 4096 + (long)b * 2048 - 2048) * 8 + h) * 64; A.ors = 8 * 64;
                        A.lse = FML + (((long)seg * 4096 + (long)b * 2048 - 2048) * 8 + h) * 2; A.lrs = 16;
                        att::attn_unit<2>(lds, A, tid);
                    } else {
                        A.jlo = 0; A.jhi = 4 * (qb + 1);
                        A.Ob = OCAT + (size_t)b * SEQ * OC_W + OC_A + h * 64; A.Of = nullptr; A.ors = OC_W; A.lse = nullptr; A.lrs = 0;
                        att::attn_unit<0>(lds, A, tid);
                    }
                } else if (u < MIX_FOX + MIX_DIL) {
                    u -= MIX_FOX; const int grp = u >> 7, v = u & 127; const int sh = 2 * grp, dil = 1 << sh;
                    const int nqb = 16 >> sh; const int qb = v % nqb; int t = v / nqb; const int slot = t & 3; t >>= 2; const int res = t % dil; const int b = t / dil;
                    const int head = grp * 4 + slot; const size_t row0 = (size_t)b * SEQ + res;
                    att::AttnArgs A;
                    A.Q = PROJ + row0 * DIN + PC_DQ + head * 64; A.K = PROJ + row0 * DIN + PC_DK + head * 64; A.V = PROJ + row0 * DIN + PC_DV + head * 64; A.rs = (long)DIN * dil;
                    A.q0 = qb * 256; A.kbase = qb * 256 - 128; A.jlo = (qb == 0) ? 2 : 0; A.jhi = 6; A.Fl = nullptr; A.rope = ROPE + row0 * 16; A.rrs = 16L * dil;
                    A.Ob = nullptr; A.Of = ODIL + ((size_t)grp * M + row0) * 256 + slot * 64; A.ors = 256L * dil; A.lse = LSE + ((size_t)grp * M + row0) * 4 + slot; A.lrs = 4L * dil;
                    att::attn_unit<1>(lds, A, tid);
                } else if (u < MIX_FOX + MIX_DIL + MIX_SGU) {
                    u -= MIX_FOX + MIX_DIL; const int g = u & 3, c = (u >> 2) & 31, b = u >> 7; const size_t row0 = (size_t)b * SEQ + c * 128;
                    const int row = tid >> 2, part = tid & 3;
                    const int r32 = lane & 31, hh = lane >> 5, tb = wave & 3, dp = wave >> 2;
                    const bf16_t* wrow = SGUW + ((size_t)(L * 4 + g) * 128 + 32 * tb + r32) * 128 + 8 * hh;
                    bf16x8 wa[8];
#pragma unroll
                    for (int i = 0; i < 8; ++i) wa[i] = *(const bf16x8*)(wrow + 16 * i);
                    const bf16_t* vrow = PROJ + (row0 + row) * DIN + PC_SV;
                    const float* gsn = sgu_g + L * 512 + 128 * g + 32 * part;
                    u32x4 wg[4]; f32x4 gga[4], ggb[4];
#pragma unroll
                    for (int i = 0; i < 4; ++i) { wg[i] = *(const u32x4*)(vrow + 128 * g + 32 * part + 8 * i); gga[i] = *(const f32x4*)(gsn + 8 * i); ggb[i] = *(const f32x4*)(gsn + 8 * i + 4); }
                    float ss = 0.f;
#pragma unroll
                    for (int i = 0; i < 16; ++i) { const u32x4 w = *(const u32x4*)(vrow + part * 128 + 8 * i);
                        ss += (bf_lo(w.x) * bf_lo(w.x) + bf_hi(w.x) * bf_hi(w.x)) + (bf_lo(w.y) * bf_lo(w.y) + bf_hi(w.y) * bf_hi(w.y)) + (bf_lo(w.z) * bf_lo(w.z) + bf_hi(w.z) * bf_hi(w.z)) + (bf_lo(w.w) * bf_lo(w.w) + bf_hi(w.w) * bf_hi(w.w)); }
                    ss += shx(ss, 1, lane); ss += shx(ss, 2, lane);
                    const float rinv = 1.0f / sqrtf(ss * (1.0f / 512.0f) + EPS);
#pragma unroll
                    for (int i = 0; i < 4; ++i) { const u32x4 w = wg[i]; const f32x4 ga = gga[i], gb = ggb[i];
                        u32x4 o; o.x = cvt_pk_bf16(bf_lo(w.x) * rinv * ga.x, bf_hi(w.x) * rinv * ga.y); o.y = cvt_pk_bf16(bf_lo(w.y) * rinv * ga.z, bf_hi(w.y) * rinv * ga.w);
                        o.z = cvt_pk_bf16(bf_lo(w.z) * rinv * gb.x, bf_hi(w.z) * rinv * gb.y); o.w = cvt_pk_bf16(bf_lo(w.w) * rinv * gb.z, bf_hi(w.w) * rinv * gb.w);
                        *(LAS u32x4*)(lds + att::LDS_SV + part * 8192 + row * 64 + i * 16) = o; }
                    BAR_L();
                    float bia[16]; bf16_t uu0[16], uu1[16];
#pragma unroll
                    for (int r = 0; r < 16; ++r) { const int t = 32 * tb + att::crow(r, hh); const size_t gr = row0 + t; const int d = 128 * g + 64 * dp + r32;
                        bia[r] = sgu_b[(L * 4 + g) * 128 + t]; uu0[r] = PROJ[gr * DIN + PC_SU + d]; uu1[r] = PROJ[gr * DIN + PC_SU + d + 32]; }
                    f32x16 o0, o1;
#pragma unroll
                    for (int r = 0; r < 16; ++r) { o0[r] = 0.f; o1[r] = 0.f; }
                    const LAS unsigned char* vp = lds + att::LDS_SV + (2 * dp) * 8192 + ((lane >> 4) & 1) * 32 + (lane & 3) * 8 + (8 * hh + ((lane & 15) >> 2)) * 64;
#pragma unroll
                    for (int i = 0; i < 8; ++i) { if (i >= 2 * tb + 2) break;
                        const bf16x8 a = wa[i];
                        const s16x4 a0 = att::vtr(vp + i * 1024), a1 = att::vtr(vp + i * 1024 + 256), b0 = att::vtr(vp + 8192 + i * 1024), b1 = att::vtr(vp + 8192 + i * 1024 + 256);
                        const bf16x8 v0 = (bf16x8){a0[0], a0[1], a0[2], a0[3], a1[0], a1[1], a1[2], a1[3]}, v1 = (bf16x8){b0[0], b0[1], b0[2], b0[3], b1[0], b1[1], b1[2], b1[3]};
                        o0 = __builtin_amdgcn_mfma_f32_32x32x16_bf16(a, v0, o0, 0, 0, 0); o1 = __builtin_amdgcn_mfma_f32_32x32x16_bf16(a, v1, o1, 0, 0, 0);
                    }
#pragma unroll
                    for (int r = 0; r < 16; ++r) { const int t = 32 * tb + att::crow(r, hh); const size_t gr = row0 + t; const float bias = bia[r];
                        const int d = 128 * g + 64 * dp + r32;
                        const float u0 = bf1(uu0[r]), u1 = bf1(uu1[r]);
                        OCAT[gr * OC_W + OC_C + d] = (bf16_t)(cvt_pk_bf16(u0 * (o0[r] + bias), 0.f) & 0xffffu); OCAT[gr * OC_W + OC_C + d + 32] = (bf16_t)(cvt_pk_bf16(u1 * (o1[r] + bias), 0.f) & 0xffffu); }
                } else {
                    u -= MIX_FOX + MIX_DIL + MIX_SGU;
                    {
                        const int c = (tid & 63) * 8, rbase = 32 * u + 4 * (tid >> 6), t0 = rbase & (SEQ - 1);
                        const bf16_t* pr = PROJ + (size_t)rbase * DIN; u32x4 xa[6], gc[6], gb[4];
#pragma unroll
                        for (int k = 0; k < 6; ++k) { if (k >= 2 || t0 >= 2) { xa[k] = *(const u32x4*)(pr + (long)(k - 2) * DIN + PC_XB + c); gc[k] = *(const u32x4*)(pr + (long)(k - 2) * DIN + PC_GC + c); }
                                                      else { xa[k] = (u32x4){0u, 0u, 0u, 0u}; gc[k] = (u32x4){0u, 0u, 0u, 0u}; } }
#pragma unroll
                        for (int i = 0; i < 4; ++i) gb[i] = *(const u32x4*)(pr + (size_t)i * DIN + PC_GB + c);
                        const float* wk = scw + (size_t)L * 3 * 512 + c; float w0[8], w1[8], w2[8];
#pragma unroll
                        for (int e = 0; e < 8; ++e) { w0[e] = wk[e]; w1[e] = wk[512 + e]; w2[e] = wk[1024 + e]; }
                        float y[6][8];
#pragma unroll
                        for (int k = 0; k < 6; ++k) { const u32x4 a = xa[k], g2 = gc[k];
                            y[k][0] = bf_lo(a.x) * bf_lo(g2.x); y[k][1] = bf_hi(a.x) * bf_hi(g2.x); y[k][2] = bf_lo(a.y) * bf_lo(g2.y); y[k][3] = bf_hi(a.y) * bf_hi(g2.y);
                            y[k][4] = bf_lo(a.z) * bf_lo(g2.z); y[k][5] = bf_hi(a.z) * bf_hi(g2.z); y[k][6] = bf_lo(a.w) * bf_lo(g2.w); y[k][7] = bf_hi(a.w) * bf_hi(g2.w); }
#pragma unroll
                        for (int i = 0; i < 4; ++i) { const u32x4 g = gb[i]; const float gbf[8] = {bf_lo(g.x), bf_hi(g.x), bf_lo(g.y), bf_hi(g.y), bf_lo(g.z), bf_hi(g.z), bf_lo(g.w), bf_hi(g.w)}; float o[8];
#pragma unroll
                            for (int e = 0; e < 8; ++e) o[e] = gbf[e] * (w0[e] * y[i][e] + w1[e] * y[i + 1][e] + w2[e] * y[i + 2][e]);
                            u32x4 w; w.x = cvt_pk_bf16(o[0], o[1]); w.y = cvt_pk_bf16(o[2], o[3]); w.z = cvt_pk_bf16(o[4], o[5]); w.w = cvt_pk_bf16(o[6], o[7]);
                            *(u32x4*)(OCAT + (size_t)(rbase + i) * OC_W + OC_B + c) = w; }
                    }
                }
                qcur = qnext;
            }
            __syncthreads();
        }
#undef TR_RUN
#undef TR_DECODE
        SEAM(pb + 1);
        if (IN(pb + 2)) { WS_LOCAL();
            const int wave = opaque_i(wave0), tid = wave * 64 + lane_id_now(), lane = tid & 63, gw = bx * 8 + wave; (void)lane; (void)gw;
            if (G * 512 * 2 == M * 4 * 8) {
                const int gt = bx * 512 + tid, NT = G * 512;
                float l2[2][3]; f32x4 da[2][3], db[2][3]; float fm0[2], fl0[2], fm1[2], fl1[2]; f32x4 fa0[2], fa1[2], fb0[2], fb1[2];
#pragma unroll
                for (int q = 0; q < 2; ++q) { const int i = gt + q * NT, d8 = i & 7, slot = (i >> 3) & 3, row = i >> 5;
#pragma unroll
                    for (int g = 0; g < 3; ++g) { l2[q][g] = LSE[((size_t)g * M + row) * 4 + slot]; const float* od = ODIL + ((size_t)g * M + row) * 256 + slot * 64 + d8 * 8; da[q][g] = *(const f32x4*)od; db[q][g] = *(const f32x4*)(od + 4); }
                    const int h = (i >> 3) & 7, rr = i >> 6;
                    fm0[q] = FML[((size_t)rr * 8 + h) * 2]; fl0[q] = FML[((size_t)rr * 8 + h) * 2 + 1]; fm1[q] = FML[((size_t)(4096 + rr) * 8 + h) * 2]; fl1[q] = FML[((size_t)(4096 + rr) * 8 + h) * 2 + 1];
                    const float* p0 = FOP + ((size_t)rr * 8 + h) * 64 + d8 * 8; const float* p1 = FOP + ((size_t)(4096 + rr) * 8 + h) * 64 + d8 * 8;
                    fa0[q] = *(const f32x4*)p0; fa1[q] = *(const f32x4*)(p0 + 4); fb0[q] = *(const f32x4*)p1; fb1[q] = *(const f32x4*)(p1 + 4); }
#pragma unroll
                for (int q = 0; q < 2; ++q) { const int i = gt + q * NT, d8 = i & 7, slot = (i >> 3) & 3, row = i >> 5;
                    const float mx = fmaxf(fmaxf(l2[q][0], l2[q][1]), l2[q][2]); float wsum = 0.f; f32x4 oa = {0.f, 0.f, 0.f, 0.f}, ob = {0.f, 0.f, 0.f, 0.f};
#pragma unroll
                    for (int g = 0; g < 3; ++g) { const float w = fast_exp2(l2[q][g] - mx); wsum += w; oa = oa + da[q][g] * w; ob = ob + db[q][g] * w; }
                    const float inv = 1.0f / wsum; u32x4 w; w.x = cvt_pk_bf16(oa.x * inv, oa.y * inv); w.y = cvt_pk_bf16(oa.z * inv, oa.w * inv); w.z = cvt_pk_bf16(ob.x * inv, ob.y * inv); w.w = cvt_pk_bf16(ob.z * inv, ob.w * inv);
                    *(u32x4*)(OCAT + (size_t)row * OC_W + OC_D + slot * 64 + d8 * 8) = w;
                    const int h = (i >> 3) & 7, rr = i >> 6, b = rr >> 11, t = 2048 + (rr & 2047);
                    const float mm = fmaxf(fm0[q], fm1[q]), w0 = fast_exp2(fm0[q] - mm), w1 = fast_exp2(fm1[q] - mm), inv2 = 1.0f / (w0 * fl0[q] + w1 * fl1[q]);
                    const f32x4 o0 = (fa0[q] * w0 + fb0[q] * w1) * inv2, o1 = (fa1[q] * w0 + fb1[q] * w1) * inv2;
                    u32x4 w2; w2.x = cvt_pk_bf16(o0.x, o0.y); w2.y = cvt_pk_bf16(o0.z, o0.w); w2.z = cvt_pk_bf16(o1.x, o1.y); w2.w = cvt_pk_bf16(o1.z, o1.w);
                    *(u32x4*)(OCAT + ((size_t)b * SEQ + t) * OC_W + OC_A + h * 64 + d8 * 8) = w2; }
            } else {
            for (int i = bx * 512 + tid; i < M * 4 * 8; i += G * 512) { const int d8 = i & 7, slot = (i >> 3) & 3, row = i >> 5;
                float l2[3], mx = -3.0e38f;
#pragma unroll
                for (int g = 0; g < 3; ++g) { l2[g] = LSE[((size_t)g * M + row) * 4 + slot]; mx = fmaxf(mx, l2[g]); }
                float wsum = 0.f, o[8];
#pragma unroll
                for (int e = 0; e < 8; ++e) o[e] = 0.f;
#pragma unroll
                for (int g = 0; g < 3; ++g) { const float w = fast_exp2(l2[g] - mx); wsum += w; const float* od = ODIL + ((size_t)g * M + row) * 256 + slot * 64 + d8 * 8;
                    const f32x4 a = *(const f32x4*)od, b = *(const f32x4*)(od + 4); o[0] += w * a.x; o[1] += w * a.y; o[2] += w * a.z; o[3] += w * a.w; o[4] += w * b.x; o[5] += w * b.y; o[6] += w * b.z; o[7] += w * b.w; }
                const float inv = 1.0f / wsum; u32x4 w; w.x = cvt_pk_bf16(o[0] * inv, o[1] * inv); w.y = cvt_pk_bf16(o[2] * inv, o[3] * inv); w.z = cvt_pk_bf16(o[4] * inv, o[5] * inv); w.w = cvt_pk_bf16(o[6] * inv, o[7] * inv);
                *(u32x4*)(OCAT + (size_t)row * OC_W + OC_D + slot * 64 + d8 * 8) = w; }
            for (int i = bx * 512 + tid; i < 4096 * 8 * 8; i += G * 512) {
                const int d8 = i & 7, h = (i >> 3) & 7, rr = i >> 6; const int b = rr >> 11, t = 2048 + (rr & 2047);
                const float m0 = FML[((size_t)rr * 8 + h) * 2], l0 = FML[((size_t)rr * 8 + h) * 2 + 1], m1 = FML[((size_t)(4096 + rr) * 8 + h) * 2], l1 = FML[((size_t)(4096 + rr) * 8 + h) * 2 + 1];
                const float mm = fmaxf(m0, m1), w0 = fast_exp2(m0 - mm), w1 = fast_exp2(m1 - mm), inv = 1.0f / (w0 * l0 + w1 * l1);
                const float* p0 = FOP + ((size_t)rr * 8 + h) * 64 + d8 * 8; const float* p1 = FOP + ((size_t)(4096 + rr) * 8 + h) * 64 + d8 * 8;
                const f32x4 a0 = *(const f32x4*)p0, a1 = *(const f32x4*)(p0 + 4), b0 = *(const f32x4*)p1, b1 = *(const f32x4*)(p1 + 4);
                const f32x4 o0 = (a0 * w0 + b0 * w1) * inv, o1 = (a1 * w0 + b1 * w1) * inv;
                u32x4 w; w.x = cvt_pk_bf16(o0.x, o0.y); w.y = cvt_pk_bf16(o0.z, o0.w); w.z = cvt_pk_bf16(o1.x, o1.y); w.w = cvt_pk_bf16(o1.z, o1.w);
                *(u32x4*)(OCAT + ((size_t)b * SEQ + t) * OC_W + OC_A + h * 64 + d8 * 8) = w; }
            }
            {
                pg8::Gemm g2{PB + (size_t)L * M * PLE, (const bf16_t*)(wl + WL_PE), M, DM, opaque_i(PLE)};   pg8::StaticOrder S2; S2.init(M, DM, G, bx);
                pg8::EpiPlain E2{PP + (size_t)L * M * DM, DM};
                __syncthreads();
                pg8::gemm_phase(lds, g2, S2, E2, pg8::NoHook{}, MK_TID());
            }
        }
        SEAM(pb + 2);
        if (IN(pb + 3)) { WS_LOCAL();
            pg8::Gemm g{OCAT, (const bf16_t*)(wl + WL_BR), M, DM, OC_W}; pg8::StaticOrder S; S.init(M, DM, G, bx);
            pg8::EpiMerge E{MG, DM, G8 + 3 * 2048}; pg8::MergeHook H{G8};
            pg8::gemm_phase(lds, g, S, E, H, MK_TID());
        }
        SEAM(pb + 3);
        if (IN(pb + 4)) { WS_LOCAL();
            pg8::Gemm g{MG, (const bf16_t*)(wl + WL_OUT), M, DM, DM}; pg8::StaticOrder S; S.init(M, DM, G, bx);
            pg8::EpiResidN E{XR, nullptr};
            pg8::gemm_phase(lds, g, S, E, pg8::NoHook{}, MK_TID());
        }
        SEAM(pb + 4);
        if (IN(pb + 5)) { WS_LOCAL();
            const int wave = opaque_i(wave0), tid = wave * 64 + lane_id_now(), lane = tid & 63, gw = bx * 8 + wave; (void)lane; (void)gw;
            norm_phase<false, false, true>(nullptr, XR, nullptr, nullptr, XN8, AS8, norm_ffn_g + L * DM, nullptr, nullptr, nullptr, nullptr, nullptr, lds, gw, NGW, lane, tid);
        }
        SEAM(pb + 5);
        if (IN(pb + 6)) { WS_LOCAL();
            pg8::Gemm g{(const bf16_t*)XN8, (const bf16_t*)(wl + WL_UP), M, 2 * DFF, opaque_i(DM / 2)}; pg8::UpOrder S; S.init(M, G, bx);
            pg8::EpiUp8 E{UP, 2 * DFF, AS8, QSC + 2 * L + 1, UPB, 1024, 40 * 256};
            pg8::gemm_phase<pg8::EpiUp8, pg8::NoHook, pg8::UpOrder, true>(lds, g, S, E, pg8::NoHook{}, MK_TID());
        }
        SEAM(pb + 6);
        if (IN(pb + 7)) { WS_LOCAL();
            const int wave = opaque_i(wave0), tid = wave * 64 + lane_id_now(), lane = tid & 63, gw = bx * 8 + wave; (void)lane; (void)gw;
            const float* cw = ffn_cw + (size_t)L * 3 * 2 * DFF;
            for (int item = bx * 512 + tid; item < 1024 * 704; item += G * 512) { const int rb = item / 704, c = (item % 704) * 8, row0 = rb * 8, t0 = row0 & (SEQ - 1);
                u32x4 gq[10], vq[10];
#pragma unroll
                for (int r = 0; r < 10; ++r) { if (r >= 2 || t0 >= 2) { const bf16_t* pr = UP + (size_t)(row0 + r - 2) * 2 * DFF + c; gq[r] = *(const u32x4*)pr; vq[r] = *(const u32x4*)(pr + DFF); }
                                               else { gq[r] = (u32x4){0u, 0u, 0u, 0u}; vq[r] = (u32x4){0u, 0u, 0u, 0u}; } }
                if (c >= 4608) {
#pragma unroll
                    for (int r = 0; r < 10; ++r) { if (r >= 2 || t0 >= 2) { const u32x4 b2 = *(const u32x4*)(UPB + (size_t)(row0 + r - 2) * 1024 + (c - 4608)); u32x4 s;
#pragma unroll
                            for (int e = 0; e < 4; ++e) s[e] = cvt_pk_bf16(bf_lo(vq[r][e]) + bf_lo(b2[e]), bf_hi(vq[r][e]) + bf_hi(b2[e]));
                            vq[r] = s; } } }
                float rq[10];
#pragma unroll
                for (int r = 0; r < 10; ++r) rq[r] = 1.0f;
                float wg[3][8], wv[3][8];
#pragma unroll
                for (int k = 0; k < 3; ++k) { const f32x4 a = *(const f32x4*)(cw + k * 2 * DFF + c), b = *(const f32x4*)(cw + k * 2 * DFF + c + 4), d = *(const f32x4*)(cw + k * 2 * DFF + DFF + c), e2 = *(const f32x4*)(cw + k * 2 * DFF + DFF + c + 4);
                    wg[k][0] = a.x; wg[k][1] = a.y; wg[k][2] = a.z; wg[k][3] = a.w; wg[k][4] = b.x; wg[k][5] = b.y; wg[k][6] = b.z; wg[k][7] = b.w;
                    wv[k][0] = d.x; wv[k][1] = d.y; wv[k][2] = d.z; wv[k][3] = d.w; wv[k][4] = e2.x; wv[k][5] = e2.y; wv[k][6] = e2.z; wv[k][7] = e2.w; }
#pragma unroll
                for (int r = 0; r < 8; ++r) { const u32x4 g0 = gq[r], g1 = gq[r + 1], g2 = gq[r + 2], v0 = vq[r], v1 = vq[r + 1], v2 = vq[r + 2];
                    float o[8];
#pragma unroll
                    for (int e = 0; e < 4; ++e) {
                        const float q0 = rq[r], q1 = rq[r + 1], q2 = rq[r + 2];
                        const float ga = wg[0][2 * e] * q0 * bf_lo(g0[e]) + wg[1][2 * e] * q1 * bf_lo(g1[e]) + wg[2][2 * e] * q2 * bf_lo(g2[e]), gb2 = wg[0][2 * e + 1] * q0 * bf_hi(g0[e]) + wg[1][2 * e + 1] * q1 * bf_hi(g1[e]) + wg[2][2 * e + 1] * q2 * bf_hi(g2[e]);
                        const float va = wv[0][2 * e] * q0 * bf_lo(v0[e]) + wv[1][2 * e] * q1 * bf_lo(v1[e]) + wv[2][2 * e] * q2 * bf_lo(v2[e]), vb = wv[0][2 * e + 1] * q0 * bf_hi(v0[e]) + wv[1][2 * e + 1] * q1 * bf_hi(v1[e]) + wv[2][2 * e + 1] * q2 * bf_hi(v2[e]);
                        o[2 * e] = ga * sigmoid_f(ga) * va; o[2 * e + 1] = gb2 * sigmoid_f(gb2) * vb; }
                    u32x4 w; w.x = cvt_pk_bf16(o[0], o[1]); w.y = cvt_pk_bf16(o[2], o[3]); w.z = cvt_pk_bf16(o[4], o[5]); w.w = cvt_pk_bf16(o[6], o[7]);
                    *(u32x4*)(HID + (size_t)(row0 + r) * DFF + c) = w; }
            }
        }
        SEAM(pb + 7);
        if (IN(pb + 8)) { WS_LOCAL();
            pg8::Gemm g{HID, (const bf16_t*)(wl + WL_DN), M, DM, DFF}; pg8::StaticOrder S; S.init(M, DM, G, bx);
            pg8::EpiResidN E{XR, SSQ + (size_t)M * 32};
            pg8::gemm_phase(lds, g, S, E, pg8::NoHook{}, MK_TID());
        }
        SEAM(pb + 8);
        if (IN(pb + 9)) { WS_LOCAL();
            pg8::Gemm g{XR, (const bf16_t*)(wl + WL_PG), M, DM, DM}; pg8::StaticOrder S; S.init(M, DM, G, bx);
            pg8::EpiPle E{XR, XRN, PP + (size_t)L * M * DM, SSQ + (size_t)M * 32};
            pg8::gemm_phase(lds, g, S, E, pg8::NoHook{}, MK_TID());
        }
        SEAM(pb + 9);
        if (IN(pb + 10)) { WS_LOCAL();
            const int wave = opaque_i(wave0), tid = wave * 64 + lane_id_now(), lane = tid & 63, gw = bx * 8 + wave; (void)lane; (void)gw;
            if (L + 1 < DEPTH) norm_phase<true, false, true>(nullptr, XRN, nullptr, RSC, XN8, AS8, norm_mix_g + (L + 1) * DM, WFG + (size_t)(L + 1) * 8 * DM, fox_b + (L + 1) * 8, LOGF, nullptr, nullptr, lds, gw, NGW, lane, tid);
            else norm_phase<false, true, true>(nullptr, XRN, nullptr, nullptr, nullptr, nullptr, nullptr, nullptr, nullptr, nullptr, final_g, X, lds, gw, NGW, lane, tid);
        }
        SEAM(pb + 10);
    }
#undef IN
#undef SEAM
#undef MK_TID
}
#undef x_in
#undef p_in
#undef pos_in
#undef norm_mix_g
#undef w_in
#undef fox_b
#undef scw
#undef sgu_g
#undef sgu_w
#undef sgu_b
#undef w_br_fox
#undef w_br_conv
#undef w_br_sgu
#undef w_br_dil
#undef w_out
#undef norm_ffn_g
#undef w_up
#undef ffn_cw
#undef w_down
#undef norm_ple_g
#undef w_pg
#undef w_pe
#undef final_g
#undef WFG
#undef SGUW
#undef ROPE
#undef LOGF
#undef FL
#undef LSE
#undef SSQ
#undef RSC
#undef FOP
#undef FML
#undef UPB
#undef G8
#undef XN8
#undef AS8
#undef QSC
#undef XR
#undef XRN
#undef PB
#undef PP
#undef XN
#undef PROJ
#undef UP
#undef HID
#undef OCAT
#undef MG
#undef ODIL
#undef WS_LOCAL
#undef wl

extern "C" void kernel_launch(void* const* d_in, const int* in_sizes, int n_in, void* d_out, int out_size, void* d_ws, size_t ws_size, hipStream_t stream) {
    static int grid = 0;
    if (grid == 0) {
        if (n_in != 23 || in_sizes[0] != M * DM || out_size != M * DM || ws_size < WS_END) { fprintf(stderr, "kernel_launch: unexpected shapes/workspace (n_in %d, ws %zu < %zu)\n", n_in, ws_size, (size_t)WS_END); grid = -1; return; }
        int dev = 0, cus = 0, per_cu = 0;
        if (hipGetDevice(&dev) != hipSuccess || hipDeviceGetAttribute(&cus, hipDeviceAttributeMultiprocessorCount, dev) != hipSuccess) { grid = -1; return; }
        if (hipFuncSetAttribute((const void*)mk_fwd, hipFuncAttributeMaxDynamicSharedMemorySize, LDS_BYTES) != hipSuccess) { fprintf(stderr, "kernel_launch: hipFuncSetAttribute failed\n"); grid = -1; return; }
        if (hipOccupancyMaxActiveBlocksPerMultiprocessor(&per_cu, (const void*)mk_fwd, 512, LDS_BYTES) != hipSuccess || per_cu < 1) fprintf(stderr, "kernel_launch: occupancy query says %d\n", per_cu);
        (void)hipGetLastError();
        grid = cus;
    }
    if (grid < 0) return;
    if (hipMemsetAsync((char*)d_ws + WS_CTL, 0, CTL_BYTES, stream) != hipSuccess) return;
    Args a{};
    for (int i = 0; i < 23; ++i) a.in[i] = (const float*)d_in[i];
    a.out = (float*)d_out; a.ws = (unsigned char*)d_ws; a.pad = 0;
    const int step = (MK_SPLIT > 0) ? MK_SPLIT : NPHASE;
    int li = 0;
    for (int lo = 0; lo < NPHASE; lo += step, ++li) {
        a.ph_lo = lo; a.ph_hi = (lo + step < NPHASE) ? lo + step : NPHASE; a.li = li;
        hipLaunchKernelGGL(mk_fwd, dim3(grid), dim3(512), LDS_BYTES, stream, a);
        if (hipPeekAtLastError() != hipSuccess) { fprintf(stderr, "kernel_launch: launch %d failed\n", li); break; }
    }
}
```

```cpp
#include <hip/hip_runtime.h>
#include <cstdio>
#include <cstdint>

#ifndef PROBE_PH
#define PROBE_PH -1
#endif
#ifndef MIX_PROBE
#define MIX_PROBE 0
#endif
#ifndef MK_SPLIT
#define MK_SPLIT 0
#endif

#define LAS __attribute__((address_space(3)))
#define GAS __attribute__((address_space(1)))
typedef unsigned short bf16_t;
typedef short bf16x8 __attribute__((ext_vector_type(8)));
typedef short s16x4 __attribute__((ext_vector_type(4)));
typedef float f32x2 __attribute__((ext_vector_type(2)));
typedef float f32x4 __attribute__((ext_vector_type(4)));
typedef float f32x16 __attribute__((ext_vector_type(16)));
typedef unsigned u32x2 __attribute__((ext_vector_type(2)));
typedef unsigned u32x4 __attribute__((ext_vector_type(4)));
typedef int v4i __attribute__((ext_vector_type(4)));


constexpr int NB = 2, SEQ = 4096, DM = 2048, DEPTH = 4, M = NB * SEQ;
constexpr int DIN_SRC = 14600, DIN = 14592;
constexpr int DFF = 5632, PLE = 256;
constexpr float EPS = 1e-6f;
constexpr float LOG2E = 1.4426950408889634f;
constexpr float C2 = 0.125f * LOG2E;
constexpr float WQ_MAX = 0.126f, WQ_INV = 127.0f / WQ_MAX, WQ_S = WQ_MAX / 127.0f;
constexpr int PC_AQ = 0, PC_AK = 512, PC_AV = 1024, PC_XB = 1536, PC_GB = 2048, PC_GC = 2560, PC_SU = 3072, PC_SV = 3584,
              PC_DQ = 4096, PC_DK = 4864, PC_DV = 5632, PC_G = 6400;
constexpr unsigned I8MASK = (3u << 4) | (7u << 22);
constexpr int N8T = __builtin_popcount(I8MASK), NBT = 25 - N8T, N8N = 8192 + N8T * 256;
constexpr int PB_EXTRA = (NBT * 32) % 256, I8_UNITS = (32 + N8T) * 32, I8_X = (I8_UNITS - (PB_EXTRA ? 2 * (256 - PB_EXTRA) : 0)) / 256;
constexpr int I8_INPHASE = I8_X * 256 + (PB_EXTRA ? 2 * (256 - PB_EXTRA) : 0), MIX_GEMM = I8_UNITS - I8_INPHASE;
__host__ __device__ __forceinline__ int nth_set(unsigned m, int k) { for (int i = 0; i < k; ++i) m &= m - 1u; return __builtin_ctz(m); }
constexpr int OC_W = 1792;
constexpr int OC_A = 0, OC_B = 512, OC_C = 1024, OC_D = 1536;

constexpr size_t MiB = 1u << 20;
constexpr size_t WS_CTL = 0, CTL_BYTES = (MK_SPLIT > 0) ? 2 * MiB : 64 * 1024;
constexpr size_t WS_WL = 2 * MiB;
constexpr size_t WL_IN = 0, WL_G8W = 32 * MiB  , WL_BR = 57 * MiB, WL_OUT = 64 * MiB, WL_UP = 72 * MiB, WL_DN = 116 * MiB, WL_PG = 138 * MiB, WL_PE = 146 * MiB, WL_STRIDE = 147 * MiB;
constexpr size_t WS_SMALL = WS_WL + 4 * WL_STRIDE;
constexpr size_t SM_WFG = 0, SM_SGUW = 256 * 1024, SM_ROPE = 768 * 1024, SM_LOGF = 1280 * 1024, SM_FL = 1536 * 1024, SM_LSE = 1792 * 1024, SM_SS = 2304 * 1024;
constexpr size_t WS_PB = WS_SMALL + 4 * MiB;
constexpr size_t WS_PP = WS_PB + 16 * MiB;
constexpr size_t WS_XN = WS_PP + 128 * MiB;
constexpr size_t WS_PROJ = WS_XN + 32 * MiB;
constexpr size_t WS_HID = WS_PROJ + 228 * MiB;
constexpr size_t WS_OCAT = WS_HID + 88 * MiB;
constexpr size_t WS_MG = WS_OCAT + 28 * MiB;
constexpr size_t WS_ODIL = WS_MG + 32 * MiB;
constexpr size_t WS_PART = WS_ODIL + 24 * MiB;
constexpr size_t WS_FOP = WS_PART + 2 * MiB;
constexpr size_t WS_FML = WS_FOP + 16 * MiB;
constexpr size_t WS_UPB = WS_FML + 1 * MiB;
constexpr size_t WS_XR = WS_UPB + 16 * MiB;
constexpr size_t WS_G8 = WS_XR + 64 * MiB;
constexpr size_t WS_XN8 = WS_G8 + 64 * MiB;
constexpr size_t WS_END = WS_XN8 + 16 * MiB;
constexpr int CW_BAR = 4096;
constexpr int CW_Q = 1024;

constexpr int LDS_BYTES = 147456;
constexpr int RING_BYTES = 131072;
constexpr int MISC_OFF = RING_BYTES + 320;

#define LDS_WAIT() asm volatile("s_waitcnt lgkmcnt(0)" ::: "memory")
#define VM_WAIT() asm volatile("s_waitcnt vmcnt(0)" ::: "memory")
#define BAR_L() asm volatile("s_waitcnt lgkmcnt(0)\n\ts_barrier" ::: "memory")
typedef __bf16 bf16x2_t __attribute__((ext_vector_type(2)));
__device__ __forceinline__ unsigned cvt_pk_bf16(float lo, float hi) { f32x2 v = {lo, hi}; bf16x2_t b = __builtin_convertvector(v, bf16x2_t); return __builtin_bit_cast(unsigned, b); }
__device__ __forceinline__ float ub0(unsigned u) { return (float)(u & 0xffu); }
__device__ __forceinline__ float ub1(unsigned u) { return (float)((u >> 8) & 0xffu); }
__device__ __forceinline__ float ub2(unsigned u) { return (float)((u >> 16) & 0xffu); }
__device__ __forceinline__ float ub3(unsigned u) { return (float)(u >> 24); }
__device__ __forceinline__ float bf_lo(unsigned u) { return __uint_as_float(u << 16); }
__device__ __forceinline__ float bf_hi(unsigned u) { return __uint_as_float(u & 0xffff0000u); }
__device__ __forceinline__ float bf1(bf16_t u) { return __uint_as_float(((unsigned)u) << 16); }
__device__ __forceinline__ float shx(float v, int mask, int lane) { return __int_as_float(__builtin_amdgcn_ds_bpermute((lane ^ mask) << 2, __float_as_int(v))); }
__device__ __forceinline__ unsigned shxu(unsigned v, int mask, int lane) { return (unsigned)__builtin_amdgcn_ds_bpermute((lane ^ mask) << 2, (int)v); }
__device__ __forceinline__ unsigned q8x4(float a, float b, float c, float d) {
    unsigned w = 0u;
    w = __builtin_amdgcn_cvt_pk_u8_f32(fminf(fmaxf(__builtin_rintf(a), -127.f), 127.f) + 128.f, 0, w); w = __builtin_amdgcn_cvt_pk_u8_f32(fminf(fmaxf(__builtin_rintf(b), -127.f), 127.f) + 128.f, 1, w);
    w = __builtin_amdgcn_cvt_pk_u8_f32(fminf(fmaxf(__builtin_rintf(c), -127.f), 127.f) + 128.f, 2, w); w = __builtin_amdgcn_cvt_pk_u8_f32(fminf(fmaxf(__builtin_rintf(d), -127.f), 127.f) + 128.f, 3, w);
    return w ^ 0x80808080u;
}
__device__ __forceinline__ float wave_max(float v, int lane) {
#pragma unroll
    for (int o = 1; o < 64; o <<= 1) v = fmaxf(v, shx(v, o, lane));
    return v;
}
__device__ __forceinline__ float wave_sum(float v, int lane) {
#pragma unroll
    for (int o = 1; o < 64; o <<= 1) v += shx(v, o, lane);
    return v;
}
__device__ __forceinline__ float fast_exp2(float x) { return __builtin_amdgcn_exp2f(x); }
__device__ __forceinline__ float fast_rcp(float x) { return __builtin_amdgcn_rcpf(x); }
__device__ __forceinline__ float sigmoid_f(float x) { return fast_rcp(1.0f + fast_exp2(-LOG2E * x)); }
__device__ __forceinline__ float gelu_tanh_f(float x) {
    const float z = 0.7978845608028654f * (x + 0.044715f * x * x * x);
    return x * fast_rcp(1.0f + fast_exp2(-2.0f * LOG2E * z));
}

namespace pg8 {
#define PG8_LAS __attribute__((address_space(3)))
constexpr int BM = 256, BK = 64, HALF = 128, HTB = HALF * BK * 2, STAGE_BYTES = 8 * HTB, NXCD = 8, WGM = 4;
__host__ __device__ __forceinline__ int lds_byte(int r, int c) { const int st = (r >> 4) * 2 + (c >> 5), rr = r & 15, cc = c & 31, ob = rr * 64 + cc * 2; return st * 1024 + (ob ^ (((ob >> 9) & 1) << 5)); }
__host__ __device__ __forceinline__ void stage_rc(int b, int& R, int& C) { const int st = b / 1024, sb = b % 1024, swz = sb ^ (((sb >> 9) & 1) << 5); R = (st >> 1) * 16 + swz / 64; C = (st & 1) * 32 + (swz % 64) / 2; }
__host__ __device__ __forceinline__ int perm32(int rho) { const int n = rho >> 4, i = rho & 15; return 8 * (i >> 2) + 4 * n + (i & 3); }
struct Unit { int pm, pn, kq; };
struct Gemm { const bf16_t* A; const bf16_t* Bt; int M, N, K; };
struct StaticOrder {
    int nM, nN, nwg, G, c;
    __host__ __device__ __forceinline__ void init(int M_, int N_, int G_, int c_) { nM = M_ / BM; nN = N_ / BM; nwg = nM * nN; G = G_; c = c_; }
    __host__ __device__ __forceinline__ bool next(int i, Unit& u) const { return map((long)i * G + c, u); }
    __host__ __device__ __forceinline__ bool map(long L, Unit& u) const {
        if (L >= nwg) return false;
        int wgid = (int)L; { const int q = nwg / NXCD, r = nwg % NXCD, xcd = wgid % NXCD, off = wgid / NXCD; wgid = (xcd < r ? xcd * (q + 1) : r * (q + 1) + (xcd - r) * q) + off; }
        const int nig = WGM * nN, gid = wgid / nig, fm = gid * WGM, gsz = (nM - fm) < WGM ? (nM - fm) : WGM;
        u.pm = fm + ((wgid % nig) % gsz); u.pn = (wgid % nig) / gsz; u.kq = 0; return true;
    }
    __device__ __forceinline__ void a_ready(const Unit&) const {}
    __device__ __forceinline__ void done(const Unit&) const {}
    __device__ __forceinline__ int nt(const Unit&, int K) const { return K / BK; }
    __device__ __forceinline__ size_t koff(const Unit&, int) const { return 0; }
};
struct OneUnit {
    int pm, pn;
    __device__ __forceinline__ bool next(int i, Unit& u) const { if (i != 0) return false; u.pm = pm; u.pn = pn; u.kq = 0; return true; }
    __device__ __forceinline__ void a_ready(const Unit&) const {}
    __device__ __forceinline__ void done(const Unit&) const {}
    __device__ __forceinline__ int nt(const Unit&, int K) const { return K / BK; }
    __device__ __forceinline__ size_t koff(const Unit&, int) const { return 0; }
};
struct ProjOrder {
    StaticOrder so;
    __device__ __forceinline__ void init(int M_, int N_, int G_, int c_) { so.init(M_, N_, G_, c_); }
    __device__ __forceinline__ bool next(int i, Unit& u) const { if (!so.next(i, u)) return false; u.pn = nth_set(~I8MASK & 0x1ffffffu, u.pn); return true; }
    __device__ __forceinline__ void a_ready(const Unit&) const {}
    __device__ __forceinline__ void done(const Unit&) const {}
    __device__ __forceinline__ int nt(const Unit&, int K) const { return K / BK; }
    __device__ __forceinline__ size_t koff(const Unit&, int) const { return 0; }
};
struct Gate8Order {
    StaticOrder so; int c;
    __device__ __forceinline__ void init(int M_, int N_, int G_, int c_) { so.init(M_, N_, G_, c_); c = c_; }
    __device__ __forceinline__ bool next(int i, Unit& u) const {
        if (so.G != 256) return so.next(i, u);
        long L;
        if (i == 0) L = (c + 128) & 255;
        else if (i < I8_X) L = (long)i * 256 + c;
        else if (PB_EXTRA && i < I8_X + 2) { if (c < PB_EXTRA) return false; L = I8_X * 256 + (long)(i - I8_X) * (256 - PB_EXTRA) + (c - PB_EXTRA); }
        else return false;
        return so.map(L, u);
    }
    __device__ __forceinline__ void a_ready(const Unit&) const {}
    __device__ __forceinline__ void done(const Unit&) const {}
    __device__ __forceinline__ int nt(const Unit&, int K) const { return K / BK; }
    __device__ __forceinline__ size_t koff(const Unit&, int) const { return 0; }
};
struct UpOrder {
    StaticOrder so; int G, c;
    __device__ __forceinline__ void init(int M_, int G_, int c_) { so.init(M_, 40 * BM, G_, c_); G = G_; c = c_; }
    __device__ __forceinline__ bool next(int i, Unit& u) const {
        if (so.next(i, u)) return true;
        const long L = (long)i * G + c - so.nwg; if (L < 0 || L >= 256) return false;
        const int tt = (int)L >> 1; u.pm = tt & 31; u.pn = 40 + (tt >> 5); u.kq = 1 + ((int)L & 1); return true;
    }
    __device__ __forceinline__ void a_ready(const Unit&) const {}
    __device__ __forceinline__ void done(const Unit&) const {}
    __device__ __forceinline__ int nt(const Unit& u, int K) const { return u.kq ? K / (2 * BK) : K / BK; }
    __device__ __forceinline__ size_t koff(const Unit& u, int K) const { return u.kq == 2 ? (size_t)K : 0; }
};
typedef f32x4 Acc[2][2][4][2];

template <int MODE> __device__ __forceinline__ void store_tile_bf16(const Acc& acc, bf16_t* O, int ldc, int row0, int col0) {
#pragma unroll
    for (int ai = 0; ai < 2; ++ai)
#pragma unroll
        for (int m = 0; m < 4; ++m) { bf16_t* rowp = O + (size_t)(row0 + ai * HALF + m * 16) * ldc + col0;
#pragma unroll
            for (int bj = 0; bj < 2; ++bj) { f32x4 v0 = acc[ai][bj][m][0], v1 = acc[ai][bj][m][1];
                if (MODE == 1) { v0 = v0 * C2; v1 = v1 * C2; }
                if (MODE == 2) {
#pragma unroll
                    for (int e = 0; e < 4; ++e) { v0[e] = gelu_tanh_f(v0[e]); v1[e] = gelu_tanh_f(v1[e]); } }
                if (MODE == 3) {
#pragma unroll
                    for (int e = 0; e < 4; ++e) { v0[e] = sigmoid_f(v0[e]); v1[e] = sigmoid_f(v1[e]); } }
                u32x4 w; w.x = cvt_pk_bf16(v0[0], v0[1]); w.y = cvt_pk_bf16(v0[2], v0[3]); w.z = cvt_pk_bf16(v1[0], v1[1]); w.w = cvt_pk_bf16(v1[2], v1[3]);
                *(u32x4*)(rowp + bj * HALF) = w; } }
}
struct NoHook { static constexpr bool ON = false; __device__ __forceinline__ void operator()(Acc&, const Unit&, int, int, int, int, int) const {} };
struct EpiPlain {
    static constexpr bool PERM = true, AFTER_DRAIN = false;
    bf16_t* O; int ldc;
    __device__ __forceinline__ void operator()(Acc& acc, const Unit& u, int wr, int wc, int fr, int fq) const {
        store_tile_bf16<0>(acc, O, ldc, u.pm * BM + wr * 64 + fr, u.pn * BM + wc * 32 + 8 * fq); }
};
struct EpiProj {
    static constexpr bool PERM = true, AFTER_DRAIN = false;
    bf16_t* O; int ldc; unsigned char* G; const float* RS;
    __device__ __forceinline__ void operator()(Acc& acc, const Unit& u, int wr, int wc, int fr, int fq) const {
        const int pn = u.pn, row0 = u.pm * BM + wr * 64 + fr, col0 = pn * BM + wc * 32 + 8 * fq;
#pragma unroll
        for (int ai = 0; ai < 2; ++ai)
#pragma unroll
            for (int m = 0; m < 4; ++m) { const float sc = RS[row0 + ai * HALF + m * 16];
#pragma unroll
                for (int bj = 0; bj < 2; ++bj) { acc[ai][bj][m][0] = acc[ai][bj][m][0] * sc; acc[ai][bj][m][1] = acc[ai][bj][m][1] * sc; } }
        if (pn < 2 || (pn >= 16 && pn < 19)) store_tile_bf16<1>(acc, O, ldc, row0, col0);
        else if (pn >= 12 && pn < 16) store_tile_bf16<2>(acc, O, ldc, row0, col0);
        else if (pn >= 25) {
            const int gc0 = col0 - PC_G;
#pragma unroll
            for (int ai = 0; ai < 2; ++ai)
#pragma unroll
                for (int m = 0; m < 4; ++m) { unsigned char* rowp = G + (size_t)(row0 + ai * HALF + m * 16) * 8192 + gc0;
#pragma unroll
                    for (int bj = 0; bj < 2; ++bj) { u32x2 w = {0u, 0u};
#pragma unroll
                        for (int e = 0; e < 4; ++e) { w.x = __builtin_amdgcn_cvt_pk_u8_f32(fmaxf(255.0f * sigmoid_f(acc[ai][bj][m][0][e]) + 0.5f, 1.0f), e, w.x);
                                                      w.y = __builtin_amdgcn_cvt_pk_u8_f32(fmaxf(255.0f * sigmoid_f(acc[ai][bj][m][1][e]) + 0.5f, 1.0f), e, w.y); }
                        *(u32x2*)(rowp + bj * HALF) = w; } }
        }
        else store_tile_bf16<0>(acc, O, ldc, row0, col0);
    }
};
__device__ __forceinline__ void row_scales(float (&rs)[2][4], const float* PART, int row0, int fr, int fq) {
    const int ln = fq * 16 + fr;
#pragma unroll
    for (int ai = 0; ai < 2; ++ai)
#pragma unroll
        for (int m = 0; m < 4; ++m) { const float* p = PART + (size_t)(row0 + ai * HALF + m * 16) * 32 + 8 * fq; const f32x4 a = *(const f32x4*)p, b = *(const f32x4*)(p + 4);
            float s = ((a.x + a.y) + (a.z + a.w)) + ((b.x + b.y) + (b.z + b.w)); s += shx(s, 16, ln); s += shx(s, 32, ln);
            rs[ai][m] = 1.0f / sqrtf(s * (1.0f / DM) + EPS); }
}
struct EpiUp8 {
    static constexpr bool PERM = true, AFTER_DRAIN = false;
    bf16_t* O; int ldc; const float* AS; const float* WS1; bf16_t* O2; int ldc2, c2;
    __device__ __forceinline__ void operator()(Acc& acc, const Unit& u, int wr, int wc, int fr, int fq) const {
        const int row0 = u.pm * BM + wr * 64 + fr; const float wqs = *WS1;
#pragma unroll
        for (int ai = 0; ai < 2; ++ai)
#pragma unroll
            for (int m = 0; m < 4; ++m) { const float sc = AS[row0 + ai * HALF + m * 16] * wqs;
#pragma unroll
                for (int bj = 0; bj < 2; ++bj)
#pragma unroll
                    for (int n = 0; n < 2; ++n) { const v4i a = __builtin_bit_cast(v4i, acc[ai][bj][m][n]); acc[ai][bj][m][n] = (f32x4){(float)a[0], (float)a[1], (float)a[2], (float)a[3]} * sc; } }
        if (u.kq == 2) store_tile_bf16<0>(acc, O2, ldc2, row0, u.pn * BM - c2 + wc * 32 + 8 * fq);
        else store_tile_bf16<0>(acc, O, ldc, row0, u.pn * BM + wc * 32 + 8 * fq); }
};
struct EpiGate8 {
    static constexpr bool PERM = true, AFTER_DRAIN = false;
    unsigned char* G; const float* AS; const float* WS1; bf16_t* O; int ldc;
    __device__ __forceinline__ void operator()(Acc& acc, const Unit& u, int wr, int wc, int fr, int fq) const {
        const int row0 = u.pm * BM + wr * 64 + fr; const float wqs = *WS1;
        if (u.pn < N8T) {
#pragma unroll
            for (int ai = 0; ai < 2; ++ai)
#pragma unroll
                for (int m = 0; m < 4; ++m) { const float sc = AS[row0 + ai * HALF + m * 16] * wqs;
#pragma unroll
                    for (int bj = 0; bj < 2; ++bj)
#pragma unroll
                        for (int n = 0; n < 2; ++n) { const v4i a = __builtin_bit_cast(v4i, acc[ai][bj][m][n]); acc[ai][bj][m][n] = (f32x4){(float)a[0], (float)a[1], (float)a[2], (float)a[3]} * sc; } }
            const int pt = nth_set(I8MASK, u.pn), col0 = pt * BM + wc * 32 + 8 * fq;
            if (pt < 2 || (pt >= 16 && pt < 19)) store_tile_bf16<1>(acc, O, ldc, row0, col0);
            else if (pt >= 12 && pt < 16) store_tile_bf16<2>(acc, O, ldc, row0, col0);
            else store_tile_bf16<0>(acc, O, ldc, row0, col0);
            return;
        }
        const int gc0 = (u.pn - N8T) * BM + wc * 32 + 8 * fq;
        float as8[2][4];
#pragma unroll
        for (int ai = 0; ai < 2; ++ai)
#pragma unroll
            for (int m = 0; m < 4; ++m) as8[ai][m] = AS[row0 + ai * HALF + m * 16];
#pragma unroll
        for (int ai = 0; ai < 2; ++ai)
#pragma unroll
            for (int m = 0; m < 4; ++m) { unsigned char* rowp = G + (size_t)(row0 + ai * HALF + m * 16) * 8192 + gc0; const float sc = -LOG2E * as8[ai][m] * wqs;
#pragma unroll
                for (int bj = 0; bj < 2; ++bj) { u32x2 w = {0u, 0u}; const v4i a0 = __builtin_bit_cast(v4i, acc[ai][bj][m][0]), a1 = __builtin_bit_cast(v4i, acc[ai][bj][m][1]);
#pragma unroll
                    for (int e = 0; e < 4; ++e) { w.x = __builtin_amdgcn_cvt_pk_u8_f32(fmaxf(__builtin_fmaf(255.0f, fast_rcp(1.0f + fast_exp2(sc * (float)a0[e])), 0.5f), 1.0f), e, w.x);
                                                  w.y = __builtin_amdgcn_cvt_pk_u8_f32(fmaxf(__builtin_fmaf(255.0f, fast_rcp(1.0f + fast_exp2(sc * (float)a1[e])), 0.5f), 1.0f), e, w.y); }
                    *(u32x2*)(rowp + bj * HALF) = w; } }
    }
};
struct EpiResidN {
    static constexpr bool PERM = true, AFTER_DRAIN = false;
    bf16_t* XR; float* SS;
    __device__ __forceinline__ void operator()(Acc& acc, const Unit& u, int wr, int wc, int fr, int fq) const {
        const int row0 = u.pm * BM + wr * 64 + fr, col0 = u.pn * BM + wc * 32 + 8 * fq;
#pragma unroll
        for (int ai = 0; ai < 2; ++ai) { u32x4 b[4][2];
#pragma unroll
            for (int m = 0; m < 4; ++m)
#pragma unroll
                for (int bj = 0; bj < 2; ++bj) b[m][bj] = *(const u32x4*)(XR + (size_t)(row0 + ai * HALF + m * 16) * DM + col0 + bj * HALF);
#pragma unroll
            for (int m = 0; m < 4; ++m) { const int row = row0 + ai * HALF + m * 16; float ss = 0.f;
#pragma unroll
                for (int bj = 0; bj < 2; ++bj) { const u32x4 x = b[m][bj];
                    const f32x4 v0 = (f32x4){bf_lo(x.x), bf_hi(x.x), bf_lo(x.y), bf_hi(x.y)} + acc[ai][bj][m][0], v1 = (f32x4){bf_lo(x.z), bf_hi(x.z), bf_lo(x.w), bf_hi(x.w)} + acc[ai][bj][m][1];
                    u32x4 w; w.x = cvt_pk_bf16(v0[0], v0[1]); w.y = cvt_pk_bf16(v0[2], v0[3]); w.z = cvt_pk_bf16(v1[0], v1[1]); w.w = cvt_pk_bf16(v1[2], v1[3]);
                    *(u32x4*)(XR + (size_t)row * DM + col0 + bj * HALF) = w;
                    ss += (v0[0] * v0[0] + v0[1] * v0[1]) + (v0[2] * v0[2] + v0[3] * v0[3]) + (v1[0] * v1[0] + v1[1] * v1[1]) + (v1[2] * v1[2] + v1[3] * v1[3]); }
                if (SS) { const int ln = fq * 16 + fr; ss += shx(ss, 16, ln); ss += shx(ss, 32, ln);
                    if (fq == 0) SS[(size_t)row * 32 + 4 * u.pn + wc] = ss; } }
            asm volatile("" ::: "memory"); }
    }
};
struct EpiPle {
    static constexpr bool PERM = true, AFTER_DRAIN = false;
    const bf16_t* XR; bf16_t* XO; const bf16_t* PP; const float* SS;
    __device__ __forceinline__ void operator()(Acc& acc, const Unit& u, int wr, int wc, int fr, int fq) const {
        const int row0 = u.pm * BM + wr * 64 + fr, col0 = u.pn * BM + wc * 32 + 8 * fq; float rs[2][4]; row_scales(rs, SS, row0, fr, fq);
#pragma unroll
        for (int ai = 0; ai < 2; ++ai)
#pragma unroll
            for (int mp = 0; mp < 2; ++mp) { u32x4 b[2][2], pp[2][2];
#pragma unroll
                for (int mm = 0; mm < 2; ++mm)
#pragma unroll
                    for (int bj = 0; bj < 2; ++bj) { const size_t off = (size_t)(row0 + ai * HALF + (2 * mp + mm) * 16) * DM + col0 + bj * HALF; b[mm][bj] = *(const u32x4*)(XR + off); pp[mm][bj] = *(const u32x4*)(PP + off); }
#pragma unroll
                for (int mm = 0; mm < 2; ++mm) { const float r = rs[ai][2 * mp + mm];
#pragma unroll
                    for (int bj = 0; bj < 2; ++bj) { const size_t off = (size_t)(row0 + ai * HALF + (2 * mp + mm) * 16) * DM + col0 + bj * HALF; const u32x4 x = b[mm][bj], p = pp[mm][bj];
                        const f32x4 a0 = acc[ai][bj][2 * mp + mm][0] * r, a1 = acc[ai][bj][2 * mp + mm][1] * r; u32x4 w;
                        w.x = cvt_pk_bf16(bf_lo(x.x) + sigmoid_f(a0[0]) * bf_lo(p.x), bf_hi(x.x) + sigmoid_f(a0[1]) * bf_hi(p.x)); w.y = cvt_pk_bf16(bf_lo(x.y) + sigmoid_f(a0[2]) * bf_lo(p.y), bf_hi(x.y) + sigmoid_f(a0[3]) * bf_hi(p.y));
                        w.z = cvt_pk_bf16(bf_lo(x.z) + sigmoid_f(a1[0]) * bf_lo(p.z), bf_hi(x.z) + sigmoid_f(a1[1]) * bf_hi(p.z)); w.w = cvt_pk_bf16(bf_lo(x.w) + sigmoid_f(a1[2]) * bf_lo(p.w), bf_hi(x.w) + sigmoid_f(a1[3]) * bf_hi(p.w));
                        *(u32x4*)(XO + off) = w; } }
                asm volatile("" ::: "memory"); }
    }
};
struct MergeHook {
    static constexpr bool ON = true;
    const unsigned char* G;
    __device__ __forceinline__ void operator()(Acc& acc, const Unit& u, int t, int wr, int wc, int fr, int fq) const {
        const int j = (t >> 3) - 1;
        unsigned off0 = (unsigned)((u.pm * BM + wr * 64 + fr) * 8192 + u.pn * BM + wc * 32 + 8 * fq);
        asm volatile("" : "+v"(off0));
        const unsigned char* gj = G + j * 2048;
#pragma unroll
        for (int ai = 0; ai < 2; ++ai) {
#pragma unroll
            for (int m = 0; m < 4; ++m) { const unsigned char* gp = gj + (off0 + (unsigned)((ai * HALF + m * 16) * 8192));
#pragma unroll
                for (int bj = 0; bj < 2; ++bj) { const u32x2 a = *(const u32x2*)(gp + bj * HALF), b = *(const u32x2*)(gp + 2048 + bj * HALF);
                    f32x4 r0, r1;
                    r0[0] = ub0(a.x) * fast_rcp(ub0(b.x)); r0[1] = ub1(a.x) * fast_rcp(ub1(b.x));
                    r0[2] = ub2(a.x) * fast_rcp(ub2(b.x)); r0[3] = ub3(a.x) * fast_rcp(ub3(b.x));
                    r1[0] = ub0(a.y) * fast_rcp(ub0(b.y)); r1[1] = ub1(a.y) * fast_rcp(ub1(b.y));
                    r1[2] = ub2(a.y) * fast_rcp(ub2(b.y)); r1[3] = ub3(a.y) * fast_rcp(ub3(b.y));
                    acc[ai][bj][m][0] = acc[ai][bj][m][0] * r0; acc[ai][bj][m][1] = acc[ai][bj][m][1] * r1; } }
            }
    }
};
struct EpiMerge {
    static constexpr bool PERM = true, AFTER_DRAIN = false;
    bf16_t* O; int ldc; const unsigned char* G3;
    __device__ __forceinline__ void operator()(Acc& acc, const Unit& u, int wr, int wc, int fr, int fq) const {
        const int row0 = u.pm * BM + wr * 64 + fr, col0 = u.pn * BM + wc * 32 + 8 * fq; const float s = 1.0f / 255.0f;
#pragma unroll
        for (int ai = 0; ai < 2; ++ai) { u32x2 g[4][2];
#pragma unroll
            for (int m = 0; m < 4; ++m)
#pragma unroll
                for (int bj = 0; bj < 2; ++bj) g[m][bj] = *(const u32x2*)(G3 + (size_t)(row0 + ai * HALF + m * 16) * 8192 + col0 + bj * HALF);
#pragma unroll
            for (int m = 0; m < 4; ++m)
#pragma unroll
                for (int bj = 0; bj < 2; ++bj) { const u32x2 gg = g[m][bj]; const f32x4 v0 = acc[ai][bj][m][0] * s, v1 = acc[ai][bj][m][1] * s;
                    u32x4 w; w.x = cvt_pk_bf16(v0[0] * ub0(gg.x), v0[1] * ub1(gg.x)); w.y = cvt_pk_bf16(v0[2] * ub2(gg.x), v0[3] * ub3(gg.x));
                    w.z = cvt_pk_bf16(v1[0] * ub0(gg.y), v1[1] * ub1(gg.y)); w.w = cvt_pk_bf16(v1[2] * ub2(gg.y), v1[3] * ub3(gg.y));
                    *(u32x4*)(O + (size_t)(row0 + ai * HALF + m * 16) * ldc + col0 + bj * HALF) = w; }
            asm volatile("" ::: "memory"); }
    }
};

template <class Epi, class Hook, class Sched, bool I8 = false>
__device__ __forceinline__ void gemm_phase(PG8_LAS unsigned char* lds, const Gemm g, const Sched& S, const Epi& E, const Hook& H, int tid) {
    asm volatile("" : "+v"(tid));
    const int wid = __builtin_amdgcn_readfirstlane(tid >> 6), lane = tid & 63, wr = wid >> 2, wc = wid & 3, fr = lane & 15, fq = lane >> 4;
    const int K = g.K;
    unsigned voffA[2], voffB[2];
#pragma unroll
    for (int i = 0; i < 2; ++i) { int R, C; stage_rc(tid * 16 + i * 8192, R, C); const int Rb = Epi::PERM ? ((R & ~31) + perm32(R & 31)) : R;
        voffA[i] = (unsigned)(R * K + C) * 2u; voffB[i] = (unsigned)(Rb * K + C) * 2u; }
    const size_t kstep = (size_t)(BK * 2);
    const size_t hstep = (size_t)HALF * K * 2;
    const size_t tstep = 2 * hstep;
    const unsigned ldsw = (unsigned)wid * 1024u;
    const int aoff = lds_byte(wr * 64 + fr, fq * 8), boff = lds_byte(wc * 32 + fr, fq * 8);
#define PG8_SA(b, h) (((b) * 2 + (h)) * HTB)
#define PG8_SB(b, h) ((4 + (b) * 2 + (h)) * HTB)
#define PG8_STAGE(bufoff, gbase, voff) do { _Pragma("unroll") for (int _i = 0; _i < 2; ++_i) \
        __builtin_amdgcn_global_load_lds((const unsigned*)((const char*)(gbase) + (voff)[_i]), (PG8_LAS unsigned*)(lds + (bufoff) + ldsw + _i * 8192), 16, 0, 0); } while (0)
#define PG8_LDA(dst, b, h) do { _Pragma("unroll") for (int m = 0; m < 4; ++m) _Pragma("unroll") for (int k = 0; k < 2; ++k) dst[m][k] = *(const PG8_LAS bf16x8*)(lds + PG8_SA(b, h) + aoff + m * 2048 + k * 1024); } while (0)
#define PG8_LDB(dst, b, h) do { _Pragma("unroll") for (int n = 0; n < 2; ++n) _Pragma("unroll") for (int k = 0; k < 2; ++k) dst[n][k] = *(const PG8_LAS bf16x8*)(lds + PG8_SB(b, h) + boff + n * 2048 + k * 1024); } while (0)
#define PG8_MMA(ai, bj, At, Bt) do { __builtin_amdgcn_s_setprio(1); _Pragma("unroll") for (int m = 0; m < 4; ++m) _Pragma("unroll") for (int n = 0; n < 2; ++n) _Pragma("unroll") for (int k = 0; k < 2; ++k) { \
        if constexpr (I8) acc[ai][bj][m][n] = __builtin_bit_cast(f32x4, __builtin_amdgcn_mfma_i32_16x16x64_i8(__builtin_bit_cast(v4i, Bt[n][k]), __builtin_bit_cast(v4i, At[m][k]), __builtin_bit_cast(v4i, acc[ai][bj][m][n]), 0, 0, 0)); \
        else acc[ai][bj][m][n] = __builtin_amdgcn_mfma_f32_16x16x32_bf16(Bt[n][k], At[m][k], acc[ai][bj][m][n], 0, 0, 0); } \
        __builtin_amdgcn_s_setprio(0); } while (0)
#define PG8_WAIT_V(n) asm volatile("s_waitcnt vmcnt(" #n ")" ::: "memory")
#define PG8_WAIT_L(n) asm volatile("s_waitcnt lgkmcnt(" #n ")" ::: "memory")
#define PG8_BAR __builtin_amdgcn_s_barrier()
#define PG8_SCHED __builtin_amdgcn_sched_barrier(0)
    Unit cur, nxt; int ui = 0;
    if (!S.next(0, cur)) return;
    Acc acc;
#pragma unroll
    for (int a = 0; a < 2; ++a)
#pragma unroll
        for (int b = 0; b < 2; ++b)
#pragma unroll
            for (int m = 0; m < 4; ++m)
#pragma unroll
                for (int n = 0; n < 2; ++n) acc[a][b][m][n] = (f32x4){0.f, 0.f, 0.f, 0.f};
    bf16x8 At[4][2], B0[2][2], B1[2][2];
    int nt = S.nt(cur, K);
    const char* cA = (const char*)g.A + (size_t)cur.pm * tstep + S.koff(cur, K); const char* cB = (const char*)g.Bt + (size_t)cur.pn * tstep + S.koff(cur, K);
    S.a_ready(cur);
    PG8_STAGE(PG8_SB(0, 0), cB, voffB); PG8_STAGE(PG8_SB(0, 1), cB + hstep, voffB); PG8_STAGE(PG8_SA(0, 0), cA, voffA); PG8_STAGE(PG8_SA(0, 1), cA + hstep, voffA);
    if (wr == 1) PG8_BAR;
    PG8_WAIT_V(2); PG8_BAR;
    PG8_STAGE(PG8_SB(1, 0), cB + kstep, voffB); PG8_STAGE(PG8_SA(1, 0), cA + kstep, voffA); PG8_STAGE(PG8_SB(1, 1), cB + hstep + kstep, voffB);
    PG8_WAIT_V(6); PG8_BAR;
    for (;;) {
        const bool has_next = S.next(ui + 1, nxt);
        const char* nA = has_next ? (const char*)g.A + (size_t)nxt.pm * tstep + S.koff(nxt, K) : cA; const char* nB = has_next ? (const char*)g.Bt + (size_t)nxt.pn * tstep + S.koff(nxt, K) : cB;
        for (int t = 0; t < nt; t += 2) {
            if constexpr (Hook::ON) { if (t != 0 && (t & 7) == 0) H(acc, cur, t, wr, wc, fr, fq); }
            const bool last = (t == nt - 2);
            const char* a1 = cA + (size_t)(t + 1) * kstep;
            const char* a2 = last ? nA : cA + (size_t)(t + 2) * kstep; const char* b2 = last ? nB : cB + (size_t)(t + 2) * kstep;
            const char* a3 = a2 + kstep; const char* b3 = b2 + kstep;
            if (last && has_next) S.a_ready(nxt);
            PG8_LDB(B0, 0, 0); PG8_LDB(B1, 0, 1); PG8_SCHED; PG8_LDA(At, 0, 0); PG8_STAGE(PG8_SA(1, 1), a1 + hstep, voffA);
            PG8_WAIT_V(8); PG8_WAIT_L(0); PG8_BAR; PG8_MMA(0, 0, At, B0); PG8_MMA(0, 1, At, B1); PG8_BAR; PG8_SCHED;
            PG8_LDA(At, 0, 1); PG8_STAGE(PG8_SB(0, 0), b2, voffB); PG8_STAGE(PG8_SB(0, 1), b2 + hstep, voffB); PG8_STAGE(PG8_SA(0, 0), a2, voffA);
            PG8_WAIT_V(8); PG8_WAIT_L(0); PG8_BAR; PG8_MMA(1, 0, At, B0); PG8_MMA(1, 1, At, B1); PG8_BAR; PG8_SCHED;
            PG8_LDB(B0, 1, 0); PG8_LDB(B1, 1, 1); PG8_SCHED; PG8_LDA(At, 1, 0); PG8_STAGE(PG8_SA(0, 1), a2 + hstep, voffA);
            PG8_WAIT_V(8); PG8_WAIT_L(0); PG8_BAR; PG8_MMA(0, 0, At, B0); PG8_MMA(0, 1, At, B1); PG8_BAR; PG8_SCHED;
            PG8_LDA(At, 1, 1); PG8_STAGE(PG8_SB(1, 0), b3, voffB); PG8_STAGE(PG8_SB(1, 1), b3 + hstep, voffB); PG8_STAGE(PG8_SA(1, 0), a3, voffA);
            PG8_WAIT_V(8); PG8_WAIT_L(0); PG8_BAR; PG8_MMA(1, 0, At, B0); PG8_MMA(1, 1, At, B1); PG8_BAR; PG8_SCHED;
        }
        if (wr == 0) PG8_BAR;
        E(acc, cur, wr, wc, fr, fq); S.done(cur);
        if (!has_next) break;
#pragma unroll
        for (int a = 0; a < 2; ++a)
#pragma unroll
            for (int b = 0; b < 2; ++b)
#pragma unroll
                for (int m = 0; m < 4; ++m)
#pragma unroll
                    for (int n = 0; n < 2; ++n) acc[a][b][m][n] = (f32x4){0.f, 0.f, 0.f, 0.f};
        cur = nxt; cA = nA; cB = nB; ++ui; nt = S.nt(cur, K);
        if (wr == 1) PG8_BAR;
    }
    PG8_WAIT_V(0);
    PG8_BAR;
#undef PG8_SA
#undef PG8_SB
#undef PG8_STAGE
#undef PG8_LDA
#undef PG8_LDB
#undef PG8_MMA
#undef PG8_WAIT_V
#undef PG8_WAIT_L
#undef PG8_BAR
#undef PG8_SCHED
}
}

#define XB_TMO      128
#define XB_XCNT(j)  (256  + 64 * (j))
#define XB_XSUB(j)  (1280 + 64 * (j))
#define XB_XGEN(j)  (2304 + 64 * (j))
#define XB_TOP      3328
#define XB_TOPGEN   3392
#define XCD_BAR_WORDS 3456
#define XB_SPIN_CAP (1u << 18)
__device__ __forceinline__ unsigned xb_ld(unsigned* p)              { return __hip_atomic_load(p, __ATOMIC_RELAXED, __HIP_MEMORY_SCOPE_AGENT); }
__device__ __forceinline__ unsigned xb_add(unsigned* p, unsigned v) { return __hip_atomic_fetch_add(p, v, __ATOMIC_RELAXED, __HIP_MEMORY_SCOPE_AGENT); }
__device__ __forceinline__ unsigned xb_xcc_id() { return (unsigned)__builtin_amdgcn_s_getreg((3 << 11) | 20) & 0xFu; }
#define XB_SPIN(cond, bar) do { unsigned _sp = 0; while (cond) { __builtin_amdgcn_s_sleep(1); \
    if ((++_sp & 255u) == 0u) { if (xb_ld(&(bar)[XB_TMO])) break; if (_sp > XB_SPIN_CAP) { atomicAdd(&(bar)[XB_TMO], 1u); break; } } } } while (0)
struct XcdBarrier { unsigned* bar; unsigned x; volatile LAS unsigned* st; };
__device__ __forceinline__ XcdBarrier xcd_barrier_post(unsigned* bar, volatile LAS unsigned* st) {
    XcdBarrier b; b.bar = bar; b.x = xb_xcc_id(); b.st = st;
    if (threadIdx.x == 0) (void)xb_add(&bar[XB_XCNT(b.x)], 1u);
    return b;
}
__device__ __forceinline__ void xcd_barrier_complete(unsigned* bar, unsigned x, unsigned& nloc, unsigned& nx) {
    const unsigned G = gridDim.x * gridDim.y * gridDim.z;
    unsigned sum, cnt, mine, sp = 0u;
    for (;;) {
        sum = 0u; cnt = 0u; mine = 0u;
#pragma unroll
        for (unsigned j = 0; j < 16; ++j) { const unsigned c = xb_ld(&bar[XB_XCNT(j)]); sum += c; cnt += (c > 0u) ? 1u : 0u; mine = (j == x) ? c : mine; }
        if (sum == G) break;
        __builtin_amdgcn_s_sleep(1);
        if ((++sp & 255u) == 0u) { if (xb_ld(&bar[XB_TMO])) break; if (sp > XB_SPIN_CAP) { atomicAdd(&bar[XB_TMO], 1u); break; } }
    }
    nloc = mine > 0u ? mine : 1u; nx = cnt > 0u ? cnt : 1u;
}
__device__ __forceinline__ void xcd_barrier(const XcdBarrier& b) {
    asm volatile("s_waitcnt vmcnt(0)" ::: "memory");
    __syncthreads();
    if (threadIdx.x == 0) {
        unsigned* bar = b.bar;
        __builtin_amdgcn_s_waitcnt(0);
        unsigned nloc = b.st[0], nx = b.st[1];
        if (nloc == 0u) { xcd_barrier_complete(bar, b.x, nloc, nx); b.st[0] = nloc; b.st[1] = nx; }
        const unsigned old = xb_add(&bar[XB_XSUB(b.x)], 1u);
        const unsigned gen = old / nloc;
        if (old + 1u == (gen + 1u) * nloc) {
            __builtin_amdgcn_fence(__ATOMIC_RELEASE, "agent");
            asm volatile("s_waitcnt vmcnt(0)" ::: "memory");
            const unsigned og = xb_add(&bar[XB_TOP], 1u);
            const unsigned tg = og / nx;
            if (og + 1u == (tg + 1u) * nx) xb_add(&bar[XB_TOPGEN], 1u);
            else XB_SPIN(xb_ld(&bar[XB_TOPGEN]) == tg, bar);
            __builtin_amdgcn_fence(__ATOMIC_ACQUIRE, "agent");
            xb_add(&bar[XB_XGEN(b.x)], 1u);
            asm volatile("s_waitcnt vmcnt(0)" ::: "memory");
        } else {
            XB_SPIN(xb_ld(&bar[XB_XGEN(b.x)]) == gen, bar);
            __builtin_amdgcn_fence(__ATOMIC_ACQUIRE, "agent");
            asm volatile("s_waitcnt vmcnt(0)" ::: "memory");
        }
    }
    __syncthreads();
}

__device__ const float c_one[1] = {1.0f};
struct TrDesc { const float* W; const float* gk; bf16_t* WT; int ldw, scol0, ldt, drow0, dk0, kb, nb, f8; float qinv; };
__device__ __forceinline__ void tr_load(f32x4 (&v)[8], float (&g)[8], const TrDesc& d, int lane) {
    const float* p = d.W + (size_t)(64 * d.kb + (lane >> 3)) * d.ldw + d.scol0 + 32 * d.nb + 4 * (lane & 7);
    const GAS float* gp = d.gk ? (const GAS float*)d.gk + 64 * d.kb + (lane >> 3) : (const GAS float*)c_one; const int gs = d.gk ? 8 : 0;
#pragma unroll
    for (int i = 0; i < 8; ++i) v[i] = __builtin_nontemporal_load((const f32x4*)(p + (size_t)(8 * i) * d.ldw));
#pragma unroll
    for (int i = 0; i < 8; ++i) g[i] = gp[i * gs];
}
__device__ __forceinline__ void tr_store(const f32x4 (&v)[8], const float (&g)[8], const TrDesc& d, LAS float* scr, int lane) {
    const int kr = lane >> 3, q = lane & 7;
#pragma unroll
    for (int i = 0; i < 8; ++i) { LAS float* s = scr + (8 * i + kr) * 33 + 4 * q; s[0] = v[i].x * g[i]; s[1] = v[i].y * g[i]; s[2] = v[i].z * g[i]; s[3] = v[i].w * g[i]; }
    LDS_WAIT(); asm volatile("" ::: "memory");
    const int c = lane & 7;
#pragma unroll
    for (int j = 0; j < 4; ++j) { const int n = (lane >> 3) + 8 * j; const LAS float* s = scr + (8 * c) * 33 + n;
        u32x4 o; o.x = cvt_pk_bf16(s[0 * 33], s[1 * 33]); o.y = cvt_pk_bf16(s[2 * 33], s[3 * 33]); o.z = cvt_pk_bf16(s[4 * 33], s[5 * 33]); o.w = cvt_pk_bf16(s[6 * 33], s[7 * 33]);
        if (d.f8) { const float qv = d.qinv; u32x2 o8; o8.x = q8x4(qv * s[0 * 33], qv * s[1 * 33], qv * s[2 * 33], qv * s[3 * 33]); o8.y = q8x4(qv * s[4 * 33], qv * s[5 * 33], qv * s[6 * 33], qv * s[7 * 33]);
            __builtin_nontemporal_store(o8, (u32x2*)((unsigned char*)d.WT + (size_t)(d.drow0 + 32 * d.nb + n) * d.ldt + d.dk0 + 64 * d.kb + 8 * c)); }
        else __builtin_nontemporal_store(o, (u32x4*)(d.WT + (size_t)(d.drow0 + 32 * d.nb + n) * d.ldt + d.dk0 + 64 * d.kb + 8 * c)); }
    LDS_WAIT(); asm volatile("" ::: "memory");
}

struct Args { const float* in[23]; float* out; unsigned char* ws; int ph_lo, ph_hi, li, pad; };

template <bool FORGET, bool FINAL, bool INBF>
__device__ __forceinline__ void norm_phase(const float* X, const bf16_t* Xb, bf16_t* XN, float* RS, unsigned* XN8, float* AS8, const float* gq, const float* wfg, const float* fb, float* logf, const float* gfin, float* outf,
                                           LAS unsigned char* lds, int gw, int NGW, int lane, int tid) {
    const bool late_fill = FORGET && NGW * 4 <= M;
    if (FORGET) {
#pragma unroll
        for (int i = 0; i < 8; ++i) __builtin_amdgcn_global_load_lds((const unsigned*)(wfg + 4 * (tid + 512 * i)), (LAS unsigned*)(lds + ((tid & ~63) + 512 * i) * 16), 16, 0, 0);
        if (!late_fill) { VM_WAIT(); __syncthreads(); }
    }
    for (int m0 = gw * 4; m0 < M; m0 += NGW * 4) {
        f32x4 v[4][8]; float rr[4];
#pragma unroll
        for (int r = 0; r < 4; ++r) {
            if (INBF) { const GAS u32x4* xr = (const GAS u32x4*)(Xb + (size_t)(m0 + r) * DM) + lane;
#pragma unroll
                for (int jj = 0; jj < 4; ++jj) { const u32x4 w = xr[64 * jj]; v[r][2 * jj] = (f32x4){bf_lo(w.x), bf_hi(w.x), bf_lo(w.y), bf_hi(w.y)}; v[r][2 * jj + 1] = (f32x4){bf_lo(w.z), bf_hi(w.z), bf_lo(w.w), bf_hi(w.w)}; }
            } else { const GAS f32x4* xr = (const GAS f32x4*)(X + (size_t)(m0 + r) * DM) + lane;
#pragma unroll
                for (int j = 0; j < 8; ++j) v[r][j] = xr[64 * j]; } }
#define NQ(j) (INBF ? (128 * ((j) >> 1) + 2 * lane + ((j) & 1)) : (64 * (j) + lane))
        if (FORGET) { if (late_fill && m0 == gw * 4) { VM_WAIT(); __syncthreads(); } }
#pragma unroll
        for (int r = 0; r < 4; ++r) { float s = 0.f;
#pragma unroll
            for (int j = 0; j < 8; ++j) s += (v[r][j].x * v[r][j].x + v[r][j].y * v[r][j].y) + (v[r][j].z * v[r][j].z + v[r][j].w * v[r][j].w);
            rr[r] = 1.0f / sqrtf(wave_sum(s, lane) * (1.0f / DM) + EPS); }
        if (FINAL) {
            f32x4 gf4[8];
#pragma unroll
            for (int j = 0; j < 8; ++j) gf4[j] = ((const GAS f32x4*)gfin)[NQ(j)];
#pragma unroll
            for (int r = 0; r < 4; ++r) { GAS f32x4* o = (GAS f32x4*)(outf + (size_t)(m0 + r) * DM);
#pragma unroll
                for (int j = 0; j < 8; ++j) o[NQ(j)] = v[r][j] * rr[r] * gf4[j]; }
        } else {
            f32x4 gq4[8];
#pragma unroll
            for (int j = 0; j < 8; ++j) gq4[j] = ((const GAS f32x4*)gq)[NQ(j)];
#pragma unroll
            for (int r = 0; r < 4; ++r) { GAS u32x2* o = (GAS u32x2*)(XN + (size_t)(m0 + r) * DM); GAS unsigned* o8 = (GAS unsigned*)(XN8 + (size_t)(m0 + r) * (DM / 4));
                float mx = 0.f;
#pragma unroll
                for (int j = 0; j < 8; ++j) { const f32x4 y = v[r][j] * gq4[j]; mx = fmaxf(mx, fmaxf(fmaxf(fabsf(y.x), fabsf(y.y)), fmaxf(fabsf(y.z), fabsf(y.w)))); }
                mx = fmaxf(wave_max(mx, lane) * rr[r], 1e-20f); const float qi = rr[r] * 127.0f / mx;
                if (lane == 0) { AS8[m0 + r] = mx * (1.0f / 127.0f); if (RS) RS[m0 + r] = rr[r]; }
#pragma unroll
                for (int j = 0; j < 8; ++j) { if (XN) { const f32x4 t = v[r][j] * rr[r]; u32x2 w; w.x = cvt_pk_bf16(t.x, t.y); w.y = cvt_pk_bf16(t.z, t.w); o[NQ(j)] = w; }
                    const f32x4 y = v[r][j] * gq4[j] * qi; o8[NQ(j)] = q8x4(y.x, y.y, y.z, y.w); } }
        }
        if (FORGET) {
#pragma unroll 1
            for (int h = 0; h < 8; ++h) {
                float a0 = 0.f, a1 = 0.f, a2 = 0.f, a3 = 0.f;
#pragma unroll
                for (int j = 0; j < 8; ++j) { const f32x4 w = *((LAS f32x4*)lds + h * 512 + NQ(j));
                    a0 += (v[0][j].x * w.x + v[0][j].y * w.y) + (v[0][j].z * w.z + v[0][j].w * w.w);
                    a1 += (v[1][j].x * w.x + v[1][j].y * w.y) + (v[1][j].z * w.z + v[1][j].w * w.w);
                    a2 += (v[2][j].x * w.x + v[2][j].y * w.y) + (v[2][j].z * w.z + v[2][j].w * w.w);
                    a3 += (v[3][j].x * w.x + v[3][j].y * w.y) + (v[3][j].z * w.z + v[3][j].w * w.w); }
                a0 = wave_sum(a0, lane); a1 = wave_sum(a1, lane); a2 = wave_sum(a2, lane); a3 = wave_sum(a3, lane);
                const float bh = fb[h];
                const float z = (lane == 0 ? a0 * rr[0] : lane == 1 ? a1 * rr[1] : lane == 2 ? a2 * rr[2] : a3 * rr[3]) + bh;
                const float az = fabsf(z);
                const float ls = fminf(z, 0.f) - 0.6931471805599453f * __builtin_amdgcn_logf(1.0f + fast_exp2(-LOG2E * az));
                if (lane < 4) logf[(size_t)h * M + m0 + lane] = ls;
            }
        }
    }
#undef NQ
}

namespace att {
constexpr int LDS_K = 0, LDS_V = 8192, LDS_BUF = 16384, LDS_SV = 32768, LDS_WS = 65536, LDS_QW = 67584, LDS_FL = 69632;
constexpr float NEG = -1e30f;
__device__ __forceinline__ int crow(int r, int hi) { return (r & 3) + 8 * (r >> 2) + 4 * hi; }
__device__ __forceinline__ s16x4 vtr(const LAS unsigned char* p) { return __builtin_bit_cast(s16x4, __builtin_amdgcn_ds_read_tr16_b64_v4i16((LAS s16x4*)p)); }
__device__ __forceinline__ float max3f(float a, float b, float c) { float r; asm("v_max3_f32 %0, %1, %2, %3" : "=v"(r) : "v"(a), "v"(b), "v"(c)); return r; }
__device__ __forceinline__ float rowmax32(const f32x16& p0, const f32x16& p1) {
    float a = max3f(p0[0], p0[1], p1[0]), b = max3f(p0[2], p0[3], p1[1]); a = max3f(a, p1[2], p1[3]);
#pragma unroll
    for (int r = 4; r < 16; r += 4) { a = max3f(a, p0[r], p0[r + 1]); b = max3f(b, p0[r + 2], p0[r + 3]); a = max3f(a, p1[r], p1[r + 1]); b = max3f(b, p1[r + 2], p1[r + 3]); }
    return fmaxf(a, b);
}
struct AttnArgs {
    const bf16_t *Q, *K, *V; long rs;
    int q0, kbase, jlo, jhi;
    const float* Fl;
    const float* rope; long rrs;
    bf16_t* Ob; float* Of; long ors;
    float* lse; long lrs;
};
__device__ __forceinline__ u32x4 rope8(u32x4 x1, u32x4 x2, const f32x4 c0, const f32x4 c1, const f32x4 s0, const f32x4 s1, bool first) {
    float a[8], b[8], c[8], s[8], o[8];
    a[0] = bf_lo(x1.x); a[1] = bf_hi(x1.x); a[2] = bf_lo(x1.y); a[3] = bf_hi(x1.y); a[4] = bf_lo(x1.z); a[5] = bf_hi(x1.z); a[6] = bf_lo(x1.w); a[7] = bf_hi(x1.w);
    b[0] = bf_lo(x2.x); b[1] = bf_hi(x2.x); b[2] = bf_lo(x2.y); b[3] = bf_hi(x2.y); b[4] = bf_lo(x2.z); b[5] = bf_hi(x2.z); b[6] = bf_lo(x2.w); b[7] = bf_hi(x2.w);
#pragma unroll
    for (int e = 0; e < 4; ++e) { c[e] = c0[e]; c[4 + e] = c1[e]; s[e] = s0[e]; s[4 + e] = s1[e]; }
#pragma unroll
    for (int e = 0; e < 8; ++e) o[e] = first ? (a[e] * c[e] - b[e] * s[e]) : (a[e] * s[e] + b[e] * c[e]);
    u32x4 w; w.x = cvt_pk_bf16(o[0], o[1]); w.y = cvt_pk_bf16(o[2], o[3]); w.z = cvt_pk_bf16(o[4], o[5]); w.w = cvt_pk_bf16(o[6], o[7]); return w;
}
template <int MODE>
__device__ __forceinline__ void attn_unit(LAS unsigned char* lds, const AttnArgs& A, int tid) {
    asm volatile("" : "+v"(tid));
    const int lane = tid & 63, wv = __builtin_amdgcn_readfirstlane(tid >> 6), r32 = lane & 31, hi = lane >> 5;
    LAS float* wsf = (LAS float*)(lds + LDS_WS) + wv * 64;
    const int qi = A.q0 + 32 * wv + r32;
    bf16x8 qr[4];
    { const bf16_t* qrow = A.Q + (long)qi * A.rs;
#pragma unroll
      for (int d0 = 0; d0 < 4; ++d0) qr[d0] = *(const bf16x8*)(qrow + d0 * 16 + hi * 8); }
    const int krow = 8 * wv + (lane & 7), kch = lane >> 3, vrow = 8 * wv + (lane >> 3), vch = lane & 7;
    const int kdo = LDS_K + kch * 1024 + krow * 16, vdo = LDS_V + (vch >> 2) * 4096 + vrow * 64 + (vch & 3) * 16;
    u32x4 kreg, vreg; f32x4 rc0, rc1, rs0, rs1;
    rc0 = rc1 = rs0 = rs1 = (f32x4){0.f, 0.f, 0.f, 0.f};
#define ATT_LOAD(j) do { const long ks_ = (long)A.kbase + 64 * (j); \
        kreg = *(const u32x4*)(A.K + (ks_ + krow) * A.rs + kch * 8); vreg = *(const u32x4*)(A.V + (ks_ + vrow) * A.rs + vch * 8); \
        if (MODE == 1) { if (kch < 2) { const float* rp_ = A.rope + (ks_ + krow) * A.rrs; rc0 = *(const f32x4*)(rp_); rc1 = *(const f32x4*)(rp_ + 4); rs0 = *(const f32x4*)(rp_ + 8); rs1 = *(const f32x4*)(rp_ + 12); } } } while (0)
    ATT_LOAD(A.jhi - 1);
    if (MODE == 1) {
        const float* rp = A.rope + (long)qi * A.rrs;
        const f32x4 c0 = *(const f32x4*)(rp), c1 = *(const f32x4*)(rp + 4), s0 = *(const f32x4*)(rp + 8), s1 = *(const f32x4*)(rp + 12);
        const u32x4 me = __builtin_bit_cast(u32x4, qr[0]); u32x4 x1, x2;
#pragma unroll
        for (int e = 0; e < 4; ++e) { auto rr = __builtin_amdgcn_permlane32_swap(me[e], me[e], false, false); x1[e] = rr[0]; x2[e] = rr[1]; }
        qr[0] = __builtin_bit_cast(bf16x8, rope8(x1, x2, c0, c1, s0, s1, hi == 0));
    }
    const float flq = (MODE != 1) ? A.Fl[qi] : 0.f;
    float m = (MODE == 1) ? NEG : 0.f, l = 0.f; f32x16 o0, o1; bool first = true;
#pragma unroll
    for (int r = 0; r < 16; ++r) { o0[r] = 0.f; o1[r] = 0.f; }
    const int qw0 = A.q0 + 32 * wv;
    int wlo = A.jlo; const int whi = (qw0 + 31 - A.kbase) >> 6;
    if (MODE == 1) { const int f = (qw0 - 128 - A.kbase) >> 6; wlo = f > wlo ? f : wlo; }
    const int k0 = A.kbase + 64 * A.jlo;
    if (MODE != 1) {
        LAS f32x4* fl4 = (LAS f32x4*)(lds + LDS_FL); const int n4 = 16 * (A.jhi - A.jlo);
        for (int i = tid; i < n4; i += 512) fl4[i] = *(const f32x4*)(A.Fl + k0 + 4 * i);
    }
#define ATT_WRITE(buf) do { if (MODE == 1) { u32x4 oth; _Pragma("unroll") for (int e = 0; e < 4; ++e) oth[e] = shxu(kreg[e], 8, lane); \
            if (kch < 2) kreg = (kch == 0) ? rope8(kreg, oth, rc0, rc1, rs0, rs1, true) : rope8(oth, kreg, rc0, rc1, rs0, rs1, false); } \
        *(LAS u32x4*)(lds + (buf) * LDS_BUF + kdo) = kreg; *(LAS u32x4*)(lds + (buf) * LDS_BUF + vdo) = vreg; } while (0)
    const int nst = A.jhi - A.jlo;
    asm volatile("s_barrier" ::: "memory");
    ATT_WRITE(0);
    if (nst > 1) ATT_LOAD(A.jhi - 2);
    BAR_L();
    for (int st = 0; st < nst; ++st) {
        const int j = A.jhi - 1 - st, cur = st & 1;
        if (j >= wlo && j <= whi) {
            const int ks = A.kbase + 64 * j;
            const LAS unsigned char* tb = lds + cur * LDS_BUF;
            f32x16 p0, p1;
            const float fm = flq - m;
            if (MODE != 1) { const LAS float* fk = (const LAS float*)(lds + LDS_FL) + (ks - k0) + 4 * hi;
#pragma unroll
                for (int g4 = 0; g4 < 4; ++g4) { const f32x4 a = *(const LAS f32x4*)(fk + 8 * g4), b = *(const LAS f32x4*)(fk + 32 + 8 * g4);
#pragma unroll
                    for (int e = 0; e < 4; ++e) { p0[4 * g4 + e] = fm - a[e]; p1[4 * g4 + e] = fm - b[e]; } }
            } else {
#pragma unroll
                for (int r = 0; r < 16; ++r) { p0[r] = 0.f; p1[r] = 0.f; } }
            { const LAS unsigned char* kb = tb + LDS_K + hi * 1024 + r32 * 16;
#pragma unroll
              for (int d0 = 0; d0 < 4; ++d0) { const bf16x8 b0 = *(const LAS bf16x8*)(kb + d0 * 2048), b1 = *(const LAS bf16x8*)(kb + d0 * 2048 + 512);
                  p0 = __builtin_amdgcn_mfma_f32_32x32x16_bf16(b0, qr[d0], p0, 0, 0, 0); p1 = __builtin_amdgcn_mfma_f32_32x32x16_bf16(b1, qr[d0], p1, 0, 0, 0); } }
            if (MODE != 1) {
                if (ks + 63 > qw0) {
#pragma unroll
                    for (int r = 0; r < 16; ++r) { const int kv = ks + crow(r, hi); if (kv > qi) p0[r] = NEG; if (kv + 32 > qi) p1[r] = NEG; } }
            } else {
#pragma unroll
                for (int r = 0; r < 16; ++r) { const int d = qi - (ks + crow(r, hi)); if (d < 0 || d > 128) p0[r] = NEG; if (d - 32 < 0 || d - 32 > 128) p1[r] = NEG; }
            }
            asm volatile("s_nop 15\n\ts_nop 7" : "+v"(p0), "+v"(p1));
            float rm = rowmax32(p0, p1);
            { auto rr = __builtin_amdgcn_permlane32_swap(__float_as_uint(rm), __float_as_uint(rm), false, false); rm = fmaxf(__uint_as_float(rr[0]), __uint_as_float(rr[1])); }
            float f = 1.0f; bool resc;
            if (MODE != 1) {
                const float d = first ? rm : fmaxf(rm, 0.f);
                resc = first || (__builtin_amdgcn_ballot_w64(rm > 0.f) != 0ull);
                if (resc) { m += d;
#pragma unroll
                    for (int r = 0; r < 16; ++r) { p0[r] -= d; p1[r] -= d; }
                    if (!first) { f = fast_exp2(-d); l *= f; } else resc = false; }
            } else {
                const float mn = fmaxf(m, rm); f = fast_exp2(m - mn); m = mn; l *= f;
#pragma unroll
                for (int r = 0; r < 16; ++r) { p0[r] -= mn; p1[r] -= mn; }
                resc = __builtin_amdgcn_ballot_w64(f != 1.0f) != 0ull;
            }
            first = false;
#pragma unroll
            for (int r = 0; r < 16; ++r) p0[r] = fast_exp2(p0[r]);
#pragma unroll
            for (int r = 0; r < 16; ++r) p1[r] = fast_exp2(p1[r]);
            { float s0 = 0.f, s1 = 0.f, s2 = 0.f, s3 = 0.f;
#pragma unroll
              for (int r = 0; r < 16; r += 2) { s0 += p0[r]; s1 += p0[r + 1]; s2 += p1[r]; s3 += p1[r + 1]; }
              l += (s0 + s1) + (s2 + s3); }
            if (resc) {
                if (hi == 0) wsf[r32] = f;
                f32x4 fr[4];
#pragma unroll
                for (int g4 = 0; g4 < 4; ++g4) fr[g4] = *(const LAS f32x4*)(wsf + 8 * g4 + 4 * hi);
#pragma unroll
                for (int r = 0; r < 16; ++r) { o0[r] *= fr[r >> 2][r & 3]; o1[r] *= fr[r >> 2][r & 3]; }
            }
            u32x4 pw[4];
#pragma unroll
            for (int e = 0; e < 4; ++e) { pw[0][e] = cvt_pk_bf16(p0[2 * e], p0[2 * e + 1]); pw[1][e] = cvt_pk_bf16(p0[8 + 2 * e], p0[9 + 2 * e]);
                                          pw[2][e] = cvt_pk_bf16(p1[2 * e], p1[2 * e + 1]); pw[3][e] = cvt_pk_bf16(p1[8 + 2 * e], p1[9 + 2 * e]); }
            const LAS unsigned char* vp = tb + LDS_V + ((lane >> 4) & 1) * 32 + (lane & 3) * 8 + (4 * hi + ((lane & 15) >> 2)) * 64;
#pragma unroll
            for (int k4 = 0; k4 < 4; ++k4) {
                const s16x4 a0 = vtr(vp + k4 * 1024), a1 = vtr(vp + k4 * 1024 + 512), b0 = vtr(vp + 4096 + k4 * 1024), b1 = vtr(vp + 4096 + k4 * 1024 + 512);
                const bf16x8 v0 = (bf16x8){a0[0], a0[1], a0[2], a0[3], a1[0], a1[1], a1[2], a1[3]}, v1 = (bf16x8){b0[0], b0[1], b0[2], b0[3], b1[0], b1[1], b1[2], b1[3]};
                o0 = __builtin_amdgcn_mfma_f32_32x32x16_bf16(__builtin_bit_cast(bf16x8, pw[k4]), v0, o0, 0, 0, 0);
                o1 = __builtin_amdgcn_mfma_f32_32x32x16_bf16(__builtin_bit_cast(bf16x8, pw[k4]), v1, o1, 0, 0, 0);
            }
        }
        if (st + 1 < nst) { ATT_WRITE(cur ^ 1); if (st + 2 < nst) ATT_LOAD(j - 2); }
        BAR_L();
    }
#undef ATT_WRITE
#undef ATT_LOAD
    { auto rr = __builtin_amdgcn_permlane32_swap(__float_as_uint(l), __float_as_uint(l), false, false); l = __uint_as_float(rr[0]) + __uint_as_float(rr[1]); }
    if (hi == 0) wsf[r32] = (MODE == 2) ? 1.0f : 1.0f / l;
    f32x4 fr[4];
#pragma unroll
    for (int g4 = 0; g4 < 4; ++g4) fr[g4] = *(const LAS f32x4*)(wsf + 8 * g4 + 4 * hi);
#pragma unroll
    for (int r = 0; r < 16; ++r) { const long row = (long)(qw0 + crow(r, hi)) * A.ors; const float s = fr[r >> 2][r & 3];
        if (MODE == 0) { A.Ob[row + r32] = (bf16_t)(cvt_pk_bf16(o0[r] * s, 0.f) & 0xffffu); A.Ob[row + 32 + r32] = (bf16_t)(cvt_pk_bf16(o1[r] * s, 0.f) & 0xffffu); }
        else { A.Of[row + r32] = o0[r] * s; A.Of[row + 32 + r32] = o1[r] * s; } }
    if (MODE == 1) { if (hi == 0) A.lse[(long)qi * A.lrs] = m + log2f(l); }
    if (MODE == 2) { if (hi == 0) { A.lse[(long)qi * A.lrs] = m; A.lse[(long)qi * A.lrs + 1] = l; } }
}
}

constexpr int NPH_PRO = 2, NPH_LAYER = 11, NPHASE = NPH_PRO + DEPTH * NPH_LAYER;
constexpr int TR_ITEMS = 37632;
constexpr int MIX_TR = 588, MIX_TRI = 64;
constexpr int MIX_FOX = 384, MIX_DIL = 384, MIX_SGU = 256, MIX_CONV = 256, MIX_UNITS = MIX_GEMM + MIX_FOX + MIX_DIL + MIX_SGU + MIX_CONV;
__constant__ double c_rope_inv[8] = {1.0, 0.19392274474868576, 0.03760603093086393, 0.007292664737217109, 0.001414213562373095, 0.0002742481756762073, 5.318295896944988e-05, 1.031338537721246e-05};

__device__ __forceinline__ void sincos_d(double x, float& sn, float& cs) {
    const double q = rint(x * 0.63661977236758134308);
    const double r = (x - q * 1.57079632679489655800e+00) - q * 6.12323399573676603587e-17;
    const int qi = ((int)q) & 3;
    const double r2 = r * r;
    double s = r * (1.0 + r2 * (-1.0 / 6 + r2 * (1.0 / 120 + r2 * (-1.0 / 5040 + r2 * (1.0 / 362880 + r2 * (-1.0 / 39916800 + r2 * (1.0 / 6227020800.0)))))));
    double c = 1.0 + r2 * (-0.5 + r2 * (1.0 / 24 + r2 * (-1.0 / 720 + r2 * (1.0 / 40320 + r2 * (-1.0 / 3628800 + r2 * (1.0 / 479001600.0 + r2 * (-1.0 / 87178291200.0)))))));
    double so = (qi == 0) ? s : (qi == 1) ? c : (qi == 2) ? -s : -c;
    double co = (qi == 0) ? c : (qi == 1) ? -s : (qi == 2) ? -c : s;
    sn = (float)so; cs = (float)co;
}

__device__ __forceinline__ int opaque_i(int k) { asm volatile("" : "+s"(k)); return k; }
__device__ __forceinline__ int lane_id_now() { int l; asm volatile("v_mbcnt_lo_u32_b32 %0, -1, 0\n\tv_mbcnt_hi_u32_b32 %0, -1, %0" : "=v"(l)); return l; }
__global__ void __launch_bounds__(512, 2) mk_fwd(Args args) {
    extern __shared__ __attribute__((aligned(16))) unsigned char lds_raw[];
    LAS unsigned char* lds = (LAS unsigned char*)lds_raw;
    volatile LAS unsigned* MISC = (volatile LAS unsigned*)(lds + MISC_OFF);
    const int wave0 = __builtin_amdgcn_readfirstlane(threadIdx.x >> 6);
#define MK_TID() (wave0 * 64 + lane_id_now())
    const int G = gridDim.x, bx = blockIdx.x, NGW = G * 8;
#define WS_LOCAL() unsigned char* ws = args.ws; float* X = args.out; asm volatile("" : "+s"(ws), "+s"(X)); (void)X
    unsigned* ctl = (unsigned*)(args.ws + WS_CTL);
    for (int u = MK_TID(); u < (LDS_BYTES - RING_BYTES) / 4; u += 512) ((LAS unsigned*)(lds + RING_BYTES))[u] = 0u;
    __syncthreads();
    XcdBarrier bar = xcd_barrier_post(ctl + CW_BAR + args.li * XCD_BAR_WORDS, MISC + 8);
    const int lo = args.ph_lo, hi = args.ph_hi;
#define IN(k) (lo <= (k) && (k) < hi)
#if PROBE_PH >= 0
    if (threadIdx.x == 0) { const unsigned long long t_ = __builtin_amdgcn_s_memrealtime(); MISC[20] = (unsigned)t_; MISC[21] = (unsigned)(t_ >> 32); }
#define PROBE_SEL(k) ((PROBE_PH < 100) ? ((k) == PROBE_PH) : ((k) >= NPH_PRO && ((k) - NPH_PRO) % NPH_LAYER == PROBE_PH - 100))
#define SEAM(k) do { if (IN(k) && IN((k) + 1)) xcd_barrier(bar); if (threadIdx.x == 0) { const unsigned long long tn_ = __builtin_amdgcn_s_memrealtime(), tp_ = (unsigned long long)MISC[20] | ((unsigned long long)MISC[21] << 32), du_ = tn_ - tp_; \
        if (PROBE_SEL(k)) { while (__builtin_amdgcn_s_memrealtime() - tn_ < du_) __builtin_amdgcn_s_sleep(8); } } __syncthreads(); \
        if (threadIdx.x == 0) { const unsigned long long t_ = __builtin_amdgcn_s_memrealtime(); MISC[20] = (unsigned)t_; MISC[21] = (unsigned)(t_ >> 32); } } while (0)
#else
#define SEAM(k) do { if (IN(k) && IN((k) + 1)) xcd_barrier(bar); } while (0)
#endif
#define x_in (args.in[opaque_i(0)])
#define p_in (args.in[opaque_i(1)])
#define pos_in ((const int*)args.in[opaque_i(2)])
#define norm_mix_g (args.in[opaque_i(3)])
#define w_in (args.in[opaque_i(4)])
#define fox_b (args.in[opaque_i(5)])
#define scw (args.in[opaque_i(6)])
#define sgu_g (args.in[opaque_i(7)])
#define sgu_w (args.in[opaque_i(8)])
#define sgu_b (args.in[opaque_i(9)])
#define w_br_fox (args.in[opaque_i(10)])
#define w_br_conv (args.in[opaque_i(11)])
#define w_br_sgu (args.in[opaque_i(12)])
#define w_br_dil (args.in[opaque_i(13)])
#define w_out (args.in[opaque_i(14)])
#define norm_ffn_g (args.in[opaque_i(15)])
#define w_up (args.in[opaque_i(16)])
#define ffn_cw (args.in[opaque_i(17)])
#define w_down (args.in[opaque_i(18)])
#define norm_ple_g (args.in[opaque_i(19)])
#define w_pg (args.in[opaque_i(20)])
#define w_pe (args.in[opaque_i(21)])
#define final_g (args.in[opaque_i(22)])
#define WFG ((float*)(ws + WS_SMALL + SM_WFG))
#define SGUW ((bf16_t*)(ws + WS_SMALL + SM_SGUW))
#define ROPE ((float*)(ws + WS_SMALL + SM_ROPE))
#define LOGF ((float*)(ws + WS_SMALL + SM_LOGF))
#define FL ((float*)(ws + WS_SMALL + SM_FL))
#define LSE ((float*)(ws + WS_SMALL + SM_LSE))
#define SSQ ((float*)(ws + WS_PART))
#define RSC ((float*)(ws + WS_SMALL + SM_SS))
#define FOP ((float*)(ws + WS_FOP))
#define FML ((float*)(ws + WS_FML))
#define UPB ((bf16_t*)(ws + WS_UPB))
#define G8 ((unsigned char*)(ws + WS_G8))
#define XN8 ((unsigned*)(ws + WS_XN8))
#define AS8 ((float*)(ws + WS_SMALL + SM_SS + 65536))
#define QSC ((float*)(ws + WS_SMALL + SM_SS + 98304))
#define XR ((bf16_t*)(ws + WS_XR) + (size_t)(L & 1) * M * DM)
#define XRN ((bf16_t*)(ws + WS_XR) + (size_t)((L + 1) & 1) * M * DM)
#define PB ((bf16_t*)(ws + WS_PB))
#define PP ((bf16_t*)(ws + WS_PP))
#define XN ((bf16_t*)(ws + WS_XN))
#define PROJ ((bf16_t*)(ws + WS_PROJ))
#define UP ((bf16_t*)(ws + WS_PROJ))
#define HID ((bf16_t*)(ws + WS_HID))
#define OCAT ((bf16_t*)(ws + WS_OCAT))
#define MG ((bf16_t*)(ws + WS_MG))
#define ODIL ((float*)(ws + WS_ODIL))

    if (IN(0)) { WS_LOCAL();
        const int tid = MK_TID(), lane = tid & 63, wave = wave0, gw = bx * 8 + wave;
        LAS float* qsl = (LAS float*)(lds + RING_BYTES + 4096);
        { float sq[8];
#pragma unroll
          for (int mth = 0; mth < 8; ++mth) { const int Ls = mth >> 1; float a = 0.f;
              for (int j = 0; j < 16; ++j) { const int i = tid + 512 * j;
                  const float w = (mth & 1) ? w_up[(size_t)Ls * DM * 2 * DFF + i] : w_in[(size_t)Ls * DM * DIN_SRC + (size_t)(i >> 11) * DIN_SRC + 6408 + (i & 2047)];
                  a += w * w; }
              sq[mth] = wave_sum(a, lane); }
          if (lane == 0) {
#pragma unroll
              for (int mth = 0; mth < 8; ++mth) qsl[8 + wave * 8 + mth] = sq[mth]; }
          __syncthreads();
          if (tid < 8) { float t = 0.f; for (int w = 0; w < 8; ++w) t += qsl[8 + w * 8 + tid];
              const float rng = 4.0f * sqrtf(t * (1.0f / 8192.0f)) + 1e-30f; qsl[tid] = 127.0f / rng; if (bx == 0) QSC[tid] = rng * (1.0f / 127.0f); }
          __syncthreads(); }
        LAS float* scr = (LAS float*)(lds + wave * 16384);
#define TR_DECODE(d, it_) do { const int L_ = (it_) / TR_ITEMS; int r_ = (it_) % TR_ITEMS; unsigned char* wl_ = ws + WS_WL + (size_t)L_ * WL_STRIDE; const float* win_ = w_in + (size_t)L_ * DM * DIN_SRC; \
            if (r_ < 1536 + 13056) { const bool pa_ = r_ < 1536; if (!pa_) r_ -= 1536; \
                if (pa_) d = TrDesc{win_, norm_mix_g + L_ * DM, (bf16_t*)(wl_ + WL_IN), DIN_SRC, 0, DM, 0, 0, r_ / 48, r_ % 48, 0, 0.f}; \
                else d = TrDesc{win_, norm_mix_g + L_ * DM, (bf16_t*)(wl_ + WL_IN), DIN_SRC, 1544, DM, 1536, 0, r_ / 408, r_ % 408, 0, 0.f}; \
                const int pc_ = d.drow0 + 32 * d.nb, pt_ = pc_ >> 8;        \
                if (pc_ >= PC_G || ((I8MASK >> pt_) & 1u)) { d.WT = (bf16_t*)(wl_ + WL_G8W); d.f8 = 1; d.gk = nullptr; d.qinv = qsl[2 * L_]; \
                    d.drow0 += (pc_ >= PC_G) ? (N8T * 256 - PC_G) : (__builtin_popcount(I8MASK & ((1u << pt_) - 1u)) - pt_) * 256; } } \
            else if ((r_ -= 1536 + 13056) < 512) { d = TrDesc{w_br_fox + (size_t)L_ * 512 * DM, nullptr, (bf16_t*)(wl_ + WL_BR), DM, 0, OC_W, 0, OC_A, r_ / 64, r_ % 64, 0, 0.f}; } \
            else if ((r_ -= 512) < 512) { d = TrDesc{w_br_conv + (size_t)L_ * 512 * DM, nullptr, (bf16_t*)(wl_ + WL_BR), DM, 0, OC_W, 0, OC_B, r_ / 64, r_ % 64, 0, 0.f}; } \
            else if ((r_ -= 512) < 512) { d = TrDesc{w_br_sgu + (size_t)L_ * 512 * DM, nullptr, (bf16_t*)(wl_ + WL_BR), DM, 0, OC_W, 0, OC_C, r_ / 64, r_ % 64, 0, 0.f}; } \
            else if ((r_ -= 512) < 256) { d = TrDesc{w_br_dil + (size_t)L_ * 256 * DM, nullptr, (bf16_t*)(wl_ + WL_BR), DM, 0, OC_W, 0, OC_D, r_ / 64, r_ % 64, 0, 0.f}; } \
            else if ((r_ -= 256) < 2048) { d = TrDesc{w_out + (size_t)L_ * DM * DM, nullptr, (bf16_t*)(wl_ + WL_OUT), DM, 0, DM, 0, 0, r_ / 64, r_ % 64, 0, 0.f}; } \
            else if ((r_ -= 2048) < 11264) { d = TrDesc{w_up + (size_t)L_ * DM * 2 * DFF, nullptr, (bf16_t*)(wl_ + WL_UP), 2 * DFF, 0, DM, 0, 0, r_ / 352, r_ % 352, 1, qsl[2 * L_ + 1]}; }   \
            else if ((r_ -= 11264) < 5632) { d = TrDesc{w_down + (size_t)L_ * DFF * DM, nullptr, (bf16_t*)(wl_ + WL_DN), DM, 0, DFF, 0, 0, r_ / 64, r_ % 64, 0, 0.f}; } \
            else if ((r_ -= 5632) < 2048) { d = TrDesc{w_pg + (size_t)L_ * DM * DM, norm_ple_g + L_ * DM, (bf16_t*)(wl_ + WL_PG), DM, 0, DM, 0, 0, r_ / 64, r_ % 64, 0, 0.f}; } \
            else { r_ -= 2048; d = TrDesc{w_pe + (size_t)L_ * PLE * DM, nullptr, (bf16_t*)(wl_ + WL_PE), DM, 0, PLE, 0, 0, r_ / 64, r_ % 64, 0, 0.f}; } } while (0)
#define TR_RUN(it0_, end_, stride_) do { TrDesc d0, d1, d2, d3; f32x4 v0[8], v1[8], v2[8], v3[8]; float g0[8], g1[8], g2[8], g3[8]; int it = (it0_);     \
            for (; it + 3 * (stride_) < (end_); it += 4 * (stride_)) { TR_DECODE(d0, it); tr_load(v0, g0, d0, lane); TR_DECODE(d1, it + (stride_)); tr_load(v1, g1, d1, lane); TR_DECODE(d2, it + 2 * (stride_)); tr_load(v2, g2, d2, lane); \
                TR_DECODE(d3, it + 3 * (stride_)); tr_load(v3, g3, d3, lane); \
                tr_store(v0, g0, d0, scr, lane); tr_store(v1, g1, d1, scr, lane); tr_store(v2, g2, d2, scr, lane); tr_store(v3, g3, d3, scr, lane); } \
            for (; it < (end_); it += (stride_)) { TR_DECODE(d0, it); tr_load(v0, g0, d0, lane); tr_store(v0, g0, d0, scr, lane); } } while (0)
        TR_RUN(gw, TR_ITEMS, NGW);
        const int gt = bx * 512 + tid, NGT = G * 512;
        for (int i = gt; i < DEPTH * 8 * DM; i += NGT) { const int L = i / (8 * DM), h = (i / DM) % 8, k = i % DM;
            WFG[i] = norm_mix_g[L * DM + k] * w_in[(size_t)L * DM * DIN_SRC + (size_t)k * DIN_SRC + 1536 + h]; }
        for (int i = gt; i < DEPTH * 4 * 128 * 128; i += NGT) { const int t = (i >> 7) & 127, s = i & 127; SGUW[i] = (s <= t) ? (bf16_t)(cvt_pk_bf16(sgu_w[i], 0.f) & 0xffffu) : (bf16_t)0; }
        for (int i = gt; i < M * 8; i += NGT) { const int row = i >> 3, jj = i & 7; float sn, cs; sincos_d((double)pos_in[row] * c_rope_inv[jj], sn, cs); ROPE[row * 16 + jj] = cs; ROPE[row * 16 + 8 + jj] = sn; }
#define CVT_STREAM(src_, dst_, n_) do { const f32x4* s_ = (const f32x4*)(src_); u32x4* d_ = (u32x4*)(dst_); \
            for (int i = gt; i < (n_); i += 4 * NGT) { f32x4 a[4], b[4]; \
                _Pragma("unroll") for (int k = 0; k < 4; ++k) { const int ii = i + k * NGT; if (ii < (n_)) { a[k] = s_[2 * ii]; b[k] = s_[2 * ii + 1]; } else { a[k] = (f32x4){0.f, 0.f, 0.f, 0.f}; b[k] = a[k]; } } \
                _Pragma("unroll") for (int k = 0; k < 4; ++k) { const int ii = i + k * NGT; u32x4 w; w.x = cvt_pk_bf16(a[k].x, a[k].y); w.y = cvt_pk_bf16(a[k].z, a[k].w); w.z = cvt_pk_bf16(b[k].x, b[k].y); w.w = cvt_pk_bf16(b[k].z, b[k].w); \
                    if (ii < (n_)) d_[ii] = w; } } } while (0)
        CVT_STREAM(x_in, ws + WS_XR, M * DM / 8);
        CVT_STREAM(p_in, PB, DEPTH * M * PLE / 8);
#undef CVT_STREAM
    }
    SEAM(0);
    if (IN(1)) { WS_LOCAL();
        const int tid = MK_TID(), lane = tid & 63, gw = bx * 8 + wave0;
        norm_phase<true, false, false>(x_in, nullptr, nullptr, RSC, XN8, AS8, norm_mix_g, WFG, fox_b, LOGF, nullptr, nullptr, lds, gw, NGW, lane, tid);
    }
    SEAM(1);

    for (int L = 0; L < DEPTH; ++L) {
        const int pb = NPH_PRO + L * NPH_LAYER;
#define wl (ws + WS_WL + (size_t)L * WL_STRIDE)
        if (IN(pb + 0)) { WS_LOCAL();
            const int bxs = opaque_i(bx);
            if (bxs >= 32 && bxs < 48 && G >= 48) {
                const int wave = opaque_i(wave0), tid = wave * 64 + lane_id_now(), lane = tid & 63, gw = bx * 8 + wave; (void)lane; (void)gw;
                const int seq = bxs - 32, b = seq >> 3, h = seq & 7; float v[8], run = 0.f;
                { const f32x4 la = *(const f32x4*)(LOGF + (size_t)h * M + b * SEQ + tid * 8), lb = *(const f32x4*)(LOGF + (size_t)h * M + b * SEQ + tid * 8 + 4);
                  const float lv[8] = {la.x, la.y, la.z, la.w, lb.x, lb.y, lb.z, lb.w};
#pragma unroll
                  for (int e = 0; e < 8; ++e) { run += lv[e]; v[e] = run; } }
                float inc = run;
#pragma unroll
                for (int o = 1; o < 64; o <<= 1) { const float t = __int_as_float(__builtin_amdgcn_ds_bpermute(((lane - o) & 63) << 2, __float_as_int(inc))); if (lane >= o) inc += t; }
                LAS float* wt = (LAS float*)lds;
                if (lane == 63) wt[wave] = inc;
                __syncthreads();
                float base = inc - run;
                for (int w = 0; w < wave; ++w) base += wt[w];
#pragma unroll
                for (int e = 0; e < 8; ++e) FL[seq * SEQ + tid * 8 + e] = (base + v[e]) * LOG2E;
                __syncthreads();
            }
            pg8::Gemm g{XR, (const bf16_t*)(wl + WL_IN), M, NBT * 256, DM}; pg8::ProjOrder S; S.init(M, NBT * 256, G, bx);
            pg8::EpiProj E{PROJ, DIN, G8, RSC};
            pg8::gemm_phase(lds, g, S, E, pg8::NoHook{}, MK_TID());
            pg8::Gemm g8{(const bf16_t*)XN8, (const bf16_t*)(wl + WL_G8W), M, N8N, opaque_i(DM / 2)}; pg8::Gate8Order S8; S8.init(M, N8N, G, bx);
            pg8::EpiGate8 E8{G8, AS8, QSC + 2 * L, PROJ, DIN};
            pg8::gemm_phase<pg8::EpiGate8, pg8::NoHook, pg8::Gate8Order, true>(lds, g8, S8, E8, pg8::NoHook{}, MK_TID());
        }
        SEAM(pb + 0);
        if (IN(pb + 1)) { WS_LOCAL();
            unsigned* qhead = ctl + CW_Q + 64 * L;
            unsigned qcur = 0u;
            if (MK_TID() == 0) qcur = __hip_atomic_fetch_add(qhead, 1u, __ATOMIC_RELAXED, __HIP_MEMORY_SCOPE_AGENT);
            for (;;) {
                const int wave = opaque_i(wave0), tid = wave * 64 + lane_id_now(), lane = tid & 63; (void)lane;
                __syncthreads();
                if (tid == 0) *(volatile LAS unsigned*)(lds + att::LDS_QW) = qcur;
                __syncthreads();
                int u = (int)*(volatile LAS unsigned*)(lds + att::LDS_QW);
                const int nq_ = MIX_UNITS + ((L + 1 < DEPTH) ? MIX_TR : 0);
#if MIX_PROBE
                const int nx_ = MIX_PROBE == 1 ? MIX_FOX : MIX_PROBE == 2 ? MIX_DIL : MIX_PROBE == 3 ? MIX_SGU : MIX_PROBE == 4 ? MIX_CONV : ((L + 1 < DEPTH) ? MIX_TR : 0);
                if (u >= nq_ + nx_) break;
                const int ex_ = u - nq_;
#else
                if (u >= nq_) break;
#endif
                if (u < MIX_GEMM) {
                    pg8::StaticOrder so; so.init(M, N8N, 256, 0); pg8::Unit gu; so.map(I8_INPHASE + u, gu);
                    pg8::Gemm g8{(const bf16_t*)XN8, (const bf16_t*)(wl + WL_G8W), M, N8N, opaque_i(DM / 2)}; pg8::OneUnit S1{gu.pm, gu.pn}; pg8::EpiGate8 E8{G8, AS8, QSC + 2 * L, PROJ, DIN};
                    pg8::gemm_phase<pg8::EpiGate8, pg8::NoHook, pg8::OneUnit, true>(lds, g8, S1, E8, pg8::NoHook{}, MK_TID());
                    if (MK_TID() == 0) qcur = __hip_atomic_fetch_add(qhead, 1u, __ATOMIC_RELAXED, __HIP_MEMORY_SCOPE_AGENT);
                    continue;
                }
                u -= MIX_GEMM;
                unsigned qnext = 0u;
                if (tid == 0) qnext = __hip_atomic_fetch_add(qhead, 1u, __ATOMIC_RELAXED, __HIP_MEMORY_SCOPE_AGENT);
                int cu = -1;
                if (L + 1 < DEPTH) { const int k = u / 19, r = u - 19 * k; if (k < 98) { if (r < 13) u = 13 * k + r; else cu = 6 * k + r - 13; } else u -= MIX_TR; }
#if MIX_PROBE
                if (ex_ >= 0) { cu = -1; u = ex_ + (MIX_PROBE == 2 ? MIX_FOX : MIX_PROBE == 3 ? MIX_FOX + MIX_DIL : MIX_PROBE == 4 ? MIX_FOX + MIX_DIL + MIX_SGU : 0); if (MIX_PROBE == 5) cu = ex_; }
#endif
                if (cu >= 0) {
                    LAS float* scr = (LAS float*)(lds + wave * 8448); LAS float* qsl = (LAS float*)(lds + RING_BYTES + 4096);
                    const int b0 = (L + 1) * TR_ITEMS + cu * MIX_TRI;
                    TR_RUN(b0 + wave, b0 + MIX_TRI, 8);
                } else if (u < MIX_FOX) {
                    const bool split = u < 256; int qb, seg, bh;
                    if (split) { qb = 15 - (u >> 5); seg = (u >> 4) & 1; bh = u & 15; } else { const int v = u - 256; qb = 7 - (v >> 4); seg = 0; bh = v & 15; }
                    const int b = bh >> 3, h = bh & 7;
                    att::AttnArgs A; const size_t r0 = (size_t)b * SEQ * DIN;
                    A.Q = PROJ + r0 + PC_AQ + h * 64; A.K = PROJ + r0 + PC_AK + h * 64; A.V = PROJ + r0 + PC_AV + h * 64; A.rs = DIN;
                    A.q0 = qb * 256; A.kbase = 0; A.Fl = FL + bh * SEQ; A.rope = nullptr; A.rrs = 0;
                    if (split) {
                        A.jlo = seg ? 2 * (qb + 1) : 0; A.jhi = seg ? 4 * (qb + 1) : 2 * (qb + 1);
                        A.Ob = nullptr; A.Of = FOP + (((long)seg * 4096 + (long)b * 2048 - 2048) * 8 + h) * 64; A.ors = 8 * 64;
                        A.lse = FML + (((long)seg * 4096 + (long)b * 2048 - 2048) * 8 + h) * 2; A.lrs = 16;
                        att::attn_unit<2>(lds, A, tid);
                    } else {
                        A.jlo = 0; A.jhi = 4 * (qb + 1);
                        A.Ob = OCAT + (size_t)b * SEQ * OC_W + OC_A + h * 64; A.Of = nullptr; A.ors = OC_W; A.lse = nullptr; A.lrs = 0;
                        att::attn_unit<0>(lds, A, tid);
                    }
                } else if (u < MIX_FOX + MIX_DIL) {
                    u -= MIX_FOX; const int grp = u >> 7, v = u & 127; const int sh = 2 * grp, dil = 1 << sh;
                    const int nqb = 16 >> sh; const int qb = v % nqb; int t = v / nqb; const int slot = t & 3; t >>= 2; const int res = t % dil; const int b = t / dil;
                    const int head = grp * 4 + slot; const size_t row0 = (size_t)b * SEQ + res;
                    att::AttnArgs A;
                    A.Q = PROJ + row0 * DIN + PC_DQ + head * 64; A.K = PROJ + row0 * DIN + PC_DK + head * 64; A.V = PROJ + row0 * DIN + PC_DV + head * 64; A.rs = (long)DIN * dil;
                    A.q0 = qb * 256; A.kbase = qb * 256 - 128; A.jlo = (qb == 0) ? 2 : 0; A.jhi = 6; A.Fl = nullptr; A.rope = ROPE + row0 * 16; A.rrs = 16L * dil;
                    A.Ob = nullptr; A.Of = ODIL + ((size_t)grp * M + row0) * 256 + slot * 64; A.ors = 256L * dil; A.lse = LSE + ((size_t)grp * M + row0) * 4 + slot; A.lrs = 4L * dil;
                    att::attn_unit<1>(lds, A, tid);
                } else if (u < MIX_FOX + MIX_DIL + MIX_SGU) {
                    u -= MIX_FOX + MIX_DIL; const int g = u & 3, c = (u >> 2) & 31, b = u >> 7; const size_t row0 = (size_t)b * SEQ + c * 128;
                    const int row = tid >> 2, part = tid & 3;
                    const int r32 = lane & 31, hh = lane >> 5, tb = wave & 3, dp = wave >> 2;
                    const bf16_t* wrow = SGUW + ((size_t)(L * 4 + g) * 128 + 32 * tb + r32) * 128 + 8 * hh;
                    bf16x8 wa[8];
#pragma unroll
                    for (int i = 0; i < 8; ++i) wa[i] = *(const bf16x8*)(wrow + 16 * i);
                    const bf16_t* vrow = PROJ + (row0 + row) * DIN + PC_SV;
                    const float* gsn = sgu_g + L * 512 + 128 * g + 32 * part;
                    u32x4 wg[4]; f32x4 gga[4], ggb[4];
#pragma unroll
                    for (int i = 0; i < 4; ++i) { wg[i] = *(const u32x4*)(vrow + 128 * g + 32 * part + 8 * i); gga[i] = *(const f32x4*)(gsn + 8 * i); ggb[i] = *(const f32x4*)(gsn + 8 * i + 4); }
                    float ss = 0.f;
#pragma unroll
                    for (int i = 0; i < 16; ++i) { const u32x4 w = *(const u32x4*)(vrow + part * 128 + 8 * i);
                        ss += (bf_lo(w.x) * bf_lo(w.x) + bf_hi(w.x) * bf_hi(w.x)) + (bf_lo(w.y) * bf_lo(w.y) + bf_hi(w.y) * bf_hi(w.y)) + (bf_lo(w.z) * bf_lo(w.z) + bf_hi(w.z) * bf_hi(w.z)) + (bf_lo(w.w) * bf_lo(w.w) + bf_hi(w.w) * bf_hi(w.w)); }
                    ss += shx(ss, 1, lane); ss += shx(ss, 2, lane);
                    const float rinv = 1.0f / sqrtf(ss * (1.0f / 512.0f) + EPS);
#pragma unroll
                    for (int i = 0; i < 4; ++i) { const u32x4 w = wg[i]; const f32x4 ga = gga[i], gb = ggb[i];
                        u32x4 o; o.x = cvt_pk_bf16(bf_lo(w.x) * rinv * ga.x, bf_hi(w.x) * rinv * ga.y); o.y = cvt_pk_bf16(bf_lo(w.y) * rinv * ga.z, bf_hi(w.y) * rinv * ga.w);
                        o.z = cvt_pk_bf16(bf_lo(w.z) * rinv * gb.x, bf_hi(w.z) * rinv * gb.y); o.w = cvt_pk_bf16(bf_lo(w.w) * rinv * gb.z, bf_hi(w.w) * rinv * gb.w);
                        *(LAS u32x4*)(lds + att::LDS_SV + part * 8192 + row * 64 + i * 16) = o; }
                    BAR_L();
                    float bia[16]; bf16_t uu0[16], uu1[16];
#pragma unroll
                    for (int r = 0; r < 16; ++r) { const int t = 32 * tb + att::crow(r, hh); const size_t gr = row0 + t; const int d = 128 * g + 64 * dp + r32;
                        bia[r] = sgu_b[(L * 4 + g) * 128 + t]; uu0[r] = PROJ[gr * DIN + PC_SU + d]; uu1[r] = PROJ[gr * DIN + PC_SU + d + 32]; }
                    f32x16 o0, o1;
#pragma unroll
                    for (int r = 0; r < 16; ++r) { o0[r] = 0.f; o1[r] = 0.f; }
                    const LAS unsigned char* vp = lds + att::LDS_SV + (2 * dp) * 8192 + ((lane >> 4) & 1) * 32 + (lane & 3) * 8 + (8 * hh + ((lane & 15) >> 2)) * 64;
#pragma unroll
                    for (int i = 0; i < 8; ++i) { if (i >= 2 * tb + 2) break;
                        const bf16x8 a = wa[i];
                        const s16x4 a0 = att::vtr(vp + i * 1024), a1 = att::vtr(vp + i * 1024 + 256), b0 = att::vtr(vp + 8192 + i * 1024), b1 = att::vtr(vp + 8192 + i * 1024 + 256);
                        const bf16x8 v0 = (bf16x8){a0[0], a0[1], a0[2], a0[3], a1[0], a1[1], a1[2], a1[3]}, v1 = (bf16x8){b0[0], b0[1], b0[2], b0[3], b1[0], b1[1], b1[2], b1[3]};
                        o0 = __builtin_amdgcn_mfma_f32_32x32x16_bf16(a, v0, o0, 0, 0, 0); o1 = __builtin_amdgcn_mfma_f32_32x32x16_bf16(a, v1, o1, 0, 0, 0);
                    }
#pragma unroll
                    for (int r = 0; r < 16; ++r) { const int t = 32 * tb + att::crow(r, hh); const size_t gr = row0 + t; const float bias = bia[r];
                        const int d = 128 * g + 64 * dp + r32;
                        const float u0 = bf1(uu0[r]), u1 = bf1(uu1[r]);
                        OCAT[gr * OC_W + OC_C + d] = (bf16_t)(cvt_pk_bf16(u0 * (o0[r] + bias), 0.f) & 0xffffu); OCAT[gr * OC_W + OC_C + d + 32] = (bf16_t)(cvt_pk_bf16(u1 * (o1[r] + bias), 0.f) & 0xffffu); }
                } else {
                    u -= MIX_FOX + MIX_DIL + MIX_SGU;
                    {
                        const int c = (tid & 63) * 8, rbase = 32 * u + 4 * (tid >> 6), t0 = rbase & (SEQ - 1);
                        const bf16_t* pr = PROJ + (size_t)rbase * DIN; u32x4 xa[6], gc[6], gb[4];
#pragma unroll
                        for (int k = 0; k < 6; ++k) { if (k >= 2 || t0 >= 2) { xa[k] = *(const u32x4*)(pr + (long)(k - 2) * DIN + PC_XB + c); gc[k] = *(const u32x4*)(pr + (long)(k - 2) * DIN + PC_GC + c); }
                                                      else { xa[k] = (u32x4){0u, 0u, 0u, 0u}; gc[k] = (u32x4){0u, 0u, 0u, 0u}; } }
#pragma unroll
                        for (int i = 0; i < 4; ++i) gb[i] = *(const u32x4*)(pr + (size_t)i * DIN + PC_GB + c);
                        const float* wk = scw + (size_t)L * 3 * 512 + c; float w0[8], w1[8], w2[8];
#pragma unroll
                        for (int e = 0; e < 8; ++e) { w0[e] = wk[e]; w1[e] = wk[512 + e]; w2[e] = wk[1024 + e]; }
                        float y[6][8];
#pragma unroll
                        for (int k = 0; k < 6; ++k) { const u32x4 a = xa[k], g2 = gc[k];
                            y[k][0] = bf_lo(a.x) * bf_lo(g2.x); y[k][1] = bf_hi(a.x) * bf_hi(g2.x); y[k][2] = bf_lo(a.y) * bf_lo(g2.y); y[k][3] = bf_hi(a.y) * bf_hi(g2.y);
                            y[k][4] = bf_lo(a.z) * bf_lo(g2.z); y[k][5] = bf_hi(a.z) * bf_hi(g2.z); y[k][6] = bf_lo(a.w) * bf_lo(g2.w); y[k][7] = bf_hi(a.w) * bf_hi(g2.w); }
#pragma unroll
                        for (int i = 0; i < 4; ++i) { const u32x4 g = gb[i]; const float gbf[8] = {bf_lo(g.x), bf_hi(g.x), bf_lo(g.y), bf_hi(g.y), bf_lo(g.z), bf_hi(g.z), bf_lo(g.w), bf_hi(g.w)}; float o[8];
#pragma unroll
                            for (int e = 0; e < 8; ++e) o[e] = gbf[e] * (w0[e] * y[i][e] + w1[e] * y[i + 1][e] + w2[e] * y[i + 2][e]);
                            u32x4 w; w.x = cvt_pk_bf16(o[0], o[1]); w.y = cvt_pk_bf16(o[2], o[3]); w.z = cvt_pk_bf16(o[4], o[5]); w.w = cvt_pk_bf16(o[6], o[7]);
                            *(u32x4*)(OCAT + (size_t)(rbase + i) * OC_W + OC_B + c) = w; }
                    }
                }
                qcur = qnext;
            }
            __syncthreads();
        }
#undef TR_RUN
#undef TR_DECODE
        SEAM(pb + 1);
        if (IN(pb + 2)) { WS_LOCAL();
            const int wave = opaque_i(wave0), tid = wave * 64 + lane_id_now(), lane = tid & 63, gw = bx * 8 + wave; (void)lane; (void)gw;
            if (G * 512 * 2 == M * 4 * 8) {
                const int gt = bx * 512 + tid, NT = G * 512;
                float l2[2][3]; f32x4 da[2][3], db[2][3]; float fm0[2], fl0[2], fm1[2], fl1[2]; f32x4 fa0[2], fa1[2], fb0[2], fb1[2];
#pragma unroll
                for (int q = 0; q < 2; ++q) { const int i = gt + q * NT, d8 = i & 7, slot = (i >> 3) & 3, row = i >> 5;
#pragma unroll
                    for (int g = 0; g < 3; ++g) { l2[q][g] = LSE[((size_t)g * M + row) * 4 + slot]; const float* od = ODIL + ((size_t)g * M + row) * 256 + slot * 64 + d8 * 8; da[q][g] = *(const f32x4*)od; db[q][g] = *(const f32x4*)(od + 4); }
                    const int h = (i >> 3) & 7, rr = i >> 6;
                    fm0[q] = FML[((size_t)rr * 8 + h) * 2]; fl0[q] = FML[((size_t)rr * 8 + h) * 2 + 1]; fm1[q] = FML[((size_t)(4096 + rr) * 8 + h) * 2]; fl1[q] = FML[((size_t)(4096 + rr) * 8 + h) * 2 + 1];
                    const float* p0 = FOP + ((size_t)rr * 8 + h) * 64 + d8 * 8; const float* p1 = FOP + ((size_t)(4096 + rr) * 8 + h) * 64 + d8 * 8;
                    fa0[q] = *(const f32x4*)p0; fa1[q] = *(const f32x4*)(p0 + 4); fb0[q] = *(const f32x4*)p1; fb1[q] = *(const f32x4*)(p1 + 4); }
#pragma unroll
                for (int q = 0; q < 2; ++q) { const int i = gt + q * NT, d8 = i & 7, slot = (i >> 3) & 3, row = i >> 5;
                    const float mx = fmaxf(fmaxf(l2[q][0], l2[q][1]), l2[q][2]); float wsum = 0.f; f32x4 oa = {0.f, 0.f, 0.f, 0.f}, ob = {0.f, 0.f, 0.f, 0.f};
#pragma unroll
                    for (int g = 0; g < 3; ++g) { const float w = fast_exp2(l2[q][g] - mx); wsum += w; oa = oa + da[q][g] * w; ob = ob + db[q][g] * w; }
                    const float inv = 1.0f / wsum; u32x4 w; w.x = cvt_pk_bf16(oa.x * inv, oa.y * inv); w.y = cvt_pk_bf16(oa.z * inv, oa.w * inv); w.z = cvt_pk_bf16(ob.x * inv, ob.y * inv); w.w = cvt_pk_bf16(ob.z * inv, ob.w * inv);
                    *(u32x4*)(OCAT + (size_t)row * OC_W + OC_D + slot * 64 + d8 * 8) = w;
                    const int h = (i >> 3) & 7, rr = i >> 6, b = rr >> 11, t = 2048 + (rr & 2047);
                    const float mm = fmaxf(fm0[q], fm1[q]), w0 = fast_exp2(fm0[q] - mm), w1 = fast_exp2(fm1[q] - mm), inv2 = 1.0f / (w0 * fl0[q] + w1 * fl1[q]);
                    const f32x4 o0 = (fa0[q] * w0 + fb0[q] * w1) * inv2, o1 = (fa1[q] * w0 + fb1[q] * w1) * inv2;
                    u32x4 w2; w2.x = cvt_pk_bf16(o0.x, o0.y); w2.y = cvt_pk_bf16(o0.z, o0.w); w2.z = cvt_pk_bf16(o1.x, o1.y); w2.w = cvt_pk_bf16(o1.z, o1.w);
                    *(u32x4*)(OCAT + ((size_t)b * SEQ + t) * OC_W + OC_A + h * 64 + d8 * 8) = w2; }
            } else {
            for (int i = bx * 512 + tid; i < M * 4 * 8; i += G * 512) { const int d8 = i & 7, slot = (i >> 3) & 3, row = i >> 5;
                float l2[3], mx = -3.0e38f;
#pragma unroll
                for (int g = 0; g < 3; ++g) { l2[g] = LSE[((size_t)g * M + row) * 4 + slot]; mx = fmaxf(mx, l2[g]); }
                float wsum = 0.f, o[8];
#pragma unroll
                for (int e = 0; e < 8; ++e) o[e] = 0.f;
#pragma unroll
                for (int g = 0; g < 3; ++g) { const float w = fast_exp2(l2[g] - mx); wsum += w; const float* od = ODIL + ((size_t)g * M + row) * 256 + slot * 64 + d8 * 8;
                    const f32x4 a = *(const f32x4*)od, b = *(const f32x4*)(od + 4); o[0] += w * a.x; o[1] += w * a.y; o[2] += w * a.z; o[3] += w * a.w; o[4] += w * b.x; o[5] += w * b.y; o[6] += w * b.z; o[7] += w * b.w; }
                const float inv = 1.0f / wsum; u32x4 w; w.x = cvt_pk_bf16(o[0] * inv, o[1] * inv); w.y = cvt_pk_bf16(o[2] * inv, o[3] * inv); w.z = cvt_pk_bf16(o[4] * inv, o[5] * inv); w.w = cvt_pk_bf16(o[6] * inv, o[7] * inv);
                *(u32x4*)(OCAT + (size_t)row * OC_W + OC_D + slot * 64 + d8 * 8) = w; }
            for (int i = bx * 512 + tid; i < 4096 * 8 * 8; i += G * 512) {
                const int d8 = i & 7, h = (i >> 3) & 7, rr = i >> 6; const int b = rr >> 11, t = 2048 + (rr & 2047);
                const float m0 = FML[((size_t)rr * 8 + h) * 2], l0 = FML[((size_t)rr * 8 + h) * 2 + 1], m1 = FML[((size_t)(4096 + rr) * 8 + h) * 2], l1 = FML[((size_t)(4096 + rr) * 8 + h) * 2 + 1];
                const float mm = fmaxf(m0, m1), w0 = fast_exp2(m0 - mm), w1 = fast_exp2(m1 - mm), inv = 1.0f / (w0 * l0 + w1 * l1);
                const float* p0 = FOP + ((size_t)rr * 8 + h) * 64 + d8 * 8; const float* p1 = FOP + ((size_t)(4096 + rr) * 8 + h) * 64 + d8 * 8;
                const f32x4 a0 = *(const f32x4*)p0, a1 = *(const f32x4*)(p0 + 4), b0 = *(const f32x4*)p1, b1 = *(const f32x4*)(p1 + 4);
                const f32x4 o0 = (a0 * w0 + b0 * w1) * inv, o1 = (a1 * w0 + b1 * w1) * inv;
                u32x4 w; w.x = cvt_pk_bf16(o0.x, o0.y); w.y = cvt_pk_bf16(o0.z, o0.w); w.z = cvt_pk_bf16(o1.x, o1.y); w.w = cvt_pk_bf16(o1.z, o1.w);
                *(u32x4*)(OCAT + ((size_t)b * SEQ + t) * OC_W + OC_A + h * 64 + d8 * 8) = w; }
            }
            {
                pg8::Gemm g2{PB + (size_t)L * M * PLE, (const bf16_t*)(wl + WL_PE), M, DM, opaque_i(PLE)};   pg8::StaticOrder S2; S2.init(M, DM, G, bx);
                pg8::EpiPlain E2{PP + (size_t)L * M * DM, DM};
                __syncthreads();
                pg8::gemm_phase(lds, g2, S2, E2, pg8::NoHook{}, MK_TID());
            }
        }
        SEAM(pb + 2);
        if (IN(pb + 3)) { WS_LOCAL();
            pg8::Gemm g{OCAT, (const bf16_t*)(wl + WL_BR), M, DM, OC_W}; pg8::StaticOrder S; S.init(M, DM, G, bx);
            pg8::EpiMerge E{MG, DM, G8 + 3 * 2048}; pg8::MergeHook H{G8};
            pg8::gemm_phase(lds, g, S, E, H, MK_TID());
        }
        SEAM(pb + 3);
        if (IN(pb + 4)) { WS_LOCAL();
            pg8::Gemm g{MG, (const bf16_t*)(wl + WL_OUT), M, DM, DM}; pg8::StaticOrder S; S.init(M, DM, G, bx);
            pg8::EpiResidN E{XR, nullptr};
            pg8::gemm_phase(lds, g, S, E, pg8::NoHook{}, MK_TID());
        }
        SEAM(pb + 4);
        if (IN(pb + 5)) { WS_LOCAL();
            const int wave = opaque_i(wave0), tid = wave * 64 + lane_id_now(), lane = tid & 63, gw = bx * 8 + wave; (void)lane; (void)gw;
            norm_phase<false, false, true>(nullptr, XR, nullptr, nullptr, XN8, AS8, norm_ffn_g + L * DM, nullptr, nullptr, nullptr, nullptr, nullptr, lds, gw, NGW, lane, tid);
        }
        SEAM(pb + 5);
        if (IN(pb + 6)) { WS_LOCAL();
            pg8::Gemm g{(const bf16_t*)XN8, (const bf16_t*)(wl + WL_UP), M, 2 * DFF, opaque_i(DM / 2)}; pg8::UpOrder S; S.init(M, G, bx);
            pg8::EpiUp8 E{UP, 2 * DFF, AS8, QSC + 2 * L + 1, UPB, 1024, 40 * 256};
            pg8::gemm_phase<pg8::EpiUp8, pg8::NoHook, pg8::UpOrder, true>(lds, g, S, E, pg8::NoHook{}, MK_TID());
        }
        SEAM(pb + 6);
        if (IN(pb + 7)) { WS_LOCAL();
            const int wave = opaque_i(wave0), tid = wave * 64 + lane_id_now(), lane = tid & 63, gw = bx * 8 + wave; (void)lane; (void)gw;
            const float* cw = ffn_cw + (size_t)L * 3 * 2 * DFF;
            for (int item = bx * 512 + tid; item < 1024 * 704; item += G * 512) { const int rb = item / 704, c = (item % 704) * 8, row0 = rb * 8, t0 = row0 & (SEQ - 1);
                u32x4 gq[10], vq[10];
#pragma unroll
                for (int r = 0; r < 10; ++r) { if (r >= 2 || t0 >= 2) { const bf16_t* pr = UP + (size_t)(row0 + r - 2) * 2 * DFF + c; gq[r] = *(const u32x4*)pr; vq[r] = *(const u32x4*)(pr + DFF); }
                                               else { gq[r] = (u32x4){0u, 0u, 0u, 0u}; vq[r] = (u32x4){0u, 0u, 0u, 0u}; } }
                if (c >= 4608) {
#pragma unroll
                    for (int r = 0; r < 10; ++r) { if (r >= 2 || t0 >= 2) { const u32x4 b2 = *(const u32x4*)(UPB + (size_t)(row0 + r - 2) * 1024 + (c - 4608)); u32x4 s;
#pragma unroll
                            for (int e = 0; e < 4; ++e) s[e] = cvt_pk_bf16(bf_lo(vq[r][e]) + bf_lo(b2[e]), bf_hi(vq[r][e]) + bf_hi(b2[e]));
                            vq[r] = s; } } }
                float rq[10];
#pragma unroll
                for (int r = 0; r < 10; ++r) rq[r] = 1.0f;
                float wg[3][8], wv[3][8];
#pragma unroll
                for (int k = 0; k < 3; ++k) { const f32x4 a = *(const f32x4*)(cw + k * 2 * DFF + c), b = *(const f32x4*)(cw + k * 2 * DFF + c + 4), d = *(const f32x4*)(cw + k * 2 * DFF + DFF + c), e2 = *(const f32x4*)(cw + k * 2 * DFF + DFF + c + 4);
                    wg[k][0] = a.x; wg[k][1] = a.y; wg[k][2] = a.z; wg[k][3] = a.w; wg[k][4] = b.x; wg[k][5] = b.y; wg[k][6] = b.z; wg[k][7] = b.w;
                    wv[k][0] = d.x; wv[k][1] = d.y; wv[k][2] = d.z; wv[k][3] = d.w; wv[k][4] = e2.x; wv[k][5] = e2.y; wv[k][6] = e2.z; wv[k][7] = e2.w; }
#pragma unroll
                for (int r = 0; r < 8; ++r) { const u32x4 g0 = gq[r], g1 = gq[r + 1], g2 = gq[r + 2], v0 = vq[r], v1 = vq[r + 1], v2 = vq[r + 2];
                    float o[8];
#pragma unroll
                    for (int e = 0; e < 4; ++e) {
                        const float q0 = rq[r], q1 = rq[r + 1], q2 = rq[r + 2];
                        const float ga = wg[0][2 * e] * q0 * bf_lo(g0[e]) + wg[1][2 * e] * q1 * bf_lo(g1[e]) + wg[2][2 * e] * q2 * bf_lo(g2[e]), gb2 = wg[0][2 * e + 1] * q0 * bf_hi(g0[e]) + wg[1][2 * e + 1] * q1 * bf_hi(g1[e]) + wg[2][2 * e + 1] * q2 * bf_hi(g2[e]);
                        const float va = wv[0][2 * e] * q0 * bf_lo(v0[e]) + wv[1][2 * e] * q1 * bf_lo(v1[e]) + wv[2][2 * e] * q2 * bf_lo(v2[e]), vb = wv[0][2 * e + 1] * q0 * bf_hi(v0[e]) + wv[1][2 * e + 1] * q1 * bf_hi(v1[e]) + wv[2][2 * e + 1] * q2 * bf_hi(v2[e]);
                        o[2 * e] = ga * sigmoid_f(ga) * va; o[2 * e + 1] = gb2 * sigmoid_f(gb2) * vb; }
                    u32x4 w; w.x = cvt_pk_bf16(o[0], o[1]); w.y = cvt_pk_bf16(o[2], o[3]); w.z = cvt_pk_bf16(o[4], o[5]); w.w = cvt_pk_bf16(o[6], o[7]);
                    *(u32x4*)(HID + (size_t)(row0 + r) * DFF + c) = w; }
            }
        }
        SEAM(pb + 7);
        if (IN(pb + 8)) { WS_LOCAL();
            pg8::Gemm g{HID, (const bf16_t*)(wl + WL_DN), M, DM, DFF}; pg8::StaticOrder S; S.init(M, DM, G, bx);
            pg8::EpiResidN E{XR, SSQ + (size_t)M * 32};
            pg8::gemm_phase(lds, g, S, E, pg8::NoHook{}, MK_TID());
        }
        SEAM(pb + 8);
        if (IN(pb + 9)) { WS_LOCAL();
            pg8::Gemm g{XR, (const bf16_t*)(wl + WL_PG), M, DM, DM}; pg8::StaticOrder S; S.init(M, DM, G, bx);
            pg8::EpiPle E{XR, XRN, PP + (size_t)L * M * DM, SSQ + (size_t)M * 32};
            pg8::gemm_phase(lds, g, S, E, pg8::NoHook{}, MK_TID());
        }
        SEAM(pb + 9);
        if (IN(pb + 10)) { WS_LOCAL();
            const int wave = opaque_i(wave0), tid = wave * 64 + lane_id_now(), lane = tid & 63, gw = bx * 8 + wave; (void)lane; (void)gw;
            if (L + 1 < DEPTH) norm_phase<true, false, true>(nullptr, XRN, nullptr, RSC, XN8, AS8, norm_mix_g + (L + 1) * DM, WFG + (size_t)(L + 1) * 8 * DM, fox_b + (L + 1) * 8, LOGF, nullptr, nullptr, lds, gw, NGW, lane, tid);
            else norm_phase<false, true, true>(nullptr, XRN, nullptr, nullptr, nullptr, nullptr, nullptr, nullptr, nullptr, nullptr, final_g, X, lds, gw, NGW, lane, tid);
        }
        SEAM(pb + 10);
    }
#undef IN
#undef SEAM
#undef MK_TID
}
#undef x_in
#undef p_in
#undef pos_in
#undef norm_mix_g
#undef w_in
#undef fox_b
#undef scw
#undef sgu_g
#undef sgu_w
#undef sgu_b
#undef w_br_fox
#undef w_br_conv
#undef w_br_sgu
#undef w_br_dil
#undef w_out
#undef norm_ffn_g
#undef w_up
#undef ffn_cw
#undef w_down
#undef norm_ple_g
#undef w_pg
#undef w_pe
#undef final_g
#undef WFG
#undef SGUW
#undef ROPE
#undef LOGF
#undef FL
#undef LSE
#undef SSQ
#undef RSC
#undef FOP
#undef FML
#undef UPB
#undef G8
#undef XN8
#undef AS8
#undef QSC
#undef XR
#undef XRN
#undef PB
#undef PP
#undef XN
#undef PROJ
#undef UP
#undef HID
#undef OCAT
#undef MG
#undef ODIL
#undef WS_LOCAL
#undef wl

extern "C" void kernel_launch(void* const* d_in, const int* in_sizes, int n_in, void* d_out, int out_size, void* d_ws, size_t ws_size, hipStream_t stream) {
    static int grid = 0;
    if (grid == 0) {
        if (n_in != 23 || in_sizes[0] != M * DM || out_size != M * DM || ws_size < WS_END) { fprintf(stderr, "kernel_launch: unexpected shapes/workspace (n_in %d, ws %zu < %zu)\n", n_in, ws_size, (size_t)WS_END); grid = -1; return; }
        int dev = 0, cus = 0, per_cu = 0;
        if (hipGetDevice(&dev) != hipSuccess || hipDeviceGetAttribute(&cus, hipDeviceAttributeMultiprocessorCount, dev) != hipSuccess) { grid = -1; return; }
        if (hipFuncSetAttribute((const void*)mk_fwd, hipFuncAttributeMaxDynamicSharedMemorySize, LDS_BYTES) != hipSuccess) { fprintf(stderr, "kernel_launch: hipFuncSetAttribute failed\n"); grid = -1; return; }
        if (hipOccupancyMaxActiveBlocksPerMultiprocessor(&per_cu, (const void*)mk_fwd, 512, LDS_BYTES) != hipSuccess || per_cu < 1) fprintf(stderr, "kernel_launch: occupancy query says %d\n", per_cu);
        (void)hipGetLastError();
        grid = cus;
    }
    if (grid < 0) return;
    if (hipMemsetAsync((char*)d_ws + WS_CTL, 0, CTL_BYTES, stream) != hipSuccess) return;
    Args a{};
    for (int i = 0; i < 23; ++i) a.in[i] = (const float*)d_in[i];
    a.out = (float*)d_out; a.ws = (unsigned char*)d_ws; a.pad = 0;
    const int step = (MK_SPLIT > 0) ? MK_SPLIT : NPHASE;
    int li = 0;
    for (int lo = 0; lo < NPHASE; lo += step, ++li) {
        a.ph_lo = lo; a.ph_hi = (lo + step < NPHASE) ? lo + step : NPHASE; a.li = li;
        hipLaunchKernelGGL(mk_fwd, dim3(grid), dim3(512), LDS_BYTES, stream, a);
        if (hipPeekAtLastError() != hipSuccess) { fprintf(stderr, "kernel_launch: launch %d failed\n", li); break; }
    }
}
```
